# Optimizing an MI355X kernel written in HIP

```python
import math
import jax, jax.numpy as jnp
from jax import lax
import numpy as np

D_MODEL = 1024
BATCH = 4
SEQ = 4096
DEPTH = 4

GM_CHUNK = 128
GM_GROUPS = 4
GM_WIDTH = 256
GM_GROUP_DIM = GM_WIDTH // GM_GROUPS
RW_HEADS = 4
RW_HEAD_DIM = 64
RW_WIDTH = RW_HEADS * RW_HEAD_DIM
RW_DECAY_LORA = 32
RW_ICLR_LORA = 32
RW_GATE_LORA = 64
RW_SHIFT_WIDTH = 3 * RW_WIDTH + RW_DECAY_LORA + RW_ICLR_LORA + RW_GATE_LORA
RW_GN_EPS = 64e-5
FOX_HEADS = 8
FOX_HEAD_DIM = 64
FOX_WIDTH = FOX_HEADS * FOX_HEAD_DIM
FOX_BLOCK = 128
ATTN_SCALE = FOX_HEAD_DIM ** -0.5
MASK_VALUE = -1e30
N_BRANCH = 3
MIX_WIDTH = GM_WIDTH + RW_WIDTH + FOX_WIDTH
IN_WIDTH = 2 * GM_WIDTH + RW_SHIFT_WIDTH + 3 * FOX_WIDTH + FOX_HEADS + N_BRANCH * D_MODEL
N_EXPERTS = 32
TOP_K = 4
D_FF = D_MODEL
SWIGLU_LIMIT = 7.0
SWIGLU_ALPHA = 1.702
MOE_BLOCK = 256
EPS = 1e-6

kernel_name = "hybrid_gmlp_rwkv7_fox_moe_adaln"


def _split(z, sizes):
    idx = np.cumsum(sizes)[:-1].tolist()
    return jnp.split(z, idx, axis=-1)


def rms_norm(x):
    xf = x.astype(jnp.float32)
    return (xf * lax.rsqrt(jnp.mean(xf * xf, axis=-1, keepdims=True) + EPS)).astype(x.dtype)


def token_shift(z):
    return jnp.pad(z, ((0, 0), (1, 0), (0, 0)))[:, :-1]


def spatial_gating_mixer(u, v, v_gain, w_s, b_s):
    bsz, t_len, _ = u.shape
    u = jax.nn.gelu(u)
    v = rms_norm(jax.nn.gelu(v)) * v_gain
    n_chunk = t_len // GM_CHUNK
    vc = v.reshape(bsz, n_chunk, GM_CHUNK, GM_GROUPS, GM_GROUP_DIM)
    w_causal = jnp.tril(w_s)
    mixed = jnp.einsum('gts,bnsgc->bntgc', w_causal, vc) + b_s.T[None, None, :, :, None]
    return u * mixed.reshape(bsz, t_len, GM_WIDTH)


def rwkv7_mixer(r, k, v, w_lo, a_lo, g_lo, w0, w2, a0, a2, g2, k_k, k_a, r_k, gn_gain, gn_bias):
    bsz, t_len, _ = r.shape
    f32 = jnp.float32
    heads = lambda z: z.astype(f32).reshape(bsz, t_len, RW_HEADS, RW_HEAD_DIM)
    w_log = -jax.nn.softplus(-(w0 + jnp.tanh(w_lo) @ w2)) - 0.5
    decay = jnp.exp(-jnp.exp(w_log.astype(f32)))
    a = jax.nn.sigmoid(a0 + a_lo @ a2)
    g = jax.nn.sigmoid(g_lo) @ g2
    kk = heads(k * k_k)
    kk = kk / jnp.maximum(jnp.linalg.norm(kk, axis=-1, keepdims=True), 1e-12)
    k = k * (1 + (a - 1) * k_a)
    rh, kh, vh, ah, dh = heads(r), heads(k), heads(v), heads(a), heads(decay)
    a_vec = -kk
    b_vec = kk * ah

    def step(state, inp):
        r_t, w_t, k_t, v_t, a_t, b_t = inp
        sa = jnp.einsum('bhij,bhj->bhi', state, a_t)
        state = (state * w_t[:, :, None, :] + sa[..., None] * b_t[:, :, None, :]
                 + v_t[..., None] * k_t[:, :, None, :])
        return state, jnp.einsum('bhij,bhj->bhi', state, r_t)

    xs = tuple(jnp.moveaxis(z, 1, 0) for z in (rh, dh, kh, vh, a_vec, b_vec))
    state0 = jnp.zeros((bsz, RW_HEADS, RW_HEAD_DIM, RW_HEAD_DIM), f32)
    _, y = lax.scan(step, state0, xs)
    y = jnp.moveaxis(y, 0, 1)
    mu = jnp.mean(y, axis=-1, keepdims=True)
    var = jnp.mean(jnp.square(y - mu), axis=-1, keepdims=True)
    yn = ((y - mu) * lax.rsqrt(var + RW_GN_EPS)).reshape(bsz, t_len, RW_WIDTH) * gn_gain + gn_bias
    bonus = (jnp.sum(rh * kh * r_k, axis=-1, keepdims=True) * vh).reshape(bsz, t_len, RW_WIDTH)
    return ((yn + bonus) * g).astype(r.dtype)


def forgetting_attention(q, k, v, f_logit, f_bias, q_gain, k_gain):
    bsz, t_len, _ = q.shape
    hd = lambda z: z.reshape(bsz, t_len, FOX_HEADS, FOX_HEAD_DIM)
    q = rms_norm(hd(q)) * q_gain
    k = rms_norm(hd(k)) * k_gain
    v = hd(v)
    log_f = jax.nn.log_sigmoid((f_logit + f_bias).astype(jnp.float32))
    cum = jnp.transpose(jnp.cumsum(log_f, axis=1), (0, 2, 1))
    n_blk = t_len // FOX_BLOCK
    q_blocks = q.reshape(bsz, n_blk, FOX_BLOCK, FOX_HEADS, FOX_HEAD_DIM).transpose(1, 0, 2, 3, 4)
    c_blocks = cum.reshape(bsz, FOX_HEADS, n_blk, FOX_BLOCK).transpose(2, 0, 1, 3)
    key_pos = jnp.arange(t_len)

    def attend_block(args):
        qb, cb, bi = args
        s = jnp.einsum('bqhd,bkhd->bhqk', qb, k, preferred_element_type=jnp.float32) * ATTN_SCALE
        s = s + cb[..., :, None] - cum[:, :, None, :]
        q_pos = bi * FOX_BLOCK + jnp.arange(FOX_BLOCK)
        s = jnp.where(key_pos[None, :] <= q_pos[:, None], s, MASK_VALUE)
        p = jax.nn.softmax(s, axis=-1).astype(v.dtype)
        return jnp.einsum('bhqk,bkhd->bqhd', p, v)

    o = lax.map(attend_block, (q_blocks, c_blocks, jnp.arange(n_blk)))
    return o.transpose(1, 0, 2, 3, 4).reshape(bsz, t_len, FOX_WIDTH)


def moe_ffn(h, w_router, b_router, w_gate_up, b_gate_up, w_down, b_down):
    bsz, t_len, d = h.shape
    n_tok = bsz * t_len
    hf = h.reshape(n_tok, d)
    logits = (hf @ w_router + b_router).astype(jnp.float32)
    top_val, top_idx = lax.top_k(logits, TOP_K)
    gate = jax.nn.softmax(top_val, axis=-1)
    n_assign = n_tok * TOP_K
    n_blocks = -(-n_assign // MOE_BLOCK) + N_EXPERTS
    n_rows = n_blocks * MOE_BLOCK
    e_flat = top_idx.reshape(-1).astype(jnp.int32)
    tok_flat = jnp.arange(n_assign, dtype=jnp.int32) // TOP_K
    order = jnp.argsort(e_flat)
    e_sorted = e_flat[order]
    counts = jnp.bincount(e_flat, length=N_EXPERTS).astype(jnp.int32)
    padded = (counts + MOE_BLOCK - 1) // MOE_BLOCK * MOE_BLOCK
    start = jnp.cumsum(counts) - counts
    pad_end = jnp.cumsum(padded)
    pad_start = pad_end - padded
    dest = pad_start[e_sorted] + jnp.arange(n_assign, dtype=jnp.int32) - start[e_sorted]
    row_tok = jnp.zeros((n_rows,), jnp.int32).at[dest].set(tok_flat[order])
    row_w = jnp.zeros((n_rows,), jnp.float32).at[dest].set(gate.reshape(-1)[order])
    block_start = jnp.arange(n_blocks, dtype=jnp.int32) * MOE_BLOCK
    block_expert = jnp.minimum(jnp.searchsorted(pad_end, block_start, side='right'), N_EXPERTS - 1)
    xin = hf[row_tok].reshape(n_blocks, MOE_BLOCK, d)

    def expert_block(args):
        xb, e = args
        gu = xb @ w_gate_up[e] + b_gate_up[e]
        g_, u_ = jnp.split(gu, 2, axis=-1)
        g_ = jnp.minimum(g_, SWIGLU_LIMIT)
        u_ = jnp.clip(u_, -SWIGLU_LIMIT, SWIGLU_LIMIT)
        act = (u_ + 1) * (g_ * jax.nn.sigmoid(SWIGLU_ALPHA * g_))
        return act @ w_down[e] + b_down[e]

    yb = lax.map(expert_block, (xin, block_expert)).reshape(n_rows, d)
    y = jax.ops.segment_sum(yb * row_w[:, None].astype(yb.dtype), row_tok, num_segments=n_tok)
    return y.reshape(bsz, t_len, d)


def hybrid_layer(x, c, w_ada, b_ada, w_in, gm_v_gain, gm_w_s, gm_b_s, rw_mu, rw_w0, rw_w2, rw_a0, rw_a2,
                 rw_g2, rw_k_k, rw_k_a, rw_r_k, rw_gn_gain, rw_gn_bias, fox_f_bias, fox_q_gain, fox_k_gain,
                 w_branch, w_o, w_router, b_router, w_gate_up, b_gate_up, w_down, b_down):
    mod = jax.nn.silu(c) @ w_ada + b_ada
    shift1, scale1, gate1, shift2, scale2, gate2 = jnp.split(mod[:, None, :], 6, axis=-1)
    h = rms_norm(x) * (1 + scale1) + shift1
    z = h @ w_in
    z_gm, z_rw, z_fox, z_gate = _split(z, (2 * GM_WIDTH, RW_SHIFT_WIDTH, 3 * FOX_WIDTH + FOX_HEADS,
                                             N_BRANCH * D_MODEL))
    u, v = _split(z_gm, (GM_WIDTH, GM_WIDTH))
    y_gm = spatial_gating_mixer(u, v, gm_v_gain, gm_w_s, gm_b_s)
    z_rw = z_rw + rw_mu * (token_shift(z_rw) - z_rw)
    r, k, vr, w_lo, a_lo, g_lo = _split(z_rw, (RW_WIDTH, RW_WIDTH, RW_WIDTH, RW_DECAY_LORA, RW_ICLR_LORA,
                                              RW_GATE_LORA))
    y_rw = rwkv7_mixer(r, k, vr, w_lo, a_lo, g_lo, rw_w0, rw_w2, rw_a0, rw_a2, rw_g2, rw_k_k, rw_k_a, rw_r_k,
                       rw_gn_gain, rw_gn_bias)
    q, kf, vf, f_logit = _split(z_fox, (FOX_WIDTH, FOX_WIDTH, FOX_WIDTH, FOX_HEADS))
    y_fox = forgetting_attention(q, kf, vf, f_logit, fox_f_bias, fox_q_gain, fox_k_gain)
    g_gm, g_rw, g_fox = _split(jax.nn.sigmoid(z_gate), (D_MODEL, D_MODEL, D_MODEL))
    p_gm, p_rw, p_fox = jnp.split(w_branch, [GM_WIDTH, GM_WIDTH + RW_WIDTH], axis=0)
    merged = g_gm * (y_gm @ p_gm) + g_rw * (y_rw @ p_rw) + g_fox * (y_fox @ p_fox)
    x = x + gate1 * (merged @ w_o)
    h2 = rms_norm(x) * (1 + scale2) + shift2
    x = x + gate2 * moe_ffn(h2, w_router, b_router, w_gate_up, b_gate_up, w_down, b_down)
    return x


def setup_inputs(seed: int = 0) -> dict:
    key = jax.random.key(seed)
    ks = iter(jax.random.split(key, 48))
    L = DEPTH
    f32 = jnp.float32
    nrm = lambda shape, s: s * jax.random.normal(next(ks), shape, f32)
    uni = lambda shape, lo, hi: jax.random.uniform(next(ks), shape, f32, lo, hi)
    inp = {}
    inp['x'] = nrm((BATCH, SEQ, D_MODEL), 1.0)
    inp['c'] = nrm((BATCH, D_MODEL), 1.0)
    inp['w_ada'] = nrm((L, D_MODEL, 6 * D_MODEL), 0.5 * D_MODEL ** -0.5)
    inp['b_ada'] = nrm((L, 6 * D_MODEL), 0.02)
    inp['w_in'] = nrm((L, D_MODEL, IN_WIDTH), D_MODEL ** -0.5)
    inp['gm_v_gain'] = 1.0 + nrm((L, GM_WIDTH), 0.02)
    inp['gm_w_s'] = nrm((L, GM_GROUPS, GM_CHUNK, GM_CHUNK), GM_CHUNK ** -0.5)
    inp['gm_b_s'] = 1.0 + nrm((L, GM_GROUPS, GM_CHUNK), 0.1)
    inp['rw_mu'] = uni((L, RW_SHIFT_WIDTH), 0.0, 1.0)
    inp['rw_w0'] = uni((L, RW_WIDTH), -6.0, -1.0)
    inp['rw_w2'] = nrm((L, RW_DECAY_LORA, RW_WIDTH), 0.1)
    inp['rw_a0'] = nrm((L, RW_WIDTH), 0.1)
    inp['rw_a2'] = nrm((L, RW_ICLR_LORA, RW_WIDTH), 0.5 * RW_ICLR_LORA ** -0.5)
    inp['rw_g2'] = nrm((L, RW_GATE_LORA, RW_WIDTH), RW_GATE_LORA ** -0.5)
    inp['rw_k_k'] = 0.85 + nrm((L, RW_WIDTH), 0.02)
    inp['rw_k_a'] = 1.0 + nrm((L, RW_WIDTH), 0.02)
    inp['rw_r_k'] = nrm((L, RW_HEADS, RW_HEAD_DIM), 0.1)
    inp['rw_gn_gain'] = 1.0 + nrm((L, RW_WIDTH), 0.02)
    inp['rw_gn_bias'] = nrm((L, RW_WIDTH), 0.02)
    inp['fox_f_bias'] = uni((L, FOX_HEADS), 2.0, 6.0)
    inp['fox_q_gain'] = 1.0 + nrm((L, FOX_HEAD_DIM), 0.02)
    inp['fox_k_gain'] = 1.0 + nrm((L, FOX_HEAD_DIM), 0.02)
    inp['w_branch'] = jnp.concatenate([nrm((L, GM_WIDTH, D_MODEL), GM_WIDTH ** -0.5),
                                       nrm((L, RW_WIDTH, D_MODEL), RW_WIDTH ** -0.5),
                                       nrm((L, FOX_WIDTH, D_MODEL), FOX_WIDTH ** -0.5)], axis=1)
    inp['w_o'] = nrm((L, D_MODEL, D_MODEL), D_MODEL ** -0.5)
    inp['w_router'] = nrm((L, D_MODEL, N_EXPERTS), D_MODEL ** -0.5)
    inp['b_router'] = nrm((L, N_EXPERTS), 0.01)
    inp['w_gate_up'] = nrm((L, N_EXPERTS, D_MODEL, 2 * D_FF), D_MODEL ** -0.5)
    inp['b_gate_up'] = nrm((L, N_EXPERTS, 2 * D_FF), 0.01)
    inp['w_down'] = nrm((L, N_EXPERTS, D_FF, D_MODEL), D_FF ** -0.5)
    inp['b_down'] = nrm((L, N_EXPERTS, D_MODEL), 0.01)
    return inp


def reference(x, c, w_ada, b_ada, w_in, gm_v_gain, gm_w_s, gm_b_s, rw_mu, rw_w0, rw_w2, rw_a0, rw_a2, rw_g2,
              rw_k_k, rw_k_a, rw_r_k, rw_gn_gain, rw_gn_bias, fox_f_bias, fox_q_gain, fox_k_gain, w_branch, w_o,
              w_router, b_router, w_gate_up, b_gate_up, w_down, b_down):
    for l in range(DEPTH):
        x = hybrid_layer(x, c, w_ada[l], b_ada[l], w_in[l], gm_v_gain[l], gm_w_s[l], gm_b_s[l], rw_mu[l],
                         rw_w0[l], rw_w2[l], rw_a0[l], rw_a2[l], rw_g2[l], rw_k_k[l], rw_k_a[l], rw_r_k[l],
                         rw_gn_gain[l], rw_gn_bias[l], fox_f_bias[l], fox_q_gain[l], fox_k_gain[l], w_branch[l],
                         w_o[l], w_router[l], b_router[l], w_gate_up[l], b_gate_up[l], w_down[l], b_down[l])
    return x
```

```cpp
#define REP_MASK 0u
#include <hip/hip_runtime.h>
#include <hip/hip_bf16.h>
#include <cmath>
#include <cstdio>
#include <cstdint>

namespace pg8 {
#define PG8_LAS __attribute__((address_space(3)))
typedef unsigned short bf16_t;
typedef short bf16x8 __attribute__((ext_vector_type(8)));
typedef float f32x4 __attribute__((ext_vector_type(4)));
typedef unsigned u32x4 __attribute__((ext_vector_type(4)));
constexpr int BM = 256, BK = 64, HALF = 128, HTB = HALF * BK * 2, STAGE_BYTES = 8 * HTB, NXCD = 8, WGM = 8;

__host__ __device__ __forceinline__ int lds_byte(int r, int c) { const int st = (r >> 4) * 2 + (c >> 5), rr = r & 15, cc = c & 31, ob = rr * 64 + cc * 2; return st * 1024 + (ob ^ (((ob >> 9) & 1) << 5)); }
__host__ __device__ __forceinline__ void stage_rc(int b, int& R, int& C) { const int st = b / 1024, sb = b % 1024, swz = sb ^ (((sb >> 9) & 1) << 5); R = (st >> 1) * 16 + swz / 64; C = (st & 1) * 32 + (swz % 64) / 2; }
__host__ __device__ __forceinline__ int perm32(int rho) { const int n = rho >> 4, i = rho & 15; return 8 * (i >> 2) + 4 * n + (i & 3); }

struct Unit { int pm, pn; };
struct Gemm { const bf16_t* A; const bf16_t* Bt; int lda, ldb, K; };

struct StaticOrder {
    int nM, nN, nwg, G, c;
    __host__ __device__ void init(int M, int N, int G_, int c_) { nM = M / BM; nN = N / BM; nwg = nM * nN; G = G_; c = c_; }
    __host__ __device__ bool next(int i, Unit& u) const {
        const long L = (long)i * G + c; if (L >= nwg) return false;
        int wgid = (int)L; { const int q = nwg / NXCD, r = nwg % NXCD, xcd = wgid % NXCD, off = wgid / NXCD; wgid = (xcd < r ? xcd * (q + 1) : r * (q + 1) + (xcd - r) * q) + off; }
        const int nig = WGM * nN, gid = wgid / nig, fm = gid * WGM, gsz = (nM - fm) < WGM ? (nM - fm) : WGM;
        u.pm = fm + ((wgid % nig) % gsz); u.pn = (wgid % nig) / gsz; return true;
    }
};
template <int NSUB> struct SubOrder {
    StaticOrder S;
    __host__ __device__ void init(int M, int N, int G_, int c_) { S.init(M, N, G_, c_); }
    __host__ __device__ bool next(int i, Unit& u) const { Unit t; if (!S.next(i / NSUB, t)) return false; u.pm = t.pm; u.pn = t.pn * NSUB + (i % NSUB); return true; }
};
struct GroupedOrder {
    const PG8_LAS int* tb; int nct, G, c;
    __device__ __forceinline__ bool next(int i, Unit& u) const {
        const int T = tb[32], x = c & 7, r = c >> 3, per = G >> 3;
        const int t0 = (T * x) >> 3, t1 = (T * (x + 1)) >> 3;
        const int q = r + per * i; const int tl = q / nct, ct = q - tl * nct; const int tg = t0 + tl;
        if (tg >= t1) return false;
        int e = 0;
#pragma unroll
        for (int k = 1; k < 32; ++k) e += (tb[k] <= tg) ? 1 : 0;
        u.pm = __builtin_amdgcn_readfirstlane(tg); u.pn = __builtin_amdgcn_readfirstlane(e * nct + ct); return true;
    }
};

typedef float pk_f32x2_t __attribute__((ext_vector_type(2))); typedef __bf16 pk_bf16x2_t __attribute__((ext_vector_type(2)));
__device__ __forceinline__ unsigned cvt_pk_bf16(float lo, float hi) { pk_f32x2_t v = {lo, hi}; pk_bf16x2_t b = __builtin_convertvector(v, pk_bf16x2_t); return __builtin_bit_cast(unsigned, b); }

template <class Epi, class Sched, bool ALIGN_EPI>
__device__ __forceinline__ void gemm_phase(PG8_LAS unsigned char* lds, const Gemm g, const Sched& S, const Epi& E, const int tid) {
    const int wid = __builtin_amdgcn_readfirstlane(tid >> 6), lane = tid & 63, wr = wid >> 2, wc = wid & 3, fr = lane & 15, fq = lane >> 4;
    const int K = g.K, nt = K / BK;
    unsigned vA[2][2], nvA[2][2], voffB[2];
    int stR[2], stC[2];
#pragma unroll
    for (int i = 0; i < 2; ++i) { int R, C; stage_rc(tid * 16 + i * 8192, R, C); const int Rb = Epi::PERM ? ((R & ~31) + perm32(R & 31)) : R; stR[i] = R; stC[i] = C;
        vA[0][i] = (unsigned)(R * g.lda + C) * 2u; vA[1][i] = (unsigned)((R + HALF) * g.lda + C) * 2u; nvA[0][i] = vA[0][i]; nvA[1][i] = vA[1][i]; voffB[i] = (unsigned)(Rb * g.ldb + C) * 2u; }
#define PG8_GOFFS(dst, un) do { _Pragma("unroll") for (int h_ = 0; h_ < 2; ++h_) _Pragma("unroll") for (int i_ = 0; i_ < 2; ++i_) dst[h_][i_] = (unsigned)(E.row_src(un, stR[i_] + HALF * h_) * g.lda + stC[i_]) * 2u; } while (0)
#define PG8_ABASE(un) ((const char*)g.A + (Epi::GATHER ? (size_t)0 : (size_t)(un).pm * tstepA) + E.a_koff(un))
#define PG8_STAGE_A(bufoff, gbase, h, vsel) do { if constexpr (Epi::GATHER) { PG8_STAGE(bufoff, gbase, vsel); } else { PG8_STAGE(bufoff, (gbase) + ((h) ? hstepA : (size_t)0), vA[0]); } } while (0)
    const size_t kstep = (size_t)(BK * 2);
    const size_t hstepA = (size_t)HALF * g.lda * 2, hstepB = (size_t)HALF * g.ldb * 2;
    const size_t tstepA = 2 * hstepA, tstepB = 2 * hstepB;
    const unsigned ldsw = (unsigned)wid * 1024u;
    const int aoff = lds_byte(wr * 64 + fr, fq * 8), boff = lds_byte(wc * 32 + fr, fq * 8);
#define PG8_SA(b, h) (((b) * 2 + (h)) * HTB)
#define PG8_SB(b, h) ((4 + (b) * 2 + (h)) * HTB)
#define PG8_STAGE(bufoff, gbase, voff) do { _Pragma("unroll") for (int _i = 0; _i < 2; ++_i) \
        __builtin_amdgcn_global_load_lds((const unsigned*)((const char*)(gbase) + (voff)[_i]), (PG8_LAS unsigned*)(lds + (bufoff) + ldsw + _i * 8192), 16, 0, 0); } while (0)
#define PG8_LDA(dst, b, h) do { _Pragma("unroll") for (int m = 0; m < 4; ++m) _Pragma("unroll") for (int k = 0; k < 2; ++k) dst[m][k] = *(const PG8_LAS bf16x8*)(lds + PG8_SA(b, h) + aoff + m * 2048 + k * 1024); } while (0)
#define PG8_LDB(dst, b, h) do { _Pragma("unroll") for (int n = 0; n < 2; ++n) _Pragma("unroll") for (int k = 0; k < 2; ++k) dst[n][k] = *(const PG8_LAS bf16x8*)(lds + PG8_SB(b, h) + boff + n * 2048 + k * 1024); } while (0)
#define PG8_MMA(ai, bj, At, Bt) do { __builtin_amdgcn_s_setprio(1); _Pragma("unroll") for (int m = 0; m < 4; ++m) _Pragma("unroll") for (int n = 0; n < 2; ++n) _Pragma("unroll") for (int k = 0; k < 2; ++k) \
        acc[ai][bj][m][n] = __builtin_amdgcn_mfma_f32_16x16x32_bf16(Bt[n][k], At[m][k], acc[ai][bj][m][n], 0, 0, 0); __builtin_amdgcn_s_setprio(0); } while (0)
#define PG8_WAIT_V(n) asm volatile("s_waitcnt vmcnt(" #n ")" ::: "memory")
#define PG8_WAIT_L(n) asm volatile("s_waitcnt lgkmcnt(" #n ")" ::: "memory")
#define PG8_BAR __builtin_amdgcn_s_barrier()
#define PG8_SCHED __builtin_amdgcn_sched_barrier(0)
    Unit cur, nxt; int ui = 0;
    if (!S.next(0, cur)) return;
    f32x4 acc[2][2][4][2];
#pragma unroll
    for (int a = 0; a < 2; ++a)
#pragma unroll
        for (int b = 0; b < 2; ++b)
#pragma unroll
            for (int m = 0; m < 4; ++m)
#pragma unroll
                for (int n = 0; n < 2; ++n) acc[a][b][m][n] = (f32x4){0.f, 0.f, 0.f, 0.f};
    bf16x8 At[4][2], B0[2][2], B1[2][2];
    if constexpr (Epi::GATHER) PG8_GOFFS(vA, cur);
    const char* cA = PG8_ABASE(cur); const char* cB = (const char*)g.Bt + (size_t)E.b_tile(cur) * tstepB + E.b_koff(cur);
    {
        PG8_STAGE(PG8_SB(0, 0), cB, voffB); PG8_STAGE(PG8_SB(0, 1), cB + hstepB, voffB); PG8_STAGE_A(PG8_SA(0, 0), cA, 0, vA[0]); PG8_STAGE_A(PG8_SA(0, 1), cA, 1, vA[1]);
        if (wr == 1) PG8_BAR;
        PG8_WAIT_V(2); PG8_BAR;
        PG8_STAGE(PG8_SB(1, 0), cB + kstep, voffB); PG8_STAGE_A(PG8_SA(1, 0), cA + kstep, 0, vA[0]); PG8_STAGE(PG8_SB(1, 1), cB + hstepB + kstep, voffB);
        PG8_WAIT_V(6); PG8_BAR;
    }
    for (;;) {
        const bool has_next = S.next(ui + 1, nxt);
        const int ntc = E.ktiles(cur, nt);
        const char* nA = has_next ? PG8_ABASE(nxt) : cA; const char* nB = has_next ? (const char*)g.Bt + (size_t)E.b_tile(nxt) * tstepB + E.b_koff(nxt) : cB;
        if constexpr (Epi::GATHER) { if (has_next) PG8_GOFFS(nvA, nxt); else { _Pragma("unroll") for (int h_ = 0; h_ < 2; ++h_) _Pragma("unroll") for (int i_ = 0; i_ < 2; ++i_) nvA[h_][i_] = vA[h_][i_]; } }
#define PG8_KBODY(t) do { \
            const bool last = (t == ntc - 2); \
            const char* a1 = cA + (size_t)(t + 1) * kstep; \
            const char* a2 = last ? nA : cA + (size_t)(t + 2) * kstep; const char* b2 = last ? nB : cB + (size_t)(t + 2) * kstep; \
            const char* a3 = a2 + kstep; const char* b3 = b2 + kstep; \
            const unsigned x00 = last ? nvA[0][0] : vA[0][0], x01 = last ? nvA[0][1] : vA[0][1], x10 = last ? nvA[1][0] : vA[1][0], x11 = last ? nvA[1][1] : vA[1][1]; \
            const unsigned w0_[2] = {x00, x01}, w1_[2] = {x10, x11}; \
            PG8_LDB(B0, 0, 0); PG8_LDB(B1, 0, 1); PG8_SCHED; PG8_LDA(At, 0, 0); PG8_STAGE_A(PG8_SA(1, 1), a1, 1, vA[1]); \
            PG8_WAIT_V(8); PG8_WAIT_L(0); PG8_BAR; PG8_MMA(0, 0, At, B0); PG8_MMA(0, 1, At, B1); PG8_BAR; PG8_SCHED; \
            PG8_LDA(At, 0, 1); PG8_STAGE(PG8_SB(0, 0), b2, voffB); PG8_STAGE(PG8_SB(0, 1), b2 + hstepB, voffB); PG8_STAGE_A(PG8_SA(0, 0), a2, 0, w0_); \
            PG8_WAIT_V(8); PG8_WAIT_L(0); PG8_BAR; PG8_MMA(1, 0, At, B0); PG8_MMA(1, 1, At, B1); PG8_BAR; PG8_SCHED; \
            PG8_LDB(B0, 1, 0); PG8_LDB(B1, 1, 1); PG8_SCHED; PG8_LDA(At, 1, 0); PG8_STAGE_A(PG8_SA(0, 1), a2, 1, w1_); \
            PG8_WAIT_V(8); PG8_WAIT_L(0); PG8_BAR; PG8_MMA(0, 0, At, B0); PG8_MMA(0, 1, At, B1); PG8_BAR; PG8_SCHED; \
            PG8_LDA(At, 1, 1); PG8_STAGE(PG8_SB(1, 0), b3, voffB); PG8_STAGE(PG8_SB(1, 1), b3 + hstepB, voffB); PG8_STAGE_A(PG8_SA(1, 0), a3, 0, w0_); \
            PG8_WAIT_V(8); PG8_WAIT_L(0); PG8_BAR; PG8_MMA(1, 0, At, B0); PG8_MMA(1, 1, At, B1); PG8_BAR; PG8_SCHED; \
        } while (0)
        { int t = 0;
          if constexpr (Epi::KHOOK) {
              for (; t < 4; t += 2) PG8_KBODY(t);
              E.khook(acc, cur, 4, wr, wc, fr, fq);
              for (; t < 8; t += 2) PG8_KBODY(t);
              E.khook(acc, cur, 8, wr, wc, fr, fq);
          }
          for (; t < ntc; t += 2) PG8_KBODY(t); }
#undef PG8_KBODY
        if constexpr (ALIGN_EPI) { if (wr == 0) PG8_BAR; }
        E(acc, cur, wr, wc, fr, fq);
        if (!has_next) break;
#pragma unroll
        for (int a = 0; a < 2; ++a)
#pragma unroll
            for (int b = 0; b < 2; ++b)
#pragma unroll
                for (int m = 0; m < 4; ++m)
#pragma unroll
                    for (int n = 0; n < 2; ++n) acc[a][b][m][n] = (f32x4){0.f, 0.f, 0.f, 0.f};
        cur = nxt; cA = nA; cB = nB; ++ui;
        if constexpr (Epi::GATHER) { _Pragma("unroll") for (int h_ = 0; h_ < 2; ++h_) _Pragma("unroll") for (int i_ = 0; i_ < 2; ++i_) vA[h_][i_] = nvA[h_][i_]; }
        if constexpr (ALIGN_EPI) { if (wr == 1) PG8_BAR; }
    }
    PG8_WAIT_V(0);
    if constexpr (!ALIGN_EPI) { if (wr == 0) PG8_BAR; }
    PG8_BAR;
#undef PG8_GOFFS
#undef PG8_ABASE
#undef PG8_STAGE_A
#undef PG8_SA
#undef PG8_SB
#undef PG8_STAGE
#undef PG8_LDA
#undef PG8_LDB
#undef PG8_MMA
#undef PG8_WAIT_V
#undef PG8_WAIT_L
#undef PG8_BAR
#undef PG8_SCHED
}
}

namespace fox {
using bf16=__hip_bfloat16;
#define FOX_LAS __attribute__((address_space(3)))
using bf16x8=__attribute__((ext_vector_type(8)))short;
using s16x4=__attribute__((ext_vector_type(4)))short;
using f32x16=__attribute__((ext_vector_type(16)))float;
using u32x4=__attribute__((ext_vector_type(4)))unsigned;
constexpr int BATCH=4,NHEAD=8,SEQ=4096,D=64,DM=6144,DMO=1024;
constexpr int NW=8,QBLK=32,QB=QBLK*NW,KVBLK=64,NQB=SEQ/QB;
__device__ __forceinline__ int crow(int r,int hi){return (r&3)+8*(r>>2)+4*hi;}
#define SBAR() __builtin_amdgcn_sched_barrier(0)
__device__ __forceinline__ void cmask(f32x16&p0,f32x16&p1,int jb,int qrel,int hi){
  const float NEG=-INFINITY; const int x=qrel-64*jb-4*hi;
  #pragma unroll
  for(int r=0;r<16;++r){const int c=(r&3)+8*(r>>2); if(c>x)p0[r]=NEG; if(c+32>x)p1[r]=NEG;}
}

constexpr int NSLOT=3, SLOTB=8192;
constexpr int LDS_K=0, LDS_V=NSLOT*SLOTB, LDS_WS=2*NSLOT*SLOTB, LDS_OST=LDS_WS+NW*64*4, LDS_NCK=LDS_OST+NW*4096, LDS_BYTES=LDS_NCK+(SEQ+64)*4;
constexpr float C2=0.125f*1.4426950408889634f;
__device__ __forceinline__ void glds16(const void*gsrc,unsigned lds_dst){unsigned keep;
  asm volatile("s_mov_b32 %0, m0\n\ts_mov_b32 m0, %2\n\ts_nop 0\n\tglobal_load_lds_dwordx4 %1, off\n\ts_mov_b32 m0, %0":"=&s"(keep):"v"(gsrc),"s"(lds_dst):"memory");}
__device__ __forceinline__ float max3f(float a,float b,float c){float r;asm("v_max3_f32 %0, %1, %2, %3":"=v"(r):"v"(a),"v"(b),"v"(c));return r;}
__device__ __forceinline__ float max2f(float a,float b){float r;asm("v_max_f32_e32 %0, %1, %2":"=v"(r):"v"(a),"v"(b));return r;}
__device__ __forceinline__ float fadd_s(float a,float b){float r;asm("v_add_f32_e32 %0, %1, %2":"=v"(r):"v"(a),"v"(b));return r;}
__device__ __forceinline__ float fsub_s(float a,float b){float r;asm("v_sub_f32_e32 %0, %1, %2":"=v"(r):"v"(a),"v"(b));return r;}
typedef float f32x2_t __attribute__((ext_vector_type(2))); typedef float f32x4_t __attribute__((ext_vector_type(4))); typedef __bf16 bf16x2_t __attribute__((ext_vector_type(2)));
__device__ __forceinline__ unsigned cvtpk_s(float lo,float hi){f32x2_t v={lo,hi};bf16x2_t b=__builtin_convertvector(v,bf16x2_t);return __builtin_bit_cast(unsigned,b);}
#define WAIT_BAR(N) asm volatile("s_waitcnt vmcnt(" #N ") lgkmcnt(0)\n\ts_barrier":::"memory")

__device__ __forceinline__ void qkt(f32x16&p0,f32x16&p1,const char*Kslot,const bf16x8*qr,int r32,int hi){
  const char*kb=Kslot+hi*1024+r32*16;
  #pragma unroll
  for(int d0=0;d0<4;++d0){
    const bf16x8 b0=*reinterpret_cast<const bf16x8*>(kb+d0*2048);
    const bf16x8 b1=*reinterpret_cast<const bf16x8*>(kb+d0*2048+512);
    p0=__builtin_amdgcn_mfma_f32_32x32x16_bf16(b0,qr[d0],p0,0,0,0);p1=__builtin_amdgcn_mfma_f32_32x32x16_bf16(b1,qr[d0],p1,0,0,0);}
}
__device__ __forceinline__ void nck_load(f32x16&c0,f32x16&c1,const FOX_LAS float*nckh,int tile){
  const FOX_LAS float*cp=nckh+tile*64;
  #pragma unroll
  for(int g=0;g<4;++g){ const f32x4_t a=*(const FOX_LAS f32x4_t*)(cp+8*g), b=*(const FOX_LAS f32x4_t*)(cp+32+8*g);
    c0[4*g]=a[0];c0[4*g+1]=a[1];c0[4*g+2]=a[2];c0[4*g+3]=a[3]; c1[4*g]=b[0];c1[4*g+1]=b[1];c1[4*g+2]=b[2];c1[4*g+3]=b[3]; }
}
typedef __attribute__((address_space(3))) const char* lds_cptr;
typedef short v4i16_t __attribute__((ext_vector_type(4)));
__device__ __forceinline__ void kload8(bf16x8*kf,lds_cptr kp){
  kf[0]=*(const __attribute__((address_space(3))) bf16x8*)(kp);      kf[1]=*(const __attribute__((address_space(3))) bf16x8*)(kp+512);
  kf[2]=*(const __attribute__((address_space(3))) bf16x8*)(kp+2048); kf[3]=*(const __attribute__((address_space(3))) bf16x8*)(kp+2560);
  kf[4]=*(const __attribute__((address_space(3))) bf16x8*)(kp+4096); kf[5]=*(const __attribute__((address_space(3))) bf16x8*)(kp+4608);
  kf[6]=*(const __attribute__((address_space(3))) bf16x8*)(kp+6144); kf[7]=*(const __attribute__((address_space(3))) bf16x8*)(kp+6656);
}
__device__ __forceinline__ void kload2(bf16x8*kf,lds_cptr kp,int j){ kf[2*j]=*(const __attribute__((address_space(3))) bf16x8*)(kp+j*2048); kf[2*j+1]=*(const __attribute__((address_space(3))) bf16x8*)(kp+j*2048+512); }
__device__ __forceinline__ s16x4 vtr(lds_cptr p){ return __builtin_bit_cast(s16x4,__builtin_amdgcn_ds_read_tr16_b64_v4i16((__attribute__((address_space(3))) v4i16_t*)p)); }
__device__ __forceinline__ float rowmax(const f32x16&p0,const f32x16&p1){
  float a=max3f(p0[0],p0[1],p1[0]),b=max3f(p0[2],p0[3],p1[1]);a=max3f(a,p1[2],p1[3]);
  #pragma unroll
  for(int r=4;r<16;r+=4){a=max3f(a,p0[r],p0[r+1]);b=max3f(b,p0[r+2],p0[r+3]);a=max3f(a,p1[r],p1[r+1]);b=max3f(b,p1[r+2],p1[r+3]);}
  const float m=max2f(a,b);
  auto rr=__builtin_amdgcn_permlane32_swap(__float_as_uint(m),__float_as_uint(m),false,false);
  return max2f(__uint_as_float(rr[0]),__uint_as_float(rr[1]));
}
__device__ __forceinline__ void pv(f32x16*o,int vb,bf16x8 pa0,bf16x8 pa1,bf16x8 pa2,bf16x8 pa3){
  #pragma unroll
  for(int d0=0;d0<2;++d0){s16x4 lo[4],hi[4];
    #pragma unroll
    for(int ks=0;ks<4;++ks){
      asm volatile("ds_read_b64_tr_b16 %0,%1 offset:%c2":"=&v"(lo[ks]):"v"(vb),"i"(d0*4096+ks*1024):"memory");
      asm volatile("ds_read_b64_tr_b16 %0,%1 offset:%c2":"=&v"(hi[ks]):"v"(vb),"i"(d0*4096+ks*1024+512):"memory");}
    asm volatile("s_waitcnt lgkmcnt(0)":::"memory");SBAR();
    #define PK(k) (bf16x8){lo[k][0],lo[k][1],lo[k][2],lo[k][3],hi[k][0],hi[k][1],hi[k][2],hi[k][3]}
    o[d0]=__builtin_amdgcn_mfma_f32_32x32x16_bf16(pa0,PK(0),o[d0],0,0,0);
    o[d0]=__builtin_amdgcn_mfma_f32_32x32x16_bf16(pa1,PK(1),o[d0],0,0,0);
    o[d0]=__builtin_amdgcn_mfma_f32_32x32x16_bf16(pa2,PK(2),o[d0],0,0,0);
    o[d0]=__builtin_amdgcn_mfma_f32_32x32x16_bf16(pa3,PK(3),o[d0],0,0,0);
    #undef PK
  }
}

#ifndef ATTN_STORE16
#define ATTN_STORE16(p,v) (*(u32x4*)(p)=(v))
#endif
template<int THRL> __device__ __forceinline__ void attn_unit(int b,int h,int qb,const bf16*Q,const bf16*K,const bf16*V,bf16*O,const float*LOGF,char*shm,int tid,float skip_thr){
  const int lane=tid&63,r32=lane&31,hi=lane>>5; const int wid=__builtin_amdgcn_readfirstlane(tid>>6);
  const long rowbase=(long)b*SEQ; const int q0=qb*QB;
  const bf16*Qw=Q+(rowbase+q0+wid*QBLK)*DM+h*D;
  const lds_cptr shm3=(lds_cptr)shm;
  const unsigned lds0=(unsigned)(uintptr_t)shm;
  float*wsf=(float*)(shm+LDS_WS)+wid*64;
  const int NT0=(q0+QB)/KVBLK;
  FOX_LAS float*nckw=(FOX_LAS float*)(shm3+LDS_NCK);
  { const int nkeys=q0+QB; float run=0.f;
    __syncthreads();
    #pragma unroll
    for(int e=0;e<8;++e){const int t_=tid*8+e; const float x_=t_<nkeys?LOGF[(rowbase+t_)*NHEAD+h]:0.f; run+=x_; nckw[t_]=-run;}
    float inc=run;
    #pragma unroll
    for(int o_=1;o_<64;o_<<=1){const float n_=__shfl_up(inc,o_); if(lane>=o_)inc+=n_;}
    FOX_LAS float*wt=(FOX_LAS float*)(shm3+LDS_WS);
    if(lane==63)wt[wid]=inc;
    __syncthreads();
    float off=inc-run;
    for(int w_=0;w_<wid;++w_)off+=wt[w_];
    #pragma unroll
    for(int e=0;e<8;++e){const int t_=tid*8+e; nckw[t_]-=off;}
    __syncthreads();
  }
  int ts;
  { FOX_LAS int*ti=(FOX_LAS int*)(shm3+LDS_WS)+32;
    if(wid==0){ const bool keep=(lane<NT0)&&(nckw[64*lane+63]>=nckw[q0]-skip_thr); const unsigned long long m_=__ballot(keep); if(lane==0)ti[0]=m_?__builtin_ctzll(m_):0; }
    __syncthreads();
    ts=__builtin_amdgcn_readfirstlane(ti[0]); ts&=~1; if(ts>NT0-4)ts=NT0-4;
  }
  const int NT=NT0-ts;
  const bf16*Kh=K+(rowbase+(long)ts*KVBLK)*DM+h*D,*Vh=V+(rowbase+(long)ts*KVBLK)*DM+h*D;
  const bf16*ksrc=Kh+(long)lane*DM+wid*8;
  const bf16*vsrc=Vh+(long)(16*(wid&3)+(lane>>2))*DM+(wid>>2)*32+(lane&3)*8;
  const unsigned kdst=lds0+LDS_K+wid*1024, vdst=lds0+LDS_V+wid*1024;
  #define DMA_K(t,slot) glds16(ksrc+(long)(t)*KVBLK*DM,(unsigned)__builtin_amdgcn_readfirstlane(kdst+(slot)))
  #define DMA_V(t,slot) glds16(vsrc+(long)(t)*KVBLK*DM,(unsigned)__builtin_amdgcn_readfirstlane(vdst+(slot)))
  const int vb0=(int)(lds0+LDS_V)+((lane>>4)&1)*32+(lane&3)*8+(4*hi+((lane&15)>>2))*64;
  const char*Kbase=shm+LDS_K; bf16x8 kf[8];
  const lds_cptr kp0=shm3+LDS_K+hi*1024+r32*16; const lds_cptr vp0=shm3+LDS_V+((lane>>4)&1)*32+(lane&3)*8+(4*hi+((lane&15)>>2))*64;
  const FOX_LAS float*nckh=(const FOX_LAS float*)(shm3+LDS_NCK)+ts*KVBLK+4*hi;
  DMA_K(0,0);DMA_V(0,0);DMA_K(1,SLOTB);
  bf16x8 qr[4];
  #pragma unroll
  for(int d0=0;d0<4;++d0)qr[d0]=*reinterpret_cast<const bf16x8*>(&Qw[(long)r32*DM+d0*16+hi*8]);
  float l_reg=0.f;f32x16 o[2];o[0]=f32x16{};o[1]=f32x16{};
  const int qrel=wid*QBLK+r32;
  float nq=-nckw[q0+qrel];
  #define CMASK(P0,P1,t) do{int jb_=(t)-(NT-4); if(jb_>=0)cmask(P0,P1,jb_,qrel,hi);}while(0)
  bool resc=false;
  #define START(P0,P1) do{ const float rm=rowmax(P0,P1); resc=false; \
    { const float dl=rm; nq=fsub_s(nq,dl); \
      _Pragma("unroll") for(int r=0;r<16;++r){P0[r]=fsub_s(P0[r],dl);P1[r]=fsub_s(P1[r],dl);} } \
    _Pragma("unroll") for(int r=0;r<16;++r)P0[r]=__builtin_amdgcn_exp2f(P0[r]); }while(0)
  #define RESC() do{ if(resc){ asm volatile("s_waitcnt lgkmcnt(0)":::"memory"); \
      _Pragma("unroll") for(int d_=0;d_<2;++d_) _Pragma("unroll") for(int r=0;r<16;++r)o[d_][r]*=wsf[crow(r,hi)]; } }while(0)
  f32x16 pA0,pA1,pB0,pB1;
  int sl_prev=0,sl_cur=0,sl_next=SLOTB;
  #define ROT() do{sl_prev=sl_cur;sl_cur=sl_next;sl_next=(sl_next==(NSLOT-1)*SLOTB)?0:sl_next+SLOTB;}while(0)
  DMA_K(2,2*SLOTB);
  WAIT_BAR(3);
  nck_load(pA0,pA1,nckh,0);
  _Pragma("unroll") for(int r=0;r<16;++r){pA0[r]+=nq;pA1[r]+=nq;}
  qkt(pA0,pA1,Kbase,qr,r32,hi);asm volatile("s_nop 15\n\ts_nop 7":"+v"(pA0),"+v"(pA1));CMASK(pA0,pA1,0);
  START(pA0,pA1);
  _Pragma("unroll") for(int r=0;r<16;++r)pA1[r]=__builtin_amdgcn_exp2f(pA1[r]);
  nck_load(pB0,pB1,nckh,1);
  _Pragma("unroll") for(int r=0;r<16;++r){pB0[r]+=nq;pB1[r]+=nq;}
  WAIT_BAR(0);
  DMA_K(3,0);DMA_V(1,SLOTB);
  ROT();
  kload8(kf,kp0+sl_cur);
  WAIT_BAR(2);
  s16x4 vlo[8],vhi[8]; u32x4 pw0,pw1,pw2,pw3;
  #define PKW(P,B) cvtpk_s(P[B],P[B+1])
  #define PAF(k) __builtin_bit_cast(bf16x8,pw##k)
  #define VFR(i) (bf16x8){vlo[i][0],vlo[i][1],vlo[i][2],vlo[i][3],vhi[i][0],vhi[i][1],vhi[i][2],vhi[i][3]}
  #define PIN(x) asm volatile("":"+v"(x))
  #define MX3(a,b,c) __builtin_fmaxf(__builtin_fmaxf((a),(b)),(c))
  #define GAPA(MF,A0,A1,A2,A3,W0,W1,PW) do{ MF; sacc+=A0; sacc+=A1; sacc+=A2; sacc+=A3; PIN(sacc); W0; W1; PIN(PW); SBAR(); }while(0)
  #define EX(v) __builtin_amdgcn_exp2f(v)
  #define GAPB(MF,X,B,GL_,Y) do{ MF; X[B]=EX(X[B]); X[B+1]=EX(X[B+1]); X[B+2]=EX(X[B+2]); X[B+3]=EX(X[B+3]); PIN(X); if(GL_){ Y[B]+=nq; Y[B+1]+=nq; Y[B+2]+=nq; Y[B+3]+=nq; PIN(Y); } SBAR(); }while(0)
  #define VRD(i) do{ vlo[i]=vtr(vp_+(((i)>>2)*4096+((i)&3)*1024)); vhi[i]=vtr(vp_+(((i)>>2)*4096+((i)&3)*1024+512)); }while(0)
  #define KRD(G,j) do{ if(G){ kload2(kf,kp0+sl_next,j); SBAR(); } }while(0)
  #define STEP(C0,C1,P0,P1,t,GK,GV,GL) do{ SBAR(); \
    const lds_cptr vp_=vp0+sl_prev; \
    VRD(0); SBAR(); float sacc=(P0[0]+P0[1]); \
    GAPA(C0=__builtin_amdgcn_mfma_f32_32x32x16_bf16(kf[0],qr[0],C0,0,0,0), P0[2],P0[3],P0[4],P0[5],     pw0[0]=PKW(P0,0), pw0[1]=PKW(P0,2), pw0); \
    VRD(4); SBAR(); GAPA(C1=__builtin_amdgcn_mfma_f32_32x32x16_bf16(kf[1],qr[0],C1,0,0,0), P0[6],P0[7],P0[8],P0[9],     pw0[2]=PKW(P0,4), pw0[3]=PKW(P0,6), pw0); \
    VRD(1); SBAR(); GAPA(C0=__builtin_amdgcn_mfma_f32_32x32x16_bf16(kf[2],qr[1],C0,0,0,0),   P0[10],P0[11],P0[12],P0[13], pw1[0]=PKW(P0,8), pw1[1]=PKW(P0,10), pw1); \
    VRD(5); SBAR(); GAPA(C1=__builtin_amdgcn_mfma_f32_32x32x16_bf16(kf[3],qr[1],C1,0,0,0),   P0[14],P0[15],P1[0],P1[1],   pw1[2]=PKW(P0,12),pw1[3]=PKW(P0,14), pw1); \
    VRD(2); SBAR(); GAPA(C0=__builtin_amdgcn_mfma_f32_32x32x16_bf16(kf[4],qr[2],C0,0,0,0),   P1[2],P1[3],P1[4],P1[5],     pw2[0]=PKW(P1,0), pw2[1]=PKW(P1,2), pw2); \
    VRD(6); SBAR(); GAPA(C1=__builtin_amdgcn_mfma_f32_32x32x16_bf16(kf[5],qr[2],C1,0,0,0),   P1[6],P1[7],P1[8],P1[9],     pw2[2]=PKW(P1,4), pw2[3]=PKW(P1,6), pw2); \
    VRD(3); SBAR(); GAPA(C0=__builtin_amdgcn_mfma_f32_32x32x16_bf16(kf[6],qr[3],C0,0,0,0),   P1[10],P1[11],P1[12],P1[13], pw3[0]=PKW(P1,8), pw3[1]=PKW(P1,10), pw3); \
    VRD(7); SBAR(); GAPA(C1=__builtin_amdgcn_mfma_f32_32x32x16_bf16(kf[7],qr[3],C1,0,0,0),   P1[14],P1[15],0.f,0.f,       pw3[2]=PKW(P1,12),pw3[3]=PKW(P1,14), pw3); \
    l_reg+=sacc; \
    if(GL){ nck_load(P0,P1,nckh,(t)+1); SBAR(); } \
    if(GK){DMA_K((t)+3,sl_cur);} if(GV){DMA_V((t)+1,sl_next);} \
    CMASK(C0,C1,t); \
    { float a=MX3(C0[0],C0[1],C1[0]),b=MX3(C0[2],C0[3],C1[1]); a=MX3(a,C1[2],C1[3]); \
      _Pragma("unroll") for(int r=4;r<16;r+=4){a=MX3(a,C0[r],C0[r+1]);b=MX3(b,C0[r+2],C0[r+3]);a=MX3(a,C1[r],C1[r+1]);b=MX3(b,C1[r+2],C1[r+3]);} \
      float rm=__builtin_fmaxf(a,b); { auto rr=__builtin_amdgcn_permlane32_swap(__float_as_uint(rm),__float_as_uint(rm),false,false); rm=__builtin_fmaxf(__uint_as_float(rr[0]),__uint_as_float(rr[1])); } \
      resc=false; \
      if(__builtin_expect(__any(rm>(float)THRL),0)){ const float dl=__builtin_fmaxf(rm,0.f); nq-=dl; \
        _Pragma("unroll") for(int r=0;r<16;++r){C0[r]-=dl;C1[r]-=dl;} \
        const float f=__builtin_amdgcn_exp2f(-dl); l_reg*=f; if(hi==0)wsf[r32]=f; resc=true; } } \
    SBAR(); \
    GAPB(o[0]=__builtin_amdgcn_mfma_f32_32x32x16_bf16(PAF(0),VFR(0),o[0],0,0,0), C0,0,GL,P0); \
    GAPB(o[1]=__builtin_amdgcn_mfma_f32_32x32x16_bf16(PAF(0),VFR(4),o[1],0,0,0), C0,4,GL,P0); \
    KRD(GL,0); GAPB(o[0]=__builtin_amdgcn_mfma_f32_32x32x16_bf16(PAF(1),VFR(1),o[0],0,0,0), C0,8,GL,P0); \
    KRD(GL,1); GAPB(o[1]=__builtin_amdgcn_mfma_f32_32x32x16_bf16(PAF(1),VFR(5),o[1],0,0,0), C0,12,GL,P0); \
    KRD(GL,2); GAPB(o[0]=__builtin_amdgcn_mfma_f32_32x32x16_bf16(PAF(2),VFR(2),o[0],0,0,0), C1,0,GL,P1); \
    KRD(GL,3); GAPB(o[1]=__builtin_amdgcn_mfma_f32_32x32x16_bf16(PAF(2),VFR(6),o[1],0,0,0), C1,4,GL,P1); \
    GAPB(o[0]=__builtin_amdgcn_mfma_f32_32x32x16_bf16(PAF(3),VFR(3),o[0],0,0,0), C1,8,GL,P1); \
    GAPB(o[1]=__builtin_amdgcn_mfma_f32_32x32x16_bf16(PAF(3),VFR(7),o[1],0,0,0), C1,12,GL,P1); \
    }while(0)
  int t=1;
  #undef CMASK
  #define CMASK(P0,P1,t) do{}while(0)
  for(;t+5<NT;t+=2){
    STEP(pB0,pB1,pA0,pA1,t,true,true,true);     WAIT_BAR(2); RESC(); ROT();
    STEP(pA0,pA1,pB0,pB1,t+1,true,true,true);   WAIT_BAR(2); RESC(); ROT();
  }
  #undef CMASK
  #define CMASK(P0,P1,t) do{int jb_=(t)-(NT-4); if(jb_>=0)cmask(P0,P1,jb_,qrel,hi);}while(0)
  #define ENDW(tt) do{ if((tt)+3<NT){WAIT_BAR(2);} else if((tt)+2<NT){WAIT_BAR(1);} else {WAIT_BAR(0);} }while(0)
  for(;t+1<NT;t+=2){
    STEP(pB0,pB1,pA0,pA1,t,(t+3<NT),(t+1<NT),(t+1<NT));       ENDW(t);   RESC(); ROT();
    STEP(pA0,pA1,pB0,pB1,t+1,(t+4<NT),(t+2<NT),(t+2<NT));     ENDW(t+1); RESC(); ROT();
  }
  STEP(pB0,pB1,pA0,pA1,NT-1,false,false,false); RESC();
  { float sacc=pB0[0]+pB0[1]; _Pragma("unroll") for(int r=2;r<16;++r)sacc+=pB0[r]; _Pragma("unroll") for(int r=0;r<16;++r)sacc+=pB1[r]; l_reg+=sacc;
    pw0=(u32x4){PKW(pB0,0),PKW(pB0,2),PKW(pB0,4),PKW(pB0,6)};pw1=(u32x4){PKW(pB0,8),PKW(pB0,10),PKW(pB0,12),PKW(pB0,14)};pw2=(u32x4){PKW(pB1,0),PKW(pB1,2),PKW(pB1,4),PKW(pB1,6)};pw3=(u32x4){PKW(pB1,8),PKW(pB1,10),PKW(pB1,12),PKW(pB1,14)};
    SBAR(); pv(o,vb0+sl_cur,PAF(0),PAF(1),PAF(2),PAF(3)); }
  #undef PKW
  #undef PAF
  #undef VFR
  #undef PIN
  #undef MX3
  #undef GAPA
  #undef GAPB
  #undef EX
  #undef VRD
  #undef KRD
  #undef STEP
  #undef ENDW
  {auto rr=__builtin_amdgcn_permlane32_swap(__float_as_uint(l_reg),__float_as_uint(l_reg),false,false);l_reg=__uint_as_float(rr[0])+__uint_as_float(rr[1]);}
  if(hi==0)wsf[32+r32]=l_reg;asm volatile("s_waitcnt lgkmcnt(0)":::"memory");
  float rli[16];
  #pragma unroll
  for(int r=0;r<16;++r)rli[r]=__builtin_amdgcn_rcpf(wsf[32+crow(r,hi)]);
  bf16*Ow=O+(rowbase+q0+wid*QBLK)*DMO+h*D;
  { bf16*stg=(bf16*)(shm+LDS_OST)+wid*2048;
    #pragma unroll
    for(int r=0;r<16;++r){const int orow=crow(r,hi);
      #pragma unroll
      for(int d0=0;d0<2;++d0)stg[orow*64+d0*32+r32]=__float2bfloat16(o[d0][r]*rli[r]);}
    asm volatile("s_waitcnt lgkmcnt(0)":::"memory");
    #pragma unroll
    for(int i=0;i<4;++i){const int row=i*8+(lane>>3),ch=lane&7; const u32x4 v=*(const u32x4*)(stg+row*64+ch*8); ATTN_STORE16(Ow+(long)row*DMO+ch*8,v);} }
  asm volatile("s_waitcnt lgkmcnt(0)\n\ts_barrier":::"memory");
  #undef DMA_K
  #undef DMA_V
  #undef CMASK
  #undef START
  #undef RESC
  #undef ROT
}
constexpr int ATTN_LDS_BYTES=LDS_BYTES;
#undef SBAR
#undef WAIT_BAR
#undef FOX_LAS
}

constexpr int NWAVES = 8, NTHR = 512;
constexpr int DM = 1024, NB = 4, NT = 4096, NL = 4, M = NB * NT;
constexpr int NHR = 4, NHF = 8, HD = 64;
constexpr int INW = 6024, ZW = 6144;
constexpr int ZC_U = 0, ZC_V = 256, ZC_R = 512, ZC_LORA = 1280, ZC_FL = 1408, ZC_Q = 1536, ZC_KF = 2048, ZC_VF = 2560, ZC_GATE = 3072;
constexpr int NE = 32, TOPK = 4, DFF = 1024;
constexpr int RWC = 32, NCH = NT / RWC;
constexpr int MAXTILES = 288, XROWS = MAXTILES * 256;
constexpr float LOG2E = 1.4426950408889634f;
constexpr float QSCALE = 0.125f * LOG2E;

constexpr size_t MiB = 1u << 20;
constexpr size_t WS_CTL = 0, CTL_ZERO_BYTES = 1 * MiB;
constexpr size_t WS_MOD = 1 * MiB;
constexpr size_t WS_WRT = 1 * MiB + 512 * 1024;
constexpr size_t WS_WIN = 2 * MiB;
constexpr size_t WS_WBR = 50 * MiB;
constexpr size_t WS_WO = 58 * MiB;
constexpr size_t WS_WGU = 66 * MiB;
constexpr size_t WS_WD = 578 * MiB;
constexpr size_t WS_XN = 1912 * MiB;
constexpr size_t WS_Z = 866 * MiB;
constexpr size_t WS_FLOGIT = 1058 * MiB;
constexpr size_t WS_LOGF = 1059 * MiB;
constexpr size_t WS_RW = 1060 * MiB;
constexpr size_t WS_Y0 = 1172 * MiB, WS_RT = 1188 * MiB;
constexpr size_t WS_S0END = 1816 * MiB, WS_PEND = 1848 * MiB, WS_SST = 1880 * MiB;
constexpr size_t WS_SSP = 1204 * MiB;
constexpr size_t WS_YMIX = 1252 * MiB;
constexpr size_t WS_MRG = 1284 * MiB;
constexpr size_t WS_MERGED = 1348 * MiB;
constexpr size_t WS_ROWTOK = 1380 * MiB;
constexpr size_t WS_TOKPOS = 1382 * MiB;
constexpr size_t WS_TOKW = 1383 * MiB;
constexpr size_t WS_XS = 1384 * MiB;
constexpr size_t WS_ACT = 1528 * MiB;
constexpr size_t WS_YS = 1672 * MiB;
constexpr size_t WS_END = 1945 * MiB;
constexpr int CW_BAR = 4096;
constexpr int CW_ATT = 12288;
constexpr int CW_CUR = 16384;

constexpr int RING_BYTES = 131072;
constexpr int LDS_BYTES = 147456;
constexpr int LDSCTL_OFF = LDS_BYTES - 1024;

#define GAS __attribute__((address_space(1)))
#define LAS __attribute__((address_space(3)))
typedef unsigned short bf16;
typedef unsigned v4u __attribute__((ext_vector_type(4)));
typedef unsigned v2u __attribute__((ext_vector_type(2)));
typedef float f32x4 __attribute__((ext_vector_type(4)));
#define LDS_WAIT() asm volatile("s_waitcnt lgkmcnt(0)" ::: "memory")
#define VM_WAIT() asm volatile("s_waitcnt vmcnt(0)" ::: "memory")
__device__ __forceinline__ unsigned f2bf(float f) { unsigned u = __builtin_bit_cast(unsigned, f); return (u + 0x7fffu + ((u >> 16) & 1u)) >> 16; }
__device__ __forceinline__ unsigned pk2(float lo, float hi) { return f2bf(lo) | (f2bf(hi) << 16); }
typedef float cvt_f32x2_t __attribute__((ext_vector_type(2))); typedef __bf16 cvt_bf16x2_t __attribute__((ext_vector_type(2)));
__device__ __forceinline__ unsigned cvtpk_c(float lo, float hi) { cvt_f32x2_t v = {lo, hi}; cvt_bf16x2_t b = __builtin_convertvector(v, cvt_bf16x2_t); return __builtin_bit_cast(unsigned, b); }
__device__ __forceinline__ float bflo(unsigned w) { return __builtin_bit_cast(float, w << 16); }
__device__ __forceinline__ float bfhi(unsigned w) { return __builtin_bit_cast(float, w & 0xffff0000u); }
__device__ __forceinline__ float bf2f(bf16 h) { return __builtin_bit_cast(float, (unsigned)h << 16); }

#define XB_TMO      128
#define XB_XCNT(j)  (256  + 64 * (j))
#define XB_XSUB(j)  (1280 + 64 * (j))
#define XB_XGEN(j)  (2304 + 64 * (j))
#define XB_TOP      3328
#define XB_TOPGEN   3392
#define XCD_BAR_WORDS 3456
#define XB_SPIN_CAP (1u << 22)

__device__ __forceinline__ unsigned xb_ld(unsigned* p)              { return __hip_atomic_load(p, __ATOMIC_RELAXED, __HIP_MEMORY_SCOPE_AGENT); }
__device__ __forceinline__ unsigned xb_add(unsigned* p, unsigned v) { return __hip_atomic_fetch_add(p, v, __ATOMIC_RELAXED, __HIP_MEMORY_SCOPE_AGENT); }
__device__ __forceinline__ unsigned xb_xcc_id() { return (unsigned)__builtin_amdgcn_s_getreg((3 << 11) | 20) & 0xFu; }
#define XB_SPIN(cond, bar) do { unsigned _sp = 0; while (cond) { __builtin_amdgcn_s_sleep(1); \
    if ((++_sp & 255u) == 0u) { if (xb_ld(&(bar)[XB_TMO])) break; if (_sp > XB_SPIN_CAP) { atomicAdd(&(bar)[XB_TMO], 1u); break; } } } } while (0)

struct XcdBarrier { unsigned* bar; unsigned x; volatile LAS unsigned* st; };

__device__ __forceinline__ XcdBarrier xcd_barrier_post(unsigned* bar, volatile LAS unsigned* st) {
    XcdBarrier b; b.bar = bar; b.x = xb_xcc_id(); b.st = st;
    if (threadIdx.x == 0) (void)xb_add(&bar[XB_XCNT(b.x)], 1u);
    return b;
}
__device__ __forceinline__ void xcd_barrier_complete(unsigned* bar, unsigned x, unsigned& nloc, unsigned& nx) {
    const unsigned G = gridDim.x * gridDim.y * gridDim.z;
    unsigned sum, cnt, mine, sp = 0u;
    for (;;) {
        sum = 0u; cnt = 0u; mine = 0u;
#pragma unroll
        for (unsigned j = 0; j < 16; ++j) { const unsigned c = xb_ld(&bar[XB_XCNT(j)]); sum += c; cnt += (c > 0u) ? 1u : 0u; mine = (j == x) ? c : mine; }
        if (sum == G) break;
        __builtin_amdgcn_s_sleep(1);
        if ((++sp & 255u) == 0u) { if (xb_ld(&bar[XB_TMO])) break; if (sp > XB_SPIN_CAP) { atomicAdd(&bar[XB_TMO], 1u); break; } }
    }
    nloc = mine > 0u ? mine : 1u; nx = cnt > 0u ? cnt : 1u;
}
__device__ __forceinline__ void xcd_barrier(const XcdBarrier& b0, unsigned* barp) {
    XcdBarrier b; b.bar = barp; b.x = xb_xcc_id(); b.st = b0.st;
    asm volatile("s_waitcnt vmcnt(0)" ::: "memory");
    __syncthreads();
    if (threadIdx.x == 0) {
        unsigned* bar = b.bar;
        __builtin_amdgcn_s_waitcnt(0);
        unsigned nloc = b.st[0], nx = b.st[1];
        if (nloc == 0u) { xcd_barrier_complete(bar, b.x, nloc, nx); b.st[0] = nloc; b.st[1] = nx; }
        const unsigned old = xb_add(&bar[XB_XSUB(b.x)], 1u);
        const unsigned gen = old / nloc;
        if (old + 1u == (gen + 1u) * nloc) {
            __builtin_amdgcn_fence(__ATOMIC_RELEASE, "agent");
            asm volatile("s_waitcnt vmcnt(0)" ::: "memory");
            const unsigned og = xb_add(&bar[XB_TOP], 1u);
            const unsigned tg = og / nx;
            if (og + 1u == (tg + 1u) * nx) xb_add(&bar[XB_TOPGEN], 1u);
            else XB_SPIN(xb_ld(&bar[XB_TOPGEN]) == tg, bar);
            __builtin_amdgcn_fence(__ATOMIC_ACQUIRE, "agent");
            xb_add(&bar[XB_XGEN(b.x)], 1u);
            asm volatile("s_waitcnt vmcnt(0)" ::: "memory");
        } else {
            XB_SPIN(xb_ld(&bar[XB_XGEN(b.x)]) == gen, bar);
            __builtin_amdgcn_fence(__ATOMIC_ACQUIRE, "agent");
            asm volatile("s_waitcnt vmcnt(0)" ::: "memory");
        }
    }
    __syncthreads();
}

struct Params { const float* in[30]; float* out; unsigned char* ws; };
typedef const __attribute__((address_space(4))) unsigned long long* kptr_t;
struct Frame {
    LAS unsigned char* lds;
    kptr_t ka;
    int tid, lane, wave, G, gw, ngw, bid;
    __device__ __forceinline__ const float* in(int k) const { return (const float*)(const GAS float*)ka[k]; }
    __device__ __forceinline__ float* out() const { return (float*)(GAS float*)ka[30]; }
    __device__ __forceinline__ unsigned char* ws() const { return (unsigned char*)(GAS unsigned char*)ka[31]; }
};
__device__ __forceinline__ float wave_sum(float v) {
#pragma unroll
    for (int o = 1; o < 64; o <<= 1) v += __shfl_xor(v, o);
    return v;
}
__device__ __forceinline__ float sigmoidf_(float x) { return 1.f / (1.f + __expf(-x)); }
__device__ __forceinline__ float sigmoid_fast(float x) { return __builtin_amdgcn_rcpf(1.f + __builtin_amdgcn_exp2f(-1.4426950408889634f * x)); }
__device__ __forceinline__ float gelu_tanh(float x) { const float y = 0.7978845608028654f * (x + 0.044715f * x * x * x); const float t = 1.f - 2.f / (1.f + __expf(2.f * y)); return 0.5f * x * (1.f + t); }
__device__ __forceinline__ float softplusf_(float x) { return fmaxf(x, 0.f) + log1pf(__expf(-fabsf(x))); }

using pg8::Unit; using pg8::cvt_pk_bf16;
struct EpiBase {
    static constexpr bool KHOOK = false, GATHER = false;
    __device__ __forceinline__ int row_src(const Unit&, int R) const { return R; }
    __device__ __forceinline__ size_t a_koff(const Unit&) const { return 0; }
    __device__ __forceinline__ size_t b_koff(const Unit&) const { return 0; }
    __device__ __forceinline__ int b_tile(const Unit& u) const { return u.pn; }
    __device__ __forceinline__ int ktiles(const Unit&, int nt) const { return nt; }
};
struct EpiZ : EpiBase {
    static constexpr bool PERM = true;
    bf16* Z; float* FL;
    __device__ __forceinline__ void operator()(const f32x4 (&acc)[2][2][4][2], const Unit& u, int wr, int wc, int fr, int fq) const {
        const int row0 = u.pm * 256 + wr * 64 + fr, col0 = u.pn * 256 + wc * 32 + 8 * fq;
#pragma unroll
        for (int ai = 0; ai < 2; ++ai)
#pragma unroll
            for (int m = 0; m < 4; ++m) { const int row = row0 + ai * 128 + m * 16; bf16* rowp = Z + (size_t)row * ZW + col0;
#pragma unroll
                for (int bj = 0; bj < 2; ++bj) { const f32x4 v0 = acc[ai][bj][m][0], v1 = acc[ai][bj][m][1];
                    v4u w; w.x = cvt_pk_bf16(v0[0], v0[1]); w.y = cvt_pk_bf16(v0[2], v0[3]); w.z = cvt_pk_bf16(v1[0], v1[1]); w.w = cvt_pk_bf16(v1[2], v1[3]);
                    *(v4u*)(rowp + bj * 128) = w; }
                if (u.pn == 5 && wc == 0 && fq == 0) { *(f32x4*)(FL + (size_t)row * 8) = acc[ai][1][m][0]; *(f32x4*)(FL + (size_t)row * 8 + 4) = acc[ai][1][m][1]; } }
    }
};
struct EpiMerge : EpiBase {
    static constexpr bool PERM = true;
    const bf16* Z; float* MRG; bf16* MERGED;
    __device__ __forceinline__ int br(const Unit& u) const { return u.pn % 3; }
    __device__ __forceinline__ size_t a_koff(const Unit& u) const { const int b = br(u); return (size_t)(b == 0 ? 0 : (b == 1 ? 256 : 512)) * 2; }
    __device__ __forceinline__ size_t b_koff(const Unit& u) const { return a_koff(u); }
    __device__ __forceinline__ int b_tile(const Unit& u) const { return u.pn / 3; }
    __device__ __forceinline__ int ktiles(const Unit& u, int) const { return br(u) == 2 ? 8 : 4; }
    __device__ __forceinline__ void operator()(const f32x4 (&acc)[2][2][4][2], const Unit& u, int wr, int wc, int fr, int fq) const {
        const int b = br(u), pn = u.pn / 3;
        const int row0 = u.pm * 256 + wr * 64 + fr, col0 = pn * 256 + wc * 32 + 8 * fq;
#pragma unroll
        for (int ai = 0; ai < 2; ++ai)
#pragma unroll
            for (int m = 0; m < 4; ++m) { const int row = row0 + ai * 128 + m * 16;
#pragma unroll
                for (int bj = 0; bj < 2; ++bj) { const int col = col0 + bj * 128;
                    const v4u gz = *(const v4u*)(Z + (size_t)row * ZW + ZC_GATE + b * 1024 + col);
                    f32x4 v0 = acc[ai][bj][m][0], v1 = acc[ai][bj][m][1];
                    v0[0] *= sigmoid_fast(bflo(gz.x)); v0[1] *= sigmoid_fast(bfhi(gz.x)); v0[2] *= sigmoid_fast(bflo(gz.y)); v0[3] *= sigmoid_fast(bfhi(gz.y));
                    v1[0] *= sigmoid_fast(bflo(gz.z)); v1[1] *= sigmoid_fast(bfhi(gz.z)); v1[2] *= sigmoid_fast(bflo(gz.w)); v1[3] *= sigmoid_fast(bfhi(gz.w));
                    float* mp = MRG + (size_t)row * DM + col;
                    if (b > 0) { v0 += *(const f32x4*)mp; v1 += *(const f32x4*)(mp + 4); }
                    if (b < 2) { *(f32x4*)mp = v0; *(f32x4*)(mp + 4) = v1; }
                    else { v4u w; w.x = cvt_pk_bf16(v0[0], v0[1]); w.y = cvt_pk_bf16(v0[2], v0[3]); w.z = cvt_pk_bf16(v1[0], v1[1]); w.w = cvt_pk_bf16(v1[2], v1[3]);
                        *(v4u*)(MERGED + (size_t)row * DM + col) = w; } } }
    }
};
struct EpiMerge2 : EpiBase {
    static constexpr bool PERM = true, KHOOK = true;
    const bf16* Z; bf16* MERGED;
    static __device__ __forceinline__ float en(float z) { return __builtin_amdgcn_exp2f(-1.4426950408889634f * fminf(fmaxf(z, -30.f), 30.f)); }
    __device__ __forceinline__ void khook(f32x4 (&acc)[2][2][4][2], const Unit& u, int t, int wr, int wc, int fr, int fq) const {
        const int ga = (t == 4) ? 0 : 1;
        int row0 = u.pm * 256 + wr * 64 + fr, col0 = u.pn * 256 + wc * 32 + 8 * fq; const bf16* Zl = Z;
        asm volatile("" : "+v"(row0), "+v"(col0), "+s"(Zl));
#pragma unroll
        for (int ai = 0; ai < 2; ++ai)
#pragma unroll
            for (int m = 0; m < 4; ++m) { const int row = row0 + ai * 128 + m * 16;
#pragma unroll
                for (int bj = 0; bj < 2; ++bj) { const bf16* zp = Zl + (size_t)row * ZW + ZC_GATE + ga * 1024 + col0 + bj * 128;
                    const v4u za = *(const v4u*)zp, zb = *(const v4u*)(zp + 1024);
                    f32x4 r0, r1;
                    r0[0] = (1.f + en(bflo(zb.x))) * __builtin_amdgcn_rcpf(1.f + en(bflo(za.x))); r0[1] = (1.f + en(bfhi(zb.x))) * __builtin_amdgcn_rcpf(1.f + en(bfhi(za.x)));
                    r0[2] = (1.f + en(bflo(zb.y))) * __builtin_amdgcn_rcpf(1.f + en(bflo(za.y))); r0[3] = (1.f + en(bfhi(zb.y))) * __builtin_amdgcn_rcpf(1.f + en(bfhi(za.y)));
                    r1[0] = (1.f + en(bflo(zb.z))) * __builtin_amdgcn_rcpf(1.f + en(bflo(za.z))); r1[1] = (1.f + en(bfhi(zb.z))) * __builtin_amdgcn_rcpf(1.f + en(bfhi(za.z)));
                    r1[2] = (1.f + en(bflo(zb.w))) * __builtin_amdgcn_rcpf(1.f + en(bflo(za.w))); r1[3] = (1.f + en(bfhi(zb.w))) * __builtin_amdgcn_rcpf(1.f + en(bfhi(za.w)));
                    acc[ai][bj][m][0] *= r0; acc[ai][bj][m][1] *= r1;
                    asm volatile("" : "+v"(acc[ai][bj][m][0]), "+v"(acc[ai][bj][m][1]) :: "memory"); } }
    }
    __device__ __forceinline__ void operator()(const f32x4 (&acc)[2][2][4][2], const Unit& u, int wr, int wc, int fr, int fq) const {
        int row0 = u.pm * 256 + wr * 64 + fr, col0 = u.pn * 256 + wc * 32 + 8 * fq; const bf16* Zl = Z;
        asm volatile("" : "+v"(row0), "+v"(col0), "+s"(Zl));
#pragma unroll
        for (int ai = 0; ai < 2; ++ai)
#pragma unroll
            for (int m = 0; m < 4; ++m) { const int row = row0 + ai * 128 + m * 16;
#pragma unroll
                for (int bj = 0; bj < 2; ++bj) { const int col = col0 + bj * 128;
                    const v4u gz = *(const v4u*)(Zl + (size_t)row * ZW + ZC_GATE + 2 * 1024 + col);
                    f32x4 v0 = acc[ai][bj][m][0], v1 = acc[ai][bj][m][1];
                    v0[0] *= __builtin_amdgcn_rcpf(1.f + en(bflo(gz.x))); v0[1] *= __builtin_amdgcn_rcpf(1.f + en(bfhi(gz.x))); v0[2] *= __builtin_amdgcn_rcpf(1.f + en(bflo(gz.y))); v0[3] *= __builtin_amdgcn_rcpf(1.f + en(bfhi(gz.y)));
                    v1[0] *= __builtin_amdgcn_rcpf(1.f + en(bflo(gz.z))); v1[1] *= __builtin_amdgcn_rcpf(1.f + en(bfhi(gz.z))); v1[2] *= __builtin_amdgcn_rcpf(1.f + en(bflo(gz.w))); v1[3] *= __builtin_amdgcn_rcpf(1.f + en(bfhi(gz.w)));
                    v4u w; w.x = cvt_pk_bf16(v0[0], v0[1]); w.y = cvt_pk_bf16(v0[2], v0[3]); w.z = cvt_pk_bf16(v1[0], v1[1]); w.w = cvt_pk_bf16(v1[2], v1[3]);
                    *(v4u*)(MERGED + (size_t)row * DM + col) = w; } }
    }
};
struct EpiWo : EpiBase {
    static constexpr bool PERM = false;
    const float* xin; float* xout; const float* gate; float* SSP;
    __device__ __forceinline__ void operator()(const f32x4 (&acc)[2][2][4][2], const Unit& u, int wr, int wc, int fr, int fq) const {
        const int row0 = u.pm * 256 + wr * 64 + fr, col0 = u.pn * 256 + wc * 32 + 4 * fq;
#pragma unroll
        for (int ai = 0; ai < 2; ++ai)
#pragma unroll
            for (int m = 0; m < 4; ++m) { const int row = row0 + ai * 128 + m * 16; const int b = row / NT; float ss = 0.f;
#pragma unroll
                for (int bj = 0; bj < 2; ++bj)
#pragma unroll
                    for (int n = 0; n < 2; ++n) { const int col = col0 + bj * 128 + n * 16;
                        const f32x4 g4 = *(const f32x4*)(gate + (size_t)b * 6144 + col); const f32x4 x4 = *(const f32x4*)(xin + (size_t)row * DM + col);
                        const f32x4 o = x4 + g4 * acc[ai][bj][m][n]; *(f32x4*)(xout + (size_t)row * DM + col) = o; ss += (o[0] * o[0] + o[1] * o[1]) + (o[2] * o[2] + o[3] * o[3]); }
                ss += __shfl_xor(ss, 16); ss += __shfl_xor(ss, 32);
                if (fq == 0) SSP[(size_t)row * 16 + u.pn * 4 + wc] = ss; }
    }
};
struct EpiMoe1 : EpiBase {
    static constexpr bool PERM = true, GATHER = true;
    const float* bgu; bf16* ACT;
    const int* ROWTOK; const LAS int* tb; const LAS int* cnt;
    __device__ __forceinline__ int row_src(const Unit& u, int R) const { const int e = u.pn >> 3; const int r = (u.pm - tb[e]) * 256 + R; return r < cnt[e] ? ROWTOK[e * M + r] : M; }
    typedef float f32x2 __attribute__((ext_vector_type(2)));
    static __device__ __forceinline__ f32x2 act2(f32x2 g, f32x2 u) {
        f32x2 gg, uu; gg.x = fminf(g.x, 7.f); gg.y = fminf(g.y, 7.f); uu.x = __builtin_amdgcn_fmed3f(u.x, -7.f, 7.f); uu.y = __builtin_amdgcn_fmed3f(u.y, -7.f, 7.f);
        const f32x2 t = gg * (-1.702f * 1.4426950408889634f); f32x2 e; e.x = __builtin_amdgcn_exp2f(t.x); e.y = __builtin_amdgcn_exp2f(t.y);
        const f32x2 d = e + 1.0f; f32x2 r; r.x = __builtin_amdgcn_rcpf(d.x); r.y = __builtin_amdgcn_rcpf(d.y);
        return (uu + 1.0f) * (gg * r);
    }
    __device__ __forceinline__ void operator()(const f32x4 (&acc)[2][2][4][2], const Unit& u, int wr, int wc, int fr, int fq) const {
        const int e = u.pn >> 3, ct = u.pn & 7;
        const int row0 = u.pm * 256 + wr * 64 + fr, j0 = ct * 128 + wc * 32 + 8 * fq;
        const float* bg = bgu + (size_t)e * 2048 + j0;
        const f32x4 bg0 = *(const f32x4*)bg, bg1 = *(const f32x4*)(bg + 4), bu0 = *(const f32x4*)(bg + 1024), bu1 = *(const f32x4*)(bg + 1028);
#pragma unroll
        for (int ai = 0; ai < 2; ++ai)
#pragma unroll
            for (int m = 0; m < 4; ++m) { const int row = row0 + ai * 128 + m * 16;
                const f32x4 g0 = acc[ai][0][m][0] + bg0, g1 = acc[ai][0][m][1] + bg1, u0 = acc[ai][1][m][0] + bu0, u1 = acc[ai][1][m][1] + bu1;
                const f32x2 o0 = act2((f32x2){g0[0], g0[1]}, (f32x2){u0[0], u0[1]}), o1 = act2((f32x2){g0[2], g0[3]}, (f32x2){u0[2], u0[3]});
                const f32x2 o2 = act2((f32x2){g1[0], g1[1]}, (f32x2){u1[0], u1[1]}), o3 = act2((f32x2){g1[2], g1[3]}, (f32x2){u1[2], u1[3]});
                v4u w; w.x = cvt_pk_bf16(o0.x, o0.y); w.y = cvt_pk_bf16(o1.x, o1.y); w.z = cvt_pk_bf16(o2.x, o2.y); w.w = cvt_pk_bf16(o3.x, o3.y);
                *(v4u*)(ACT + (size_t)row * DFF + j0) = w; }
    }
};
struct EpiMoe2 : EpiBase {
    static constexpr bool PERM = true;
    const float* bd; bf16* YS;
    __device__ __forceinline__ void operator()(const f32x4 (&acc)[2][2][4][2], const Unit& u, int wr, int wc, int fr, int fq) const {
        const int e = u.pn >> 2, ct = u.pn & 3;
        const int row0 = u.pm * 256 + wr * 64 + fr, col0 = ct * 256 + wc * 32 + 8 * fq;
#pragma unroll
        for (int bj = 0; bj < 2; ++bj) { const float* bp = bd + (size_t)e * 1024 + col0 + bj * 128; const f32x4 b0 = *(const f32x4*)bp, b1 = *(const f32x4*)(bp + 4);
#pragma unroll
            for (int ai = 0; ai < 2; ++ai)
#pragma unroll
                for (int m = 0; m < 4; ++m) { const int row = row0 + ai * 128 + m * 16; const f32x4 v0 = acc[ai][bj][m][0] + b0, v1 = acc[ai][bj][m][1] + b1;
                    v4u w; w.x = cvt_pk_bf16(v0[0], v0[1]); w.y = cvt_pk_bf16(v0[2], v0[3]); w.z = cvt_pk_bf16(v1[0], v1[1]); w.w = cvt_pk_bf16(v1[2], v1[3]);
                    *(v4u*)(YS + (size_t)row * DM + col0 + bj * 128) = w; } }
    }
};

template <class Map>
__device__ __forceinline__ void transpose_item(const float* W, int K, int N, bf16* WT, LAS float* scr, int kb, int nb, int lane, Map map) {
    const int k0 = 64 * kb, n0 = 32 * nb;
    const int sc = map(n0 + (lane & 31));
#pragma unroll 8
    for (int i = 0; i < 32; ++i) { const int kk = 2 * i + (lane >> 5); scr[kk * 33 + (lane & 31)] = sc >= 0 ? W[(size_t)(k0 + kk) * N + sc] : 0.f; }
    LDS_WAIT(); asm volatile("" ::: "memory");
    const int c = lane & 7;
#pragma unroll
    for (int j = 0; j < 4; ++j) { const int n = (lane >> 3) + 8 * j; const LAS float* s = scr + (8 * c) * 33 + n;
        v4u o; o.x = pk2(s[0 * 33], s[1 * 33]); o.y = pk2(s[2 * 33], s[3 * 33]); o.z = pk2(s[4 * 33], s[5 * 33]); o.w = pk2(s[6 * 33], s[7 * 33]);
        *(v4u*)(WT + (size_t)(n0 + n) * K + k0 + 8 * c) = o; }
    LDS_WAIT(); asm volatile("" ::: "memory");
}
struct MapWin { __device__ __forceinline__ int operator()(int d) const {
    if (d < 1408) return d; if (d < 1416) return 2944 + (d - 1408); if (d < 1536) return -1; if (d < 3072) return 1408 + (d - 1536); return 2952 + (d - 3072); } };
struct MapId { __device__ __forceinline__ int operator()(int d) const { return d; } };
struct MapGU { __device__ __forceinline__ int operator()(int d) const { const int ct = d >> 8, w = d & 255; return w < 128 ? ct * 128 + w : 1024 + ct * 128 + (w - 128); } };

__device__ __forceinline__ void p_convert(Frame& F) {
    LAS float* scr = (LAS float*)(F.lds + F.wave * 16384);
    constexpr int I_WIN = 16 * 192, I_SQ = 16 * 32, I_GU = 16 * 64;
    constexpr int N_WIN = NL * I_WIN, N_BR = NL * I_SQ, N_WO = NL * I_SQ, N_GU = NL * NE * I_GU, N_D = NL * NE * I_SQ;
    constexpr int NITEMS = N_WIN + N_BR + N_WO + N_GU + N_D;
    for (int it = F.gw; it < NITEMS; it += F.ngw) {
        int r = it;
        if (r < N_WIN) { const int l = r / I_WIN, q = r % I_WIN; transpose_item(F.in(4) + (size_t)l * DM * INW, DM, INW, (bf16*)(F.ws() + WS_WIN) + (size_t)l * ZW * DM, scr, q / 192, q % 192, F.lane, MapWin()); continue; } r -= N_WIN;
        if (r < N_BR) { const int l = r / I_SQ, q = r % I_SQ; transpose_item(F.in(22) + (size_t)l * DM * DM, DM, DM, (bf16*)(F.ws() + WS_WBR) + (size_t)l * DM * DM, scr, q / 32, q % 32, F.lane, MapId()); continue; } r -= N_BR;
        if (r < N_WO) { const int l = r / I_SQ, q = r % I_SQ; transpose_item(F.in(23) + (size_t)l * DM * DM, DM, DM, (bf16*)(F.ws() + WS_WO) + (size_t)l * DM * DM, scr, q / 32, q % 32, F.lane, MapId()); continue; } r -= N_WO;
        if (r < N_GU) { const int le = r / I_GU, q = r % I_GU; transpose_item(F.in(26) + (size_t)le * DM * 2048, DM, 2048, (bf16*)(F.ws() + WS_WGU) + (size_t)le * 2048 * DM, scr, q / 64, q % 64, F.lane, MapGU()); continue; } r -= N_GU;
        { const int le = r / I_SQ, q = r % I_SQ; transpose_item(F.in(28) + (size_t)le * DFF * DM, DFF, DM, (bf16*)(F.ws() + WS_WD) + (size_t)le * DM * DFF, scr, q / 32, q % 32, F.lane, MapId()); }
    }
}
__device__ __forceinline__ void p_mod(Frame& F) {
    LAS float* sc = (LAS float*)(F.lds);
    LAS float* part = (LAS float*)(F.lds + 16384);
    const float* c = F.in(1);
    for (int i = F.tid; i < NB * DM; i += NTHR) { const float v = c[i]; sc[i] = v * sigmoidf_(v); }
    __syncthreads();
    float* MOD = (float*)(F.ws() + WS_MOD);
    for (int un = F.bid; un < NL * 96; un += F.G) {
        const int l = un / 96, n0 = (un % 96) * 64, n = n0 + F.lane, kq = F.wave;
        const float* W = F.in(2) + (size_t)l * DM * 6144 + n;
        float a0 = 0.f, a1 = 0.f, a2 = 0.f, a3 = 0.f;
#pragma unroll 8
        for (int k = kq * 128; k < kq * 128 + 128; ++k) { const float w = W[(size_t)k * 6144]; a0 += w * sc[k]; a1 += w * sc[1024 + k]; a2 += w * sc[2048 + k]; a3 += w * sc[3072 + k]; }
        part[(kq * 4 + 0) * 64 + F.lane] = a0; part[(kq * 4 + 1) * 64 + F.lane] = a1; part[(kq * 4 + 2) * 64 + F.lane] = a2; part[(kq * 4 + 3) * 64 + F.lane] = a3;
        __syncthreads();
        if (F.tid < 256) { const int b = F.tid >> 6, cn = F.tid & 63; float s = 0.f;
#pragma unroll
            for (int q = 0; q < 8; ++q) s += part[(q * 4 + b) * 64 + cn];
            MOD[((size_t)l * NB + b) * 6144 + n0 + cn] = s + F.in(3)[(size_t)l * 6144 + n0 + cn]; }
        __syncthreads();
    }
}
__device__ __forceinline__ void norm_row_store(const f32x4 (&v)[4], float rs, const float* shift, const float* scale, bf16* orow, int lane) {
#pragma unroll
    for (int j = 0; j < 4; ++j) { const int c = 4 * lane + 256 * j; const f32x4 sh = *(const f32x4*)(shift + c), sc = *(const f32x4*)(scale + c);
        const f32x4 o = v[j] * rs * (sc + 1.f) + sh; v2u w; w.x = pk2(o[0], o[1]); w.y = pk2(o[2], o[3]); *(v2u*)(orow + c) = w; }
}
__device__ __forceinline__ void p_norm_rows(Frame& F, const float* x, const float* modl  , int shift_off, int scale_off) {
    bf16* XN = (bf16*)(F.ws() + WS_XN);
    if (F.gw == 0) { v4u z = {0u, 0u, 0u, 0u}; ((v4u*)(XN + (size_t)M * DM))[F.lane] = z; ((v4u*)(XN + (size_t)M * DM))[64 + F.lane] = z; }
    for (int row = F.gw; row < M; row += F.ngw) {
        const f32x4* xr = (const f32x4*)(x + (size_t)row * DM) + F.lane; f32x4 v[4]; float s = 0.f;
#pragma unroll
        for (int j = 0; j < 4; ++j) { v[j] = xr[64 * j]; s += (v[j][0] * v[j][0] + v[j][1] * v[j][1]) + (v[j][2] * v[j][2] + v[j][3] * v[j][3]); }
        const float rs = 1.f / sqrtf(wave_sum(s) * (1.f / DM) + 1e-6f);
        const float* mb = modl + (size_t)(row / NT) * 6144;
        norm_row_store(v, rs, mb + shift_off, mb + scale_off, XN + (size_t)row * DM, F.lane);
    }
}

__device__ __forceinline__ void ld4bf(const bf16* p, float (&o)[4]) { const v2u w = *(const v2u*)p; o[0] = bflo(w.x); o[1] = bfhi(w.x); o[2] = bflo(w.y); o[3] = bfhi(w.y); }
__device__ __forceinline__ void p_prep(Frame& F, int l, bool dummy, int g_begin, int g_step, int g_end) {
    bf16* Z = (bf16*)(F.ws() + WS_Z); const size_t zd = dummy ? (WS_XS - WS_Z) / 2 : 0;
    float* RWB = (float*)(F.ws() + WS_RW);
    const size_t TS = (size_t)M * 256;
    float *R_ = RWB, *KP_ = RWB + TS, *VV_ = RWB + 2 * TS, *AV_ = RWB + 3 * TS, *BV_ = RWB + 4 * TS, *WD_ = RWB + 5 * TS, *GG_ = RWB + 6 * TS;
    const float* FL = (const float*)(F.ws() + WS_FLOGIT); float* LOGF = (float*)(F.ws() + WS_LOGF);
    const float* vgain = F.in(5) + (size_t)l * 256;
    const float* mu = F.in(8) + (size_t)l * 896;
    const float* w0 = F.in(9) + (size_t)l * 256; const float* w2 = F.in(10) + (size_t)l * 32 * 256;
    const float* a0 = F.in(11) + (size_t)l * 256; const float* a2 = F.in(12) + (size_t)l * 32 * 256;
    const float* g2 = F.in(13) + (size_t)l * 64 * 256;
    const float* k_k = F.in(14) + (size_t)l * 256; const float* k_a = F.in(15) + (size_t)l * 256;
    const float* fbias = F.in(19) + (size_t)l * 8; const float* qgain = F.in(20) + (size_t)l * 64; const float* kgain = F.in(21) + (size_t)l * 64;
    LAS float* scr = (LAS float*)(F.lds + F.wave * 2048);
    const int lane = F.lane, c4 = 4 * lane;
    for (int grp = g_begin; grp < g_end; grp += g_step) {
        float k4[4][4];
#pragma unroll
        for (int tk = 0; tk < 4; ++tk) {
            const int tok = 4 * grp + tk; float r4[4], v4[4];
            bf16* zr = Z + (size_t)tok * ZW; const bf16* zp = zr - ZW; const bool hasprev = (tok % NT) != 0;
            { float u[4]; ld4bf(zr + ZC_U + c4, u); v2u w; w.x = pk2(gelu_tanh(u[0]), gelu_tanh(u[1])); w.y = pk2(gelu_tanh(u[2]), gelu_tanh(u[3])); *(v2u*)(zr + zd + ZC_U + c4) = w;
              float v[4]; ld4bf(zr + ZC_V + c4, v); float ss = 0.f;
#pragma unroll
              for (int i = 0; i < 4; ++i) { v[i] = gelu_tanh(v[i]); ss += v[i] * v[i]; }
              const float rs = 1.f / sqrtf(wave_sum(ss) * (1.f / 256.f) + 1e-6f); const f32x4 gn = *(const f32x4*)(vgain + c4);
              w.x = pk2(v[0] * rs * gn[0], v[1] * rs * gn[1]); w.y = pk2(v[2] * rs * gn[2], v[3] * rs * gn[3]); *(v2u*)(zr + zd + ZC_V + c4) = w; }
            { float cur[4], prv[4] = {0.f, 0.f, 0.f, 0.f}; f32x4 m4;
              ld4bf(zr + ZC_R + c4, cur); if (hasprev) ld4bf(zp + ZC_R + c4, prv); m4 = *(const f32x4*)(mu + c4);
#pragma unroll
              for (int i = 0; i < 4; ++i) r4[i] = cur[i] + m4[i] * (prv[i] - cur[i]);
              ld4bf(zr + ZC_R + 256 + c4, cur); if (hasprev) ld4bf(zp + ZC_R + 256 + c4, prv); m4 = *(const f32x4*)(mu + 256 + c4);
#pragma unroll
              for (int i = 0; i < 4; ++i) k4[tk][i] = cur[i] + m4[i] * (prv[i] - cur[i]);
              ld4bf(zr + ZC_R + 512 + c4, cur); if (hasprev) ld4bf(zp + ZC_R + 512 + c4, prv); m4 = *(const f32x4*)(mu + 512 + c4);
#pragma unroll
              for (int i = 0; i < 4; ++i) v4[i] = cur[i] + m4[i] * (prv[i] - cur[i]);
              *(f32x4*)(R_ + (size_t)tok * 256 + c4) = (f32x4){r4[0], r4[1], r4[2], r4[3]}; *(f32x4*)(VV_ + (size_t)tok * 256 + c4) = (f32x4){v4[0], v4[1], v4[2], v4[3]};
              if (lane < 32) { ld4bf(zr + ZC_LORA + c4, cur); if (hasprev) ld4bf(zp + ZC_LORA + c4, prv); m4 = *(const f32x4*)(mu + 768 + c4);
#pragma unroll
                  for (int i = 0; i < 4; ++i) { float x = cur[i] + m4[i] * (prv[i] - cur[i]);
                      if (lane < 8) x = 1.f - 2.f / (1.f + __expf(2.f * x));
                      else if (lane >= 16) x = sigmoidf_(x);
                      scr[tk * 128 + c4 + i] = x; } }
            }
#pragma unroll
            for (int qk = 0; qk < 2; ++qk) {
                bf16* p = zr + (qk == 0 ? ZC_Q : ZC_KF) + 8 * lane; const v4u w = *(const v4u*)p;
                float x[8] = {bflo(w.x), bfhi(w.x), bflo(w.y), bfhi(w.y), bflo(w.z), bfhi(w.z), bflo(w.w), bfhi(w.w)}; float ss = 0.f;
#pragma unroll
                for (int i = 0; i < 8; ++i) ss += x[i] * x[i];
                ss += __shfl_xor(ss, 1); ss += __shfl_xor(ss, 2); ss += __shfl_xor(ss, 4);
                const float rs = (1.f / sqrtf(ss * (1.f / 64.f) + 1e-6f)) * (qk == 0 ? QSCALE : 1.f);
                const float* gp = (qk == 0 ? qgain : kgain) + 8 * (lane & 7); const f32x4 g0 = *(const f32x4*)gp, g1 = *(const f32x4*)(gp + 4);
                v4u o; o.x = pk2(x[0] * rs * g0[0], x[1] * rs * g0[1]); o.y = pk2(x[2] * rs * g0[2], x[3] * rs * g0[3]); o.z = pk2(x[4] * rs * g1[0], x[5] * rs * g1[1]); o.w = pk2(x[6] * rs * g1[2], x[7] * rs * g1[3]);
                *(v4u*)(p + zd) = o;
            }
            if (lane < 8) { const float f = FL[(size_t)tok * 8 + lane] + fbias[lane]; LOGF[(size_t)tok * 8 + lane] = (fminf(f, 0.f) - log1pf(__expf(-fabsf(f)))) * LOG2E; }
            asm volatile("" ::: "memory");
        }
        LDS_WAIT(); asm volatile("" ::: "memory");
        f32x4 aw[4], aa[4], ag[4];
#pragma unroll
        for (int tk = 0; tk < 4; ++tk) { aw[tk] = (f32x4){0.f, 0.f, 0.f, 0.f}; aa[tk] = aw[tk]; ag[tk] = aw[tk]; }
        int c4m = c4; asm volatile("" : "+v"(c4m));
#pragma unroll 4
        for (int j = 0; j < 32; ++j) { const f32x4 wv = *(const f32x4*)(w2 + j * 256 + c4m), av_ = *(const f32x4*)(a2 + j * 256 + c4m);
#pragma unroll
            for (int tk = 0; tk < 4; ++tk) { aw[tk] += scr[tk * 128 + j] * wv; aa[tk] += scr[tk * 128 + 32 + j] * av_; } }
#pragma unroll 4
        for (int j = 0; j < 64; ++j) { const f32x4 gv = *(const f32x4*)(g2 + j * 256 + c4m);
#pragma unroll
            for (int tk = 0; tk < 4; ++tk) ag[tk] += scr[tk * 128 + 64 + j] * gv; }
        asm volatile("" ::: "memory");
        const f32x4 w04 = *(const f32x4*)(w0 + c4m), a04 = *(const f32x4*)(a0 + c4m), kk4 = *(const f32x4*)(k_k + c4m), ka4 = *(const f32x4*)(k_a + c4m);
#pragma unroll
        for (int tk = 0; tk < 4; ++tk) {
            f32x4 dec, av, kkv, kp; float ss = 0.f;
#pragma unroll
            for (int i = 0; i < 4; ++i) { const float uu = w04[i] + aw[tk][i]; const float wlog = -softplusf_(-uu) - 0.5f; dec[i] = __expf(-__expf(wlog));
                av[i] = sigmoidf_(a04[i] + aa[tk][i]); kkv[i] = k4[tk][i] * kk4[i]; ss += kkv[i] * kkv[i]; kp[i] = k4[tk][i] * (1.f + (av[i] - 1.f) * ka4[i]); }
            ss += __shfl_xor(ss, 1); ss += __shfl_xor(ss, 2); ss += __shfl_xor(ss, 4); ss += __shfl_xor(ss, 8);
            const float inv = 1.f / fmaxf(sqrtf(ss), 1e-12f);
            f32x4 nkk, bv;
#pragma unroll
            for (int i = 0; i < 4; ++i) { const float q = kkv[i] * inv; nkk[i] = -q; bv[i] = q * av[i]; }
            const size_t o = (size_t)(4 * grp + tk) * 256 + c4m;
            *(f32x4*)(KP_ + o) = kp;
            *(f32x4*)(AV_ + o) = nkk; *(f32x4*)(BV_ + o) = bv; *(f32x4*)(WD_ + o) = dec; *(f32x4*)(GG_ + o) = ag[tk];
        }
        LDS_WAIT(); asm volatile("" ::: "memory");
    }
}

typedef float f32x2 __attribute__((ext_vector_type(2)));
__device__ __forceinline__ void p_rwkv_pass1(Frame& F, int un_begin, int un_step, int un_end) {
    const float* RWB = (const float*)(F.ws() + WS_RW); const size_t TS = (size_t)M * 256;
    float* Y0 = (float*)(F.ws() + WS_Y0); float* RT = (float*)(F.ws() + WS_RT);
    float* S0E = (float*)(F.ws() + WS_S0END); float* PE = (float*)(F.ws() + WS_PEND);
    LAS float* sh = (LAS float*)F.lds;
    constexpr int NBATCH = RWC / 4;
    const int sub = F.wave >> 2, h = F.wave & 3, i = F.lane, tid = F.tid;
    for (int un = un_begin; un < un_end; un += un_step) {
        const int tok0 = un * 2 * RWC;
        int ii = i; asm volatile("" : "+v"(ii));
        float S[64], P[64];
#pragma unroll
        for (int j = 0; j < 64; ++j) { S[j] = 0.f; P[j] = (j == ii) ? 1.f : 0.f; }
#define RW1_SRC(r, batch) (RWB + (size_t)((((tid + 512 * (r)) >> 8) % 6)) * TS + (size_t)(tok0 + ((tid + 512 * (r)) / 1536) * RWC + (batch) * 4 + (((tid + 512 * (r)) >> 6) & 3)) * 256 + ((tid + 512 * (r)) & 63) * 4)
#define RW1_DMA(batch) do { _Pragma("unroll") for (int r = 0; r < 6; ++r) __builtin_amdgcn_global_load_lds((const unsigned*)RW1_SRC(r, batch), (LAS unsigned*)(F.lds + ((batch) & 1) * 49152 + (F.wave * 64 + 512 * r) * 16), 16, 0, 0); } while (0)
#define FMAC(acc, a, b) asm("v_fmac_f32 %0, %1, %2" : "+v"(acc) : "v"(a), "v"(b))
#define FMA3(d, a, b, c) asm("v_fma_f32 %0, %1, %2, %3" : "=v"(d) : "v"(a), "v"(b), "v"(c))
#define MUL2(d, a, b) asm("v_mul_f32 %0, %1, %2" : "=v"(d) : "v"(a), "v"(b))
        __syncthreads();
        RW1_DMA(0);
        for (int batch = 0; batch < NBATCH; ++batch) {
            asm volatile("s_waitcnt vmcnt(0)" ::: "memory");
            __syncthreads();
            if (batch + 1 < NBATCH) RW1_DMA(batch + 1);
            const LAS float* cb = sh + (batch & 1) * 12288 + sub * (6 * 4 * 256) + h * 64;
#pragma unroll 1
            for (int st = 0; st < 4; ++st) {
                const LAS float* rr = cb + 0 * 1024 + st * 256; const LAS float* kk = cb + 1 * 1024 + st * 256; const LAS float* vv = cb + 2 * 1024 + st * 256;
                const LAS float* av = cb + 3 * 1024 + st * 256; const LAS float* bv = cb + 4 * 1024 + st * 256; const LAS float* wd = cb + 5 * 1024 + st * 256;
                const float vi = vv[i];
                float aS0 = 0.f, aS1 = 0.f, aP0 = 0.f, aP1 = 0.f;
#pragma unroll
                for (int j = 0; j < 64; j += 4) { const f32x4 a4 = *(const LAS f32x4*)(av + j);
                    FMAC(aS0, S[j], a4[0]); FMAC(aS1, S[j + 1], a4[1]); FMAC(aP0, P[j], a4[0]); FMAC(aP1, P[j + 1], a4[1]);
                    FMAC(aS0, S[j + 2], a4[2]); FMAC(aS1, S[j + 3], a4[3]); FMAC(aP0, P[j + 2], a4[2]); FMAC(aP1, P[j + 3], a4[3]); }
                const float saS = aS0 + aS1, saP = aP0 + aP1;
                float yS0 = 0.f, yS1 = 0.f, yP0 = 0.f, yP1 = 0.f;
#pragma unroll
                for (int j = 0; j < 64; j += 4) {
                    const f32x4 w4 = *(const LAS f32x4*)(wd + j), b4 = *(const LAS f32x4*)(bv + j), k4 = *(const LAS f32x4*)(kk + j), r4 = *(const LAS f32x4*)(rr + j);
#pragma unroll
                    for (int q = 0; q < 4; ++q) { float tS, tP; MUL2(tS, saS, b4[q]); MUL2(tP, saP, b4[q]); FMAC(tS, vi, k4[q]);
                        FMA3(S[j + q], S[j + q], w4[q], tS); FMA3(P[j + q], P[j + q], w4[q], tP); }
                    FMAC(yS0, S[j], r4[0]); FMAC(yS1, S[j + 1], r4[1]); FMAC(yP0, P[j], r4[0]); FMAC(yP1, P[j + 1], r4[1]);
                    FMAC(yS0, S[j + 2], r4[2]); FMAC(yS1, S[j + 3], r4[3]); FMAC(yP0, P[j + 2], r4[2]); FMAC(yP1, P[j + 3], r4[3]); }
                const size_t o = (size_t)(tok0 + sub * RWC + batch * 4 + st) * 256 + h * 64 + i;
                Y0[o] = yS0 + yS1; RT[o] = yP0 + yP1;
            }
        }
#undef FMAC
#undef FMA3
#undef MUL2
#undef RW1_SRC
#undef RW1_DMA
        const size_t sb = ((size_t)(un * 2 + sub) * 4 + h) * 4096 + (size_t)i * 64;
#pragma unroll
        for (int j = 0; j < 64; j += 4) { *(f32x4*)(S0E + sb + j) = (f32x4){S[j], S[j + 1], S[j + 2], S[j + 3]}; *(f32x4*)(PE + sb + j) = (f32x4){P[j], P[j + 1], P[j + 2], P[j + 3]}; }
    }
}
__device__ __forceinline__ void p_rwkv_pass2(Frame& F, int first_block) {
    typedef float f32x16 __attribute__((ext_vector_type(16)));
    typedef short bf16x8_t __attribute__((ext_vector_type(8)));
    const float* S0E = (const float*)(F.ws() + WS_S0END); const float* PE = (const float*)(F.ws() + WS_PEND); float* SST = (float*)(F.ws() + WS_SST);
    constexpr int LP = 72;
    constexpr int IMG = 64 * LP;
    LAS bf16* SH = (LAS bf16*)F.lds;
    LAS bf16* PT = SH + 4 * IMG;
    const int bh = F.bid - first_block; if (bh < 0 || bh >= NB * NHR) return;
    const int b = bh / NHR, h = bh % NHR, tid = F.tid, lane = F.lane, w = F.wave;
    const int l31 = lane & 31, hi = lane >> 5, tJ = (w >> 1) & 1, tI = w & 1;
    const size_t cbase = ((size_t)(b * NCH) * 4 + h) * 4096;
    for (int idx = tid; idx < 2 * IMG; idx += NTHR) SH[idx] = 0;
    for (int idx = tid; idx < 4096; idx += NTHR) { const int i_ = idx >> 6, j_ = idx & 63; const float v = PE[cbase + idx]; const unsigned vh = f2bf(v);
        PT[j_ * LP + i_] = (bf16)vh; PT[IMG + j_ * LP + i_] = (bf16)f2bf(v - __builtin_bit_cast(float, vh << 16)); }
    __syncthreads();
    if (w < 4) {
        const float* s0p = S0E + cbase + (size_t)(32 * tI + l31) * 64 + 32 * tJ + 4 * hi;
        const LAS bf16* ap0 = PT + (32 * tJ + l31) * LP + 8 * hi; const LAS bf16* bp0 = SH + (32 * tI + l31) * LP + 8 * hi;
        LAS bf16* sw0 = SH + (32 * tI + l31) * LP + 32 * tJ + 4 * hi;
        f32x4 cA[4], cB[4];
#define P2_S0(dst, cc) do { _Pragma("unroll") for (int g = 0; g < 4; ++g) dst[g] = *(const f32x4*)(s0p + (size_t)(cc) * 16384 + 8 * g); } while (0)
#define P2_STEP(cin, cb_, cnext) do { f32x16 acc; _Pragma("unroll") for (int g = 0; g < 4; ++g) { acc[4 * g] = cin[g][0]; acc[4 * g + 1] = cin[g][1]; acc[4 * g + 2] = cin[g][2]; acc[4 * g + 3] = cin[g][3]; } \
        if ((cnext) < NCH) P2_S0(cin, cnext); \
        const LAS bf16* ap = ap0 + (cb_) * 2 * IMG; const LAS bf16* bp = bp0 + (cb_) * 2 * IMG; bf16x8_t ah[4], al[4], bhh[4], bll[4]; \
        _Pragma("unroll") for (int s = 0; s < 4; ++s) { ah[s] = *(const LAS bf16x8_t*)(ap + 16 * s); al[s] = *(const LAS bf16x8_t*)(ap + IMG + 16 * s); bhh[s] = *(const LAS bf16x8_t*)(bp + 16 * s); bll[s] = *(const LAS bf16x8_t*)(bp + IMG + 16 * s); } \
        _Pragma("unroll") for (int s = 0; s < 4; ++s) { acc = __builtin_amdgcn_mfma_f32_32x32x16_bf16(ah[s], bhh[s], acc, 0, 0, 0); acc = __builtin_amdgcn_mfma_f32_32x32x16_bf16(ah[s], bll[s], acc, 0, 0, 0); acc = __builtin_amdgcn_mfma_f32_32x32x16_bf16(al[s], bhh[s], acc, 0, 0, 0); } \
        LAS bf16* sw = sw0 + ((cb_) ^ 1) * 2 * IMG; \
        _Pragma("unroll") for (int g = 0; g < 4; ++g) { v2u vh, vl; vh.x = cvtpk_c(acc[4 * g], acc[4 * g + 1]); vh.y = cvtpk_c(acc[4 * g + 2], acc[4 * g + 3]); \
            vl.x = cvtpk_c(acc[4 * g] - bflo(vh.x), acc[4 * g + 1] - bfhi(vh.x)); vl.y = cvtpk_c(acc[4 * g + 2] - bflo(vh.y), acc[4 * g + 3] - bfhi(vh.y)); \
            *(LAS v2u*)(sw + 8 * g) = vh; *(LAS v2u*)(sw + IMG + 8 * g) = vl; } \
        asm volatile("s_waitcnt lgkmcnt(0)\n\ts_barrier" ::: "memory"); } while (0)
        P2_S0(cA, 0); P2_S0(cB, 1);
        for (int c = 0; c < NCH; c += 2) { P2_STEP(cA, 0, c + 2); P2_STEP(cB, 1, c + 3); }
#undef P2_S0
#undef P2_STEP
    } else if (w < 6) {
        const int q = tid - 256;
        f32x4 pa[4], pb[4];
#define P2_PL(cc) do { _Pragma("unroll") for (int r = 0; r < 4; ++r) { const int it_ = q + 128 * r; const float* p_ = PE + cbase + (size_t)(cc) * 16384 + (size_t)(2 * (it_ >> 4)) * 64 + 4 * (it_ & 15); pa[r] = *(const f32x4*)p_; pb[r] = *(const f32x4*)(p_ + 64); } } while (0)
        P2_PL(1);
        for (int c = 0; c < NCH; ++c) {
            if (c + 1 < NCH) { LAS bf16* pn = PT + ((c & 1) ^ 1) * 2 * IMG;
#pragma unroll
                for (int r = 0; r < 4; ++r) { const int it_ = q + 128 * r, ip = it_ >> 4, j4 = it_ & 15;
#pragma unroll
                    for (int e = 0; e < 4; ++e) { const unsigned vh = cvtpk_c(pa[r][e], pb[r][e]); const unsigned vl = cvtpk_c(pa[r][e] - bflo(vh), pb[r][e] - bfhi(vh));
                        *(LAS unsigned*)(pn + (4 * j4 + e) * LP + 2 * ip) = vh; *(LAS unsigned*)(pn + IMG + (4 * j4 + e) * LP + 2 * ip) = vl; } }
                if (c + 2 < NCH) P2_PL(c + 2); }
            asm volatile("s_waitcnt lgkmcnt(0)\n\ts_barrier" ::: "memory");
        }
#undef P2_PL
    } else {
        const int q = tid - 384;
        for (int c = 0; c < NCH; ++c) {
            const LAS bf16* sc = SH + (c & 1) * 2 * IMG;
#pragma unroll
            for (int r = 0; r < 4; ++r) { const int it_ = q + 128 * r, i_ = it_ >> 3, j8 = it_ & 7;
                const v4u vh = *(const LAS v4u*)(sc + i_ * LP + 8 * j8), vl = *(const LAS v4u*)(sc + IMG + i_ * LP + 8 * j8);
                float* dst = SST + cbase + (size_t)c * 16384 + (size_t)i_ * 64 + 8 * j8;
                *(f32x4*)dst = (f32x4){bflo(vh.x) + bflo(vl.x), bfhi(vh.x) + bfhi(vl.x), bflo(vh.y) + bflo(vl.y), bfhi(vh.y) + bfhi(vl.y)};
                *(f32x4*)(dst + 4) = (f32x4){bflo(vh.z) + bflo(vl.z), bfhi(vh.z) + bfhi(vl.z), bflo(vh.w) + bflo(vl.w), bfhi(vh.w) + bfhi(vl.w)}; }
            asm volatile("s_waitcnt lgkmcnt(0)\n\ts_barrier" ::: "memory");
        }
    }
    __syncthreads();
}
__device__ __forceinline__ void p_rwkv_pass3(Frame& F, int l) {
    const float* RWB = (const float*)(F.ws() + WS_RW); const size_t TS = (size_t)M * 256;
    const float *R_ = RWB, *KP_ = RWB + TS, *VV_ = RWB + 2 * TS, *GG_ = RWB + 6 * TS;
    const float* Y0 = (const float*)(F.ws() + WS_Y0); const float* RT = (const float*)(F.ws() + WS_RT); const float* SST = (const float*)(F.ws() + WS_SST);
    bf16* YMIX = (bf16*)(F.ws() + WS_YMIX);
    const float* r_k = F.in(16) + (size_t)l * 256; const float* gng = F.in(17) + (size_t)l * 256; const float* gnb = F.in(18) + (size_t)l * 256;
    const int h = F.wave >> 1, half = F.wave & 1, i = F.lane, ch = h * 64 + i;
    const float rk = r_k[ch], gg = gng[ch], gb = gnb[ch];
    for (int un = F.bid; un < NB * NCH; un += F.G) {
        const float* srow = SST + ((size_t)un * 4 + h) * 4096 + (size_t)i * 64;
        float s[64];
#pragma unroll
        for (int j = 0; j < 64; j += 4) { const f32x4 t = *(const f32x4*)(srow + j); s[j] = t[0]; s[j + 1] = t[1]; s[j + 2] = t[2]; s[j + 3] = t[3]; }
        for (int tt = 0; tt < RWC / 2; ++tt) {
            const int tok = un * RWC + half * (RWC / 2) + tt; const size_t o = (size_t)tok * 256 + ch;
            const float* rt = RT + (size_t)tok * 256 + h * 64;
            float y0 = Y0[o], y1 = 0.f;
#pragma unroll
            for (int j = 0; j < 64; j += 4) { const f32x4 t = *(const f32x4*)(rt + j); y0 += s[j] * t[0] + s[j + 2] * t[2]; y1 += s[j + 1] * t[1] + s[j + 3] * t[3]; if ((j & 28) == 28) __builtin_amdgcn_sched_barrier(0); }
            const float y = y0 + y1;
            const float mu = wave_sum(y) * (1.f / 64.f); const float d = y - mu; const float var = wave_sum(d * d) * (1.f / 64.f);
            const float yn = d * (1.f / sqrtf(var + 64e-5f)) * gg + gb;
            const float rv = R_[o], kv = KP_[o], vv = VV_[o], gt = GG_[o];
            const float dot = wave_sum(rv * kv * rk);
            const float out = (yn + dot * vv) * gt;
            YMIX[(size_t)tok * DM + 256 + ch] = (bf16)f2bf(out);
        }
    }
}

__device__ __forceinline__ void p_gmlp_unit_valu(Frame& F, int l, int un) {
    const bf16* Z = (const bf16*)(F.ws() + WS_Z); bf16* YMIX = (bf16*)(F.ws() + WS_YMIX);
    const float* Ws = F.in(6) + (size_t)l * 4 * 128 * 128; const float* bs = F.in(7) + (size_t)l * 4 * 128;
    LAS float* WT = (LAS float*)F.lds;
    LAS bf16* Vs = (LAS bf16*)(F.lds + 65536);
    const int t = F.tid & 127, cq = F.tid >> 7;
    const int tok0 = un * 128;
    for (int g = 0; g < 4; ++g) {
        __syncthreads();
        for (int idx = F.tid; idx < 128 * 128; idx += NTHR) { const int tt = idx >> 7, ss = idx & 127; WT[ss * 128 + tt] = Ws[(size_t)g * 16384 + idx]; }
        for (int idx = F.tid; idx < 128 * 8; idx += NTHR) { const int ss = idx >> 3, c8 = idx & 7; *(LAS v4u*)(Vs + ss * 64 + c8 * 8) = *(const v4u*)(Z + (size_t)(tok0 + ss) * ZW + ZC_V + g * 64 + c8 * 8); }
        __syncthreads();
        float acc[16];
#pragma unroll
        for (int q = 0; q < 16; ++q) acc[q] = 0.f;
        const int smax = (t | 63);
        for (int s = 0; s <= smax; ++s) {
            const float w = (s <= t) ? WT[s * 128 + t] : 0.f;
            const v4u a = *(const LAS v4u*)(Vs + s * 64 + cq * 16), b = *(const LAS v4u*)(Vs + s * 64 + cq * 16 + 8);
            acc[0] += w * bflo(a.x); acc[1] += w * bfhi(a.x); acc[2] += w * bflo(a.y); acc[3] += w * bfhi(a.y); acc[4] += w * bflo(a.z); acc[5] += w * bfhi(a.z); acc[6] += w * bflo(a.w); acc[7] += w * bfhi(a.w);
            acc[8] += w * bflo(b.x); acc[9] += w * bfhi(b.x); acc[10] += w * bflo(b.y); acc[11] += w * bfhi(b.y); acc[12] += w * bflo(b.z); acc[13] += w * bfhi(b.z); acc[14] += w * bflo(b.w); acc[15] += w * bfhi(b.w);
        }
        const float bb = bs[g * 128 + t];
        const bf16* up = Z + (size_t)(tok0 + t) * ZW + ZC_U + g * 64 + cq * 16; const v4u u0 = *(const v4u*)up, u1 = *(const v4u*)(up + 8);
        v4u o0, o1;
        o0.x = pk2(bflo(u0.x) * (acc[0] + bb), bfhi(u0.x) * (acc[1] + bb)); o0.y = pk2(bflo(u0.y) * (acc[2] + bb), bfhi(u0.y) * (acc[3] + bb));
        o0.z = pk2(bflo(u0.z) * (acc[4] + bb), bfhi(u0.z) * (acc[5] + bb)); o0.w = pk2(bflo(u0.w) * (acc[6] + bb), bfhi(u0.w) * (acc[7] + bb));
        o1.x = pk2(bflo(u1.x) * (acc[8] + bb), bfhi(u1.x) * (acc[9] + bb)); o1.y = pk2(bflo(u1.y) * (acc[10] + bb), bfhi(u1.y) * (acc[11] + bb));
        o1.z = pk2(bflo(u1.z) * (acc[12] + bb), bfhi(u1.z) * (acc[13] + bb)); o1.w = pk2(bflo(u1.w) * (acc[14] + bb), bfhi(u1.w) * (acc[15] + bb));
        bf16* op = YMIX + (size_t)(tok0 + t) * DM + g * 64 + cq * 16; *(v4u*)op = o0; *(v4u*)(op + 8) = o1;
    }
    __syncthreads();
}

__device__ __forceinline__ void p_gmlp_unit(Frame& F, int l, int un) {
    typedef float f32x16 __attribute__((ext_vector_type(16)));
    typedef short bf16x8_t __attribute__((ext_vector_type(8)));
    const bf16* Z = (const bf16*)(F.ws() + WS_Z); bf16* YMIX = (bf16*)(F.ws() + WS_YMIX);
    const float* Ws = F.in(6) + (size_t)l * 4 * 128 * 128; const float* bs = F.in(7) + (size_t)l * 4 * 128;
    constexpr int LV = 136;
    LAS bf16* Vt = (LAS bf16*)F.lds;
    const int tid = F.tid, lane = F.lane, w = F.wave, l31 = lane & 31, hi = lane >> 5, mt = w >> 1, nt = w & 1;
    const int tok0 = un * 128;
    __syncthreads();
#pragma unroll
    for (int it = 0; it < 8; ++it) { const int s = (tid & 63) + 64 * (it & 1), c8 = (tid >> 6) + 8 * (it >> 1);
        const v4u v = *(const v4u*)(Z + (size_t)(tok0 + s) * ZW + ZC_V + c8 * 8); LAS bf16* d = Vt + (c8 * 8) * LV + s;
        d[0] = (bf16)(v.x & 0xffffu); d[LV] = (bf16)(v.x >> 16); d[2 * LV] = (bf16)(v.y & 0xffffu); d[3 * LV] = (bf16)(v.y >> 16);
        d[4 * LV] = (bf16)(v.z & 0xffffu); d[5 * LV] = (bf16)(v.z >> 16); d[6 * LV] = (bf16)(v.w & 0xffffu); d[7 * LV] = (bf16)(v.w >> 16); }
    __syncthreads();
    const int trow = 32 * mt + l31;
#pragma unroll 1
    for (int g = 0; g < 4; ++g) {
        f32x16 acc;
#pragma unroll
        for (int r = 0; r < 16; ++r) acc[r] = 0.f;
        const float* wrow = Ws + (size_t)g * 16384 + (size_t)trow * 128 + 8 * hi;
        const LAS bf16* bp = Vt + (g * 64 + 32 * nt + l31) * LV + 8 * hi;
        const int nks = 2 * (mt + 1);
#pragma unroll 2
        for (int ks = 0; ks < nks; ++ks) {
            const f32x4 a0 = *(const f32x4*)(wrow + 16 * ks), a1 = *(const f32x4*)(wrow + 16 * ks + 4);
            const int s0 = 16 * ks + 8 * hi;
            v4u ap; ap.x = pk2(s0 + 0 <= trow ? a0[0] : 0.f, s0 + 1 <= trow ? a0[1] : 0.f); ap.y = pk2(s0 + 2 <= trow ? a0[2] : 0.f, s0 + 3 <= trow ? a0[3] : 0.f);
            ap.z = pk2(s0 + 4 <= trow ? a1[0] : 0.f, s0 + 5 <= trow ? a1[1] : 0.f); ap.w = pk2(s0 + 6 <= trow ? a1[2] : 0.f, s0 + 7 <= trow ? a1[3] : 0.f);
            const bf16x8_t bfr = *(const LAS bf16x8_t*)(bp + 16 * ks);
            acc = __builtin_amdgcn_mfma_f32_32x32x16_bf16(__builtin_bit_cast(bf16x8_t, ap), bfr, acc, 0, 0, 0);
        }
        const int c = g * 64 + 32 * nt + l31;
#pragma unroll
        for (int r = 0; r < 16; ++r) { const int t = 32 * mt + (r & 3) + 8 * (r >> 2) + 4 * hi; const size_t tok = (size_t)(tok0 + t);
            const float u = bf2f(Z[tok * ZW + ZC_U + c]); YMIX[tok * DM + c] = (bf16)f2bf(u * (acc[r] + bs[g * 128 + t])); }
    }
    __syncthreads();
}

__device__ __forceinline__ void p_attn_unit_naive(Frame& F, int bh, int qb) {
    const bf16* Z = (const bf16*)(F.ws() + WS_Z); const float* LOGF = (const float*)(F.ws() + WS_LOGF); bf16* YMIX = (bf16*)(F.ws() + WS_YMIX);
    LAS float* Ks = (LAS float*)F.lds;
    LAS float* Vs = (LAS float*)(F.lds + 16384);
    LAS float* CUM = (LAS float*)(F.lds + 32768);
    LAS float* WT = (LAS float*)(F.lds + 49152);
    const int b = bh / NHF, h = bh % NHF, q0 = qb * 256, tid = F.tid, r = tid >> 1, dh = (tid & 1) * 32;
    const int nkeys = q0 + 256;
    const size_t tokb = (size_t)b * NT;
    __syncthreads();
    { float v[8]; float run = 0.f;
#pragma unroll
      for (int e = 0; e < 8; ++e) { const int t = tid * 8 + e; v[e] = t < nkeys ? LOGF[(tokb + t) * 8 + h] : 0.f; run += v[e]; v[e] = run; }
      float inc = run;
#pragma unroll
      for (int o = 1; o < 64; o <<= 1) { const float n = __shfl_up(inc, o); if (F.lane >= o) inc += n; }
      if (F.lane == 63) WT[F.wave] = inc;
      __syncthreads();
      float off = inc - run;
      for (int w = 0; w < F.wave; ++w) off += WT[w];
#pragma unroll
      for (int e = 0; e < 8; ++e) { const int t = tid * 8 + e; if (t < nkeys) CUM[t] = off + v[e]; }
    }
    __syncthreads();
    const int tq = q0 + r;
    float qv[32];
    { const bf16* qp = Z + (tokb + tq) * ZW + ZC_Q + h * 64 + dh;
#pragma unroll
      for (int d = 0; d < 32; d += 8) { const v4u w = *(const v4u*)(qp + d); qv[d] = bflo(w.x); qv[d + 1] = bfhi(w.x); qv[d + 2] = bflo(w.y); qv[d + 3] = bfhi(w.y); qv[d + 4] = bflo(w.z); qv[d + 5] = bfhi(w.z); qv[d + 6] = bflo(w.w); qv[d + 7] = bfhi(w.w); } }
    const float cq = CUM[tq];
    float mrun = -INFINITY, lrun = 0.f; float o[32];
#pragma unroll
    for (int d = 0; d < 32; ++d) o[d] = 0.f;
    for (int kt = 0; kt < nkeys / 64; ++kt) {
        __syncthreads();
        { const int kr = tid >> 3, c8 = (tid & 7) * 8; const bf16* kp = Z + (tokb + kt * 64 + kr) * ZW + h * 64 + c8;
          const v4u kw = *(const v4u*)(kp + ZC_KF), vw = *(const v4u*)(kp + ZC_VF);
          *(LAS f32x4*)(Ks + kr * 64 + c8) = (f32x4){bflo(kw.x), bfhi(kw.x), bflo(kw.y), bfhi(kw.y)}; *(LAS f32x4*)(Ks + kr * 64 + c8 + 4) = (f32x4){bflo(kw.z), bfhi(kw.z), bflo(kw.w), bfhi(kw.w)};
          *(LAS f32x4*)(Vs + kr * 64 + c8) = (f32x4){bflo(vw.x), bfhi(vw.x), bflo(vw.y), bfhi(vw.y)}; *(LAS f32x4*)(Vs + kr * 64 + c8 + 4) = (f32x4){bflo(vw.z), bfhi(vw.z), bflo(vw.w), bfhi(vw.w)}; }
        __syncthreads();
        const int klim = min(64, q0 + 256 - kt * 64);
#pragma unroll 1
        for (int kl = 0; kl < klim; ++kl) {
            const LAS float* kr = Ks + kl * 64 + dh; float a0 = 0.f, a1 = 0.f;
#pragma unroll
            for (int d = 0; d < 32; d += 4) { const f32x4 k4 = *(const LAS f32x4*)(kr + d); a0 += qv[d] * k4[0] + qv[d + 2] * k4[2]; a1 += qv[d + 1] * k4[1] + qv[d + 3] * k4[3]; }
            float part = a0 + a1; part += __shfl_xor(part, 1);
            const int key = kt * 64 + kl; float sv = part + cq - CUM[key];
            if (key <= tq) {
                if (sv > mrun) { const float scale = exp2f(mrun - sv); lrun *= scale;
#pragma unroll
                    for (int d = 0; d < 32; ++d) o[d] *= scale;
                    mrun = sv; }
                const float p = exp2f(sv - mrun); lrun += p; const LAS float* vr = Vs + kl * 64 + dh;
#pragma unroll
                for (int d = 0; d < 32; d += 4) { const f32x4 v4 = *(const LAS f32x4*)(vr + d); o[d] += p * v4[0]; o[d + 1] += p * v4[1]; o[d + 2] += p * v4[2]; o[d + 3] += p * v4[3]; }
            }
        }
    }
    { const float inv = 1.f / lrun; bf16* op = YMIX + (tokb + tq) * DM + 512 + h * 64 + dh;
#pragma unroll
      for (int d = 0; d < 32; d += 8) { v4u w; w.x = pk2(o[d] * inv, o[d + 1] * inv); w.y = pk2(o[d + 2] * inv, o[d + 3] * inv); w.z = pk2(o[d + 4] * inv, o[d + 5] * inv); w.w = pk2(o[d + 6] * inv, o[d + 7] * inv); *(v4u*)(op + d) = w; } }
    __syncthreads();
}

#ifndef ATTN_NAIVE
#define ATTN_NAIVE 0
#endif
__device__ __forceinline__ void p_attn_unit(Frame& F, int l, int bh, int qb) {
#if ATTN_NAIVE
    p_attn_unit_naive(F, bh, qb);
#else
    const fox::bf16* Zb = (const fox::bf16*)(F.ws() + WS_Z);
    float gq = fabsf(F.in(20)[(size_t)l * 64 + F.lane]), gk = fabsf(F.in(21)[(size_t)l * 64 + F.lane]);
#pragma unroll
    for (int o = 1; o < 64; o <<= 1) { gq = fmaxf(gq, __shfl_xor(gq, o)); gk = fmaxf(gk, __shfl_xor(gk, o)); }
    const float skip_thr = 44.f + 2.f * (64.f * gq * gk * QSCALE * 1.02f);
    fox::attn_unit<20>(bh / NHF, bh % NHF, qb, Zb + ZC_Q, Zb + ZC_KF, Zb + ZC_VF, (fox::bf16*)(F.ws() + WS_YMIX) + 512, (const float*)(F.ws() + WS_LOGF), (char*)F.lds, F.tid, skip_thr);
#endif
}

__device__ __forceinline__ void p_route(Frame& F, int l, int lcur) {
    typedef short bf16x8_t __attribute__((ext_vector_type(8)));
    const float* x = F.out(); const float* modl = (const float*)(F.ws() + WS_MOD) + (size_t)l * NB * 6144;
    bf16* XN = (bf16*)(F.ws() + WS_XN);
    const bf16* wth = (const bf16*)(F.ws() + WS_WRT) + (size_t)l * 2 * NE * DM; const bf16* wtl = wth + NE * DM;
    const float* br = F.in(25) + (size_t)l * NE;
    unsigned* cur = (unsigned*)(F.ws() + WS_CTL) + CW_CUR + lcur * NE * 64;
    int* ROWTOK = (int*)(F.ws() + (lcur == l ? WS_ROWTOK : WS_XS)); int* TOKPOS = (int*)(F.ws() + WS_TOKPOS); float* TOKW = (float*)(F.ws() + WS_TOKW);
    constexpr int WP = 1032;
    LAS bf16* wlds = (LAS bf16*)F.lds;
    LAS float* lg = (LAS float*)(F.lds + 2 * NE * WP * 2 + F.wave * 1152);
    const int lane = F.lane, t = lane & 15, quad = lane >> 4;
    __syncthreads();
    for (int ch = F.tid; ch < 2 * NE * 128; ch += NTHR) { const int rw_ = ch >> 7, c8 = ch & 127; *(LAS v4u*)(wlds + rw_ * WP + c8 * 8) = *(const v4u*)(wth + (size_t)rw_ * DM + c8 * 8); }
    __syncthreads();
    for (int grp = F.gw; grp < M / 16; grp += F.ngw) {
        const int row = grp * 16 + t; const float* xr = x + (size_t)row * DM + 8 * quad;
        const float* mb = modl + (size_t)(row / NT) * 6144 + 8 * quad;
        float ss;
        { const f32x4* sp = (const f32x4*)((const float*)(F.ws() + WS_SSP) + (size_t)row * 16); const f32x4 p0 = sp[0], p1 = sp[1], p2 = sp[2], p3 = sp[3];
          ss = (((p0[0] + p0[1]) + (p0[2] + p0[3])) + ((p1[0] + p1[1]) + (p1[2] + p1[3]))) + (((p2[0] + p2[1]) + (p2[2] + p2[3])) + ((p3[0] + p3[1]) + (p3[2] + p3[3]))); }
        const float rs = 1.f / sqrtf(ss * (1.f / DM) + 1e-6f);
        f32x4 acc0 = {0.f, 0.f, 0.f, 0.f}, acc1 = acc0;
        const LAS bf16* wh0 = wlds + t * WP + 8 * quad; const LAS bf16* wl0 = wlds + (NE + t) * WP + 8 * quad;
#pragma unroll 2
        for (int ks = 0; ks < 32; ++ks) {
            const f32x4 a = *(const f32x4*)(xr + 32 * ks), b = *(const f32x4*)(xr + 32 * ks + 4);
            const f32x4 sh0 = *(const f32x4*)(mb + 3072 + 32 * ks), sh1 = *(const f32x4*)(mb + 3072 + 32 * ks + 4), sc0 = *(const f32x4*)(mb + 4096 + 32 * ks), sc1 = *(const f32x4*)(mb + 4096 + 32 * ks + 4);
            const f32x4 h0 = a * rs * (sc0 + 1.f) + sh0, h1 = b * rs * (sc1 + 1.f) + sh1;
            v4u hi, lo;
            hi.x = pk2(h0[0], h0[1]); hi.y = pk2(h0[2], h0[3]); hi.z = pk2(h1[0], h1[1]); hi.w = pk2(h1[2], h1[3]);
            lo.x = pk2(h0[0] - bflo(hi.x), h0[1] - bfhi(hi.x)); lo.y = pk2(h0[2] - bflo(hi.y), h0[3] - bfhi(hi.y)); lo.z = pk2(h1[0] - bflo(hi.z), h1[1] - bfhi(hi.z)); lo.w = pk2(h1[2] - bflo(hi.w), h1[3] - bfhi(hi.w));
            *(v4u*)(XN + (size_t)row * DM + 32 * ks + 8 * quad) = hi;
            const bf16x8_t ah = __builtin_bit_cast(bf16x8_t, hi), al = __builtin_bit_cast(bf16x8_t, lo);
            const bf16x8_t bh0 = *(const LAS bf16x8_t*)(wh0 + 32 * ks), bh1 = *(const LAS bf16x8_t*)(wh0 + 16 * WP + 32 * ks), bl0 = *(const LAS bf16x8_t*)(wl0 + 32 * ks), bl1 = *(const LAS bf16x8_t*)(wl0 + 16 * WP + 32 * ks);
            acc0 = __builtin_amdgcn_mfma_f32_16x16x32_bf16(ah, bh0, acc0, 0, 0, 0); acc1 = __builtin_amdgcn_mfma_f32_16x16x32_bf16(ah, bh1, acc1, 0, 0, 0);
            acc0 = __builtin_amdgcn_mfma_f32_16x16x32_bf16(ah, bl0, acc0, 0, 0, 0); acc1 = __builtin_amdgcn_mfma_f32_16x16x32_bf16(ah, bl1, acc1, 0, 0, 0);
            acc0 = __builtin_amdgcn_mfma_f32_16x16x32_bf16(al, bh0, acc0, 0, 0, 0); acc1 = __builtin_amdgcn_mfma_f32_16x16x32_bf16(al, bh1, acc1, 0, 0, 0);
        }
        const float b0 = br[t], b1 = br[16 + t];
#pragma unroll 1
        for (int half = 0; half < 2; ++half) {
            if ((quad >> 1) == half) {
#pragma unroll
                for (int i = 0; i < 4; ++i) { lg[((4 * quad + i) & 7) * 36 + t] = acc0[i] + b0; lg[((4 * quad + i) & 7) * 36 + 16 + t] = acc1[i] + b1; } }
            LDS_WAIT(); asm volatile("" ::: "memory");
            if (lane < 16 && (lane >> 3) == half) {
                float v[32];
#pragma unroll
                for (int q = 0; q < 8; ++q) { const f32x4 t4 = *(const LAS f32x4*)(lg + (lane & 7) * 36 + 4 * q); v[4 * q] = t4[0]; v[4 * q + 1] = t4[1]; v[4 * q + 2] = t4[2]; v[4 * q + 3] = t4[3]; }
                float tv[4]; int ti[4];
#pragma unroll
                for (int k = 0; k < 4; ++k) { float bv = -INFINITY; int bi = 0;
#pragma unroll
                    for (int e = 0; e < 32; ++e) { const bool taken = (k > 0 && ti[0] == e) || (k > 1 && ti[1] == e) || (k > 2 && ti[2] == e); if (!taken && v[e] > bv) { bv = v[e]; bi = e; } }
                    tv[k] = bv; ti[k] = bi; }
                const float e1 = __expf(tv[1] - tv[0]), e2 = __expf(tv[2] - tv[0]), e3 = __expf(tv[3] - tv[0]); const float inv = 1.f / (1.f + e1 + e2 + e3);
                const float gt[4] = {inv, e1 * inv, e2 * inv, e3 * inv};
                const int tok = grp * 16 + lane;
#pragma unroll
                for (int k = 0; k < 4; ++k) { const int e = ti[k];
                    const unsigned slot = __hip_atomic_fetch_add(cur + e * 64, 1u, __ATOMIC_RELAXED, __HIP_MEMORY_SCOPE_AGENT);
                    ROWTOK[e * M + slot] = tok; TOKPOS[tok * 4 + k] = e * M + (int)slot; TOKW[tok * 4 + k] = gt[k]; }
            }
            LDS_WAIT(); asm volatile("" ::: "memory");
        }
    }
    __syncthreads();
}
__device__ __forceinline__ void p_convert_router(Frame& F) {
    const float* w = F.in(24); bf16* wt = (bf16*)(F.ws() + WS_WRT);
    for (int idx = F.bid * NTHR + F.tid; idx < NL * NE * DM; idx += F.G * NTHR) {
        const int l = idx / (NE * DM), e = (idx / DM) % NE, c = idx % DM;
        const float v = w[((size_t)l * DM + c) * NE + e]; const unsigned hi = f2bf(v); const unsigned lo = f2bf(v - __builtin_bit_cast(float, hi << 16));
        wt[((size_t)(l * 2 + 0) * NE + e) * DM + c] = (bf16)hi; wt[((size_t)(l * 2 + 1) * NE + e) * DM + c] = (bf16)lo;
    }
}
__device__ __forceinline__ void moe_table(Frame& F, int l) {
    LAS int* tb = (LAS int*)(F.lds + LDSCTL_OFF + 64); LAS int* cnt = (LAS int*)(F.lds + LDSCTL_OFF + 256);
    unsigned* cur = (unsigned*)(F.ws() + WS_CTL) + CW_CUR + l * NE * 64;
    __syncthreads();
    if (F.tid < NE) cnt[F.tid] = (int)__hip_atomic_load(cur + F.tid * 64, __ATOMIC_RELAXED, __HIP_MEMORY_SCOPE_AGENT);
    __syncthreads();
    if (F.tid == 0) { int a = 0; for (int e = 0; e < NE; ++e) { tb[e] = a; a += (cnt[e] + 255) >> 8; } tb[NE] = a; }
    __syncthreads();
}
__device__ __forceinline__ void p_gather(Frame& F) {
    const LAS int* tb = (const LAS int*)(F.lds + LDSCTL_OFF + 64); const LAS int* cnt = (const LAS int*)(F.lds + LDSCTL_OFF + 256);
    const bf16* XN = (const bf16*)(F.ws() + WS_XN); bf16* XS = (bf16*)(F.ws() + WS_XS); const int* ROWTOK = (const int*)(F.ws() + WS_ROWTOK);
    const int nrows = tb[NE] * 256;
    for (int R = F.gw; R < nrows; R += F.ngw) {
        const int tg = R >> 8; int e = 0;
#pragma unroll
        for (int k = 1; k < NE; ++k) e += (tb[k] <= tg) ? 1 : 0;
        const int rr = R - tb[e] * 256;
        v4u a = {0u, 0u, 0u, 0u}, b = a;
        if (rr < cnt[e]) { const int tok = ROWTOK[e * M + rr]; const v4u* src = (const v4u*)(XN + (size_t)tok * DM); a = src[F.lane]; b = src[64 + F.lane]; }
        v4u* dst = (v4u*)(XS + (size_t)R * DM); dst[F.lane] = a; dst[64 + F.lane] = b;
    }
}
__device__ __forceinline__ void p_combine(Frame& F, int l, bool dummy) {
    const LAS int* tb = (const LAS int*)(F.lds + LDSCTL_OFF + 64);
    float* x = F.out(); float* xd = dummy ? (float*)(F.ws() + WS_MRG) : x; const float* MOD = (const float*)(F.ws() + WS_MOD); const float* modl = MOD + (size_t)l * NB * 6144;
    const bf16* YS = (const bf16*)(F.ws() + WS_YS); const int* TOKPOS = (const int*)(F.ws() + WS_TOKPOS); const float* TOKW = (const float*)(F.ws() + WS_TOKW);
    bf16* XN = (bf16*)(F.ws() + (dummy ? WS_MERGED : WS_XN));
    const int lane = F.lane;
    for (int row = F.gw; row < M; row += F.ngw) {
        const float* mb = modl + (size_t)(row / NT) * 6144;
        f32x4 acc[4];
#pragma unroll
        for (int j = 0; j < 4; ++j) acc[j] = (f32x4){0.f, 0.f, 0.f, 0.f};
#pragma unroll
        for (int k = 0; k < 4; ++k) { const int pos = TOKPOS[row * 4 + k]; const float w = TOKW[row * 4 + k]; const int e = pos / M, slot = pos % M;
            const bf16* yr = YS + (size_t)(tb[e] * 256 + slot) * DM;
#pragma unroll
            for (int j = 0; j < 4; ++j) { float t[4]; ld4bf(yr + 4 * lane + 256 * j, t); acc[j] += w * (f32x4){t[0], t[1], t[2], t[3]}; } }
        f32x4 v[4]; float s = 0.f;
#pragma unroll
        for (int j = 0; j < 4; ++j) { const int c = 4 * lane + 256 * j; f32x4* xp = (f32x4*)(x + (size_t)row * DM + c); const f32x4 g2 = *(const f32x4*)(mb + 5120 + c);
            v[j] = *xp + g2 * acc[j]; *(f32x4*)(xd + (size_t)row * DM + c) = v[j]; s += (v[j][0] * v[j][0] + v[j][1] * v[j][1]) + (v[j][2] * v[j][2] + v[j][3] * v[j][3]); }
        if (l + 1 < NL) { const float rs = 1.f / sqrtf(wave_sum(s) * (1.f / DM) + 1e-6f); const float* mn = MOD + ((size_t)(l + 1) * NB + row / NT) * 6144;
            norm_row_store(v, rs, mn + 0, mn + 1024, XN + (size_t)row * DM, lane); }
    }
}

__global__ void __launch_bounds__(NTHR, 2) fwd(Params P) {
    extern __shared__ __attribute__((aligned(16))) unsigned char lds[];
    Frame F;
    F.lds = (LAS unsigned char*)lds; F.ka = (kptr_t)__builtin_amdgcn_kernarg_segment_ptr();
    F.tid = threadIdx.x; F.lane = F.tid & 63; F.wave = __builtin_amdgcn_readfirstlane(F.tid >> 6);
    F.G = gridDim.x; F.bid = blockIdx.x; F.gw = blockIdx.x * NWAVES + F.wave; F.ngw = F.G * NWAVES;
    for (int u = F.tid; u < (LDS_BYTES - LDSCTL_OFF) / 4; u += NTHR) ((LAS unsigned*)(F.lds + LDSCTL_OFF))[u] = 0u;
    __syncthreads();
    XcdBarrier bar = xcd_barrier_post((unsigned*)(F.ws() + WS_CTL) + CW_BAR, (volatile LAS unsigned*)(F.lds + LDSCTL_OFF));
#define GRID_BAR() do { PHASE_BEGIN(); xcd_barrier(bar, (unsigned*)(F.ws() + WS_CTL) + CW_BAR); } while (0)
#ifndef PH_MASK
#define PH_MASK 0xFFFFFFFFu
#endif
#define PH(k) if constexpr ((PH_MASK >> (k)) & 1u)
#ifndef REP_MASK
#define REP_MASK 0u
#endif
#define REP(k) for (int _r = 0; _r < ((((REP_MASK) >> (k)) & 1u) ? 2 : 1); ++_r)
#define PHASE_BEGIN() do { kptr_t _k = (kptr_t)__builtin_amdgcn_kernarg_segment_ptr(); int _t = threadIdx.x, _b = blockIdx.x, _g = gridDim.x; asm volatile("" : "+s"(_k), "+v"(_t), "+s"(_b), "+s"(_g)); \
    F.ka = _k; F.tid = _t; F.lane = _t & 63; F.wave = __builtin_amdgcn_readfirstlane(_t >> 6); F.bid = _b; F.G = _g; F.gw = _b * NWAVES + F.wave; F.ngw = _g * NWAVES; } while (0)

    PHASE_BEGIN();
    REP(0) PH(0) { p_convert(F); p_convert_router(F); }
    __syncthreads();
    PHASE_BEGIN();
    PH(1) p_mod(F);
    GRID_BAR();
    PHASE_BEGIN();
    PH(2) p_norm_rows(F, F.in(0), (const float*)(F.ws() + WS_MOD), 0, 1024);
    GRID_BAR();

#define LAYER_BODY(l) do { \
 \
        PHASE_BEGIN(); \
        REP(3) PH(3) { pg8::Gemm g{(const bf16*)(F.ws() + WS_XN), (const bf16*)(F.ws() + WS_WIN) + (size_t)l * ZW * DM, DM, DM, DM}; pg8::StaticOrder S; S.init(M, ZW, F.G, F.bid); \
          EpiZ E; E.Z = (bf16*)(F.ws() + WS_Z); E.FL = (float*)(F.ws() + WS_FLOGIT); \
          pg8::gemm_phase<EpiZ, pg8::StaticOrder, true>(F.lds, g, S, E, F.tid); } \
        GRID_BAR(); \
 \
        PHASE_BEGIN(); \
        static_assert(2 * RWC == 64 && (M / 64) == NB * NCH / 2, "prep + pass 1 share the unit: 64 consecutive tokens"); \
        PH(4) for (int un = F.bid; un < M / 64; un += F.G) { \
            p_prep(F, l, false, 16 * un + F.wave, 8, 16 * un + 16); \
            VM_WAIT(); \
            PH(5) p_rwkv_pass1(F, un, 1, un + 1); \
            __syncthreads(); } \
        GRID_BAR(); \
 \
        PHASE_BEGIN(); \
        REP(6) PH(6) { const int nrw = NB * NHR; \
          if (F.bid >= F.G - nrw) { REP(15) PH(15) p_rwkv_pass2(F, F.G - nrw); } \
          else { const int nw = F.G - nrw, me = F.bid; \
 \
              PH(16) { unsigned* qh = (unsigned*)(F.ws() + WS_CTL) + CW_ATT + 64 * l; LAS int* qs = (LAS int*)(F.lds + LDSCTL_OFF + 512); \
                for (;;) { __syncthreads(); if (F.tid == 0) qs[0] = (int)__hip_atomic_fetch_add(qh, 1u, __ATOMIC_RELAXED, __HIP_MEMORY_SCOPE_AGENT); __syncthreads(); \
                    const int idx = __builtin_amdgcn_readfirstlane(qs[0]); if (idx >= 512 + M / 128) break; \
                    if (idx < 512) p_attn_unit(F, l, idx & 31, 15 - (idx >> 5)); else { PHASE_BEGIN(); p_gmlp_unit(F, l, idx - 512); } } } } } \
        GRID_BAR(); \
 \
        PHASE_BEGIN(); \
        REP(7) PH(7) p_rwkv_pass3(F, l); \
        GRID_BAR(); \
 \
        PHASE_BEGIN(); \
        REP(8) PH(8) { pg8::Gemm g{(const bf16*)(F.ws() + WS_YMIX), (const bf16*)(F.ws() + WS_WBR) + (size_t)l * DM * DM, DM, DM, DM}; pg8::StaticOrder S; S.init(M, DM, F.G, F.bid); \
          EpiMerge2 E; E.Z = (const bf16*)(F.ws() + WS_Z); E.MERGED = (bf16*)(F.ws() + WS_MERGED); \
          pg8::gemm_phase<EpiMerge2, pg8::StaticOrder, false>(F.lds, g, S, E, F.tid); } \
        GRID_BAR(); \
 \
        PHASE_BEGIN(); \
        PH(9) { pg8::Gemm g{(const bf16*)(F.ws() + WS_MERGED), (const bf16*)(F.ws() + WS_WO) + (size_t)l * DM * DM, DM, DM, DM}; pg8::StaticOrder S; S.init(M, DM, F.G, F.bid); \
          EpiWo E; E.xin = (l == 0) ? F.in(0) : F.out(); E.xout = F.out(); E.gate = (const float*)(F.ws() + WS_MOD) + (size_t)l * NB * 6144 + 2048; E.SSP = (float*)(F.ws() + WS_SSP); \
          pg8::gemm_phase<EpiWo, pg8::StaticOrder, false>(F.lds, g, S, E, F.tid); } \
        GRID_BAR(); \
 \
        PHASE_BEGIN(); \
        if constexpr ((REP_MASK >> 10) & 1u) { p_route(F, l, l + 4); __syncthreads(); } \
        PH(10) p_route(F, l, l); \
        GRID_BAR(); \
 \
        PHASE_BEGIN(); \
        moe_table(F, l); \
        REP(12) PH(12) { pg8::Gemm g{(const bf16*)(F.ws() + WS_XN), (const bf16*)(F.ws() + WS_WGU) + (size_t)l * NE * 2048 * DM, DM, DM, DM}; \
          pg8::GroupedOrder S; S.tb = (const LAS int*)(F.lds + LDSCTL_OFF + 64); S.nct = 8; S.G = F.G; S.c = F.bid; \
          EpiMoe1 E; E.bgu = F.in(27) + (size_t)l * NE * 2048; E.ACT = (bf16*)(F.ws() + WS_ACT); E.ROWTOK = (const int*)(F.ws() + WS_ROWTOK); E.tb = S.tb; E.cnt = (const LAS int*)(F.lds + LDSCTL_OFF + 256); \
          pg8::gemm_phase<EpiMoe1, pg8::GroupedOrder, true>(F.lds, g, S, E, F.tid); } \
        GRID_BAR(); \
 \
        PHASE_BEGIN(); \
        REP(13) PH(13) { pg8::Gemm g{(const bf16*)(F.ws() + WS_ACT), (const bf16*)(F.ws() + WS_WD) + (size_t)l * NE * DM * DFF, DFF, DFF, DFF}; \
          pg8::GroupedOrder S; S.tb = (const LAS int*)(F.lds + LDSCTL_OFF + 64); S.nct = 4; S.G = F.G; S.c = F.bid; \
          EpiMoe2 E; E.bd = F.in(29) + (size_t)l * NE * DM; E.YS = (bf16*)(F.ws() + WS_YS); \
          pg8::gemm_phase<EpiMoe2, pg8::GroupedOrder, true>(F.lds, g, S, E, F.tid); } \
        GRID_BAR(); \
 \
        PHASE_BEGIN(); \
        if constexpr ((REP_MASK >> 14) & 1u) { p_combine(F, l, true); } \
        PH(14) p_combine(F, l, false); \
        GRID_BAR(); \
    } while (0)
    LAYER_BODY(0); LAYER_BODY(1); LAYER_BODY(2); LAYER_BODY(3);
#undef LAYER_BODY
}

extern "C" void kernel_launch(void* const* d_in, const int* in_sizes, int n_in, void* d_out, int out_size, void* d_ws, size_t ws_size, hipStream_t stream) {
    static int grid = 0;
    if (grid == 0) {
        if (n_in != 30 || out_size != M * DM || ws_size < WS_END) { fprintf(stderr, "kernel_launch: unexpected shapes (n_in %d, out %d, ws %zu)\n", n_in, out_size, ws_size); grid = -1; return; }
        int dev = 0, cus = 0, per_cu = 0;
        if (hipGetDevice(&dev) != hipSuccess || hipDeviceGetAttribute(&cus, hipDeviceAttributeMultiprocessorCount, dev) != hipSuccess) { grid = -1; return; }
        if (hipFuncSetAttribute((const void*)fwd, hipFuncAttributeMaxDynamicSharedMemorySize, LDS_BYTES) != hipSuccess) { fprintf(stderr, "kernel_launch: hipFuncSetAttribute failed\n"); grid = -1; return; }
        if (hipOccupancyMaxActiveBlocksPerMultiprocessor(&per_cu, (const void*)fwd, NTHR, LDS_BYTES) != hipSuccess || per_cu < 1) { fprintf(stderr, "kernel_launch: occupancy query says %d\n", per_cu); (void)hipGetLastError(); grid = -1; return; }
        grid = cus;
    }
    if (grid < 0) return;
    if (hipMemsetAsync((char*)d_ws + WS_CTL, 0, CTL_ZERO_BYTES, stream) != hipSuccess) return;
    Params p{};
    for (int i = 0; i < 30; ++i) p.in[i] = (const float*)d_in[i];
    p.out = (float*)d_out; p.ws = (unsigned char*)d_ws;
    hipLaunchKernelGGL(fwd, dim3(grid), dim3(NTHR), LDS_BYTES, stream, p);
}
```

```cpp
#define REP_MASK 0u
#define PROBE_TS 0
#include <hip/hip_runtime.h>
#include <hip/hip_bf16.h>
#include <cmath>
#include <cstdio>
#include <cstdint>

namespace pg8 {
#define PG8_LAS __attribute__((address_space(3)))
typedef unsigned short bf16_t;
typedef short bf16x8 __attribute__((ext_vector_type(8)));
typedef float f32x4 __attribute__((ext_vector_type(4)));
typedef unsigned u32x4 __attribute__((ext_vector_type(4)));
constexpr int BM = 256, BK = 64, HALF = 128, HTB = HALF * BK * 2, STAGE_BYTES = 8 * HTB, NXCD = 8, WGM = 8;

__host__ __device__ __forceinline__ int lds_byte(int r, int c) { const int st = (r >> 4) * 2 + (c >> 5), rr = r & 15, cc = c & 31, ob = rr * 64 + cc * 2; return st * 1024 + (ob ^ (((ob >> 9) & 1) << 5)); }
__host__ __device__ __forceinline__ void stage_rc(int b, int& R, int& C) { const int st = b / 1024, sb = b % 1024, swz = sb ^ (((sb >> 9) & 1) << 5); R = (st >> 1) * 16 + swz / 64; C = (st & 1) * 32 + (swz % 64) / 2; }
__host__ __device__ __forceinline__ int perm32(int rho) { const int n = rho >> 4, i = rho & 15; return 8 * (i >> 2) + 4 * n + (i & 3); }

struct Unit { int pm, pn; };
struct Gemm { const bf16_t* A; const bf16_t* Bt; int lda, ldb, K; };

struct StaticOrder {
    int nM, nN, nwg, G, c;
    __host__ __device__ void init(int M, int N, int G_, int c_) { nM = M / BM; nN = N / BM; nwg = nM * nN; G = G_; c = c_; }
    __host__ __device__ bool next(int i, Unit& u) const {
        const long L = (long)i * G + c; if (L >= nwg) return false;
        int wgid = (int)L; { const int q = nwg / NXCD, r = nwg % NXCD, xcd = wgid % NXCD, off = wgid / NXCD; wgid = (xcd < r ? xcd * (q + 1) : r * (q + 1) + (xcd - r) * q) + off; }
        const int nig = WGM * nN, gid = wgid / nig, fm = gid * WGM, gsz = (nM - fm) < WGM ? (nM - fm) : WGM;
        u.pm = fm + ((wgid % nig) % gsz); u.pn = (wgid % nig) / gsz; return true;
    }
};
template <int NSUB> struct SubOrder {
    StaticOrder S;
    __host__ __device__ void init(int M, int N, int G_, int c_) { S.init(M, N, G_, c_); }
    __host__ __device__ bool next(int i, Unit& u) const { Unit t; if (!S.next(i / NSUB, t)) return false; u.pm = t.pm; u.pn = t.pn * NSUB + (i % NSUB); return true; }
};
struct GroupedOrder {
    const PG8_LAS int* tb; int nct, G, c;
    __device__ __forceinline__ bool next(int i, Unit& u) const {
        const int T = tb[32], x = c & 7, r = c >> 3, per = G >> 3;
        const int t0 = (T * x) >> 3, t1 = (T * (x + 1)) >> 3;
        const int q = r + per * i; const int tl = q / nct, ct = q - tl * nct; const int tg = t0 + tl;
        if (tg >= t1) return false;
        int e = 0;
#pragma unroll
        for (int k = 1; k < 32; ++k) e += (tb[k] <= tg) ? 1 : 0;
        u.pm = __builtin_amdgcn_readfirstlane(tg); u.pn = __builtin_amdgcn_readfirstlane(e * nct + ct); return true;
    }
};

typedef float pk_f32x2_t __attribute__((ext_vector_type(2))); typedef __bf16 pk_bf16x2_t __attribute__((ext_vector_type(2)));
__device__ __forceinline__ unsigned cvt_pk_bf16(float lo, float hi) { pk_f32x2_t v = {lo, hi}; pk_bf16x2_t b = __builtin_convertvector(v, pk_bf16x2_t); return __builtin_bit_cast(unsigned, b); }

template <class Epi, class Sched, bool ALIGN_EPI>
__device__ __forceinline__ void gemm_phase(PG8_LAS unsigned char* lds, const Gemm g, const Sched& S, const Epi& E, const int tid) {
    const int wid = __builtin_amdgcn_readfirstlane(tid >> 6), lane = tid & 63, wr = wid >> 2, wc = wid & 3, fr = lane & 15, fq = lane >> 4;
    const int K = g.K, nt = K / BK;
    unsigned vA[2][2], nvA[2][2], voffB[2];
    int stR[2], stC[2];
#pragma unroll
    for (int i = 0; i < 2; ++i) { int R, C; stage_rc(tid * 16 + i * 8192, R, C); const int Rb = Epi::PERM ? ((R & ~31) + perm32(R & 31)) : R; stR[i] = R; stC[i] = C;
        vA[0][i] = (unsigned)(R * g.lda + C) * 2u; vA[1][i] = (unsigned)((R + HALF) * g.lda + C) * 2u; nvA[0][i] = vA[0][i]; nvA[1][i] = vA[1][i]; voffB[i] = (unsigned)(Rb * g.ldb + C) * 2u; }
#define PG8_GOFFS(dst, un) do { _Pragma("unroll") for (int h_ = 0; h_ < 2; ++h_) _Pragma("unroll") for (int i_ = 0; i_ < 2; ++i_) dst[h_][i_] = (unsigned)(E.row_src(un, stR[i_] + HALF * h_) * g.lda + stC[i_]) * 2u; } while (0)
#define PG8_ABASE(un) ((const char*)g.A + (Epi::GATHER ? (size_t)0 : (size_t)(un).pm * tstepA) + E.a_koff(un))
#define PG8_STAGE_A(bufoff, gbase, h, vsel) do { if constexpr (Epi::GATHER) { PG8_STAGE(bufoff, gbase, vsel); } else { PG8_STAGE(bufoff, (gbase) + ((h) ? hstepA : (size_t)0), vA[0]); } } while (0)
    const size_t kstep = (size_t)(BK * 2);
    const size_t hstepA = (size_t)HALF * g.lda * 2, hstepB = (size_t)HALF * g.ldb * 2;
    const size_t tstepA = 2 * hstepA, tstepB = 2 * hstepB;
    const unsigned ldsw = (unsigned)wid * 1024u;
    const int aoff = lds_byte(wr * 64 + fr, fq * 8), boff = lds_byte(wc * 32 + fr, fq * 8);
#define PG8_SA(b, h) (((b) * 2 + (h)) * HTB)
#define PG8_SB(b, h) ((4 + (b) * 2 + (h)) * HTB)
#define PG8_STAGE(bufoff, gbase, voff) do { _Pragma("unroll") for (int _i = 0; _i < 2; ++_i) \
        __builtin_amdgcn_global_load_lds((const unsigned*)((const char*)(gbase) + (voff)[_i]), (PG8_LAS unsigned*)(lds + (bufoff) + ldsw + _i * 8192), 16, 0, 0); } while (0)
#define PG8_LDA(dst, b, h) do { _Pragma("unroll") for (int m = 0; m < 4; ++m) _Pragma("unroll") for (int k = 0; k < 2; ++k) dst[m][k] = *(const PG8_LAS bf16x8*)(lds + PG8_SA(b, h) + aoff + m * 2048 + k * 1024); } while (0)
#define PG8_LDB(dst, b, h) do { _Pragma("unroll") for (int n = 0; n < 2; ++n) _Pragma("unroll") for (int k = 0; k < 2; ++k) dst[n][k] = *(const PG8_LAS bf16x8*)(lds + PG8_SB(b, h) + boff + n * 2048 + k * 1024); } while (0)
#define PG8_MMA(ai, bj, At, Bt) do { __builtin_amdgcn_s_setprio(1); _Pragma("unroll") for (int m = 0; m < 4; ++m) _Pragma("unroll") for (int n = 0; n < 2; ++n) _Pragma("unroll") for (int k = 0; k < 2; ++k) \
        acc[ai][bj][m][n] = __builtin_amdgcn_mfma_f32_16x16x32_bf16(Bt[n][k], At[m][k], acc[ai][bj][m][n], 0, 0, 0); __builtin_amdgcn_s_setprio(0); } while (0)
#define PG8_WAIT_V(n) asm volatile("s_waitcnt vmcnt(" #n ")" ::: "memory")
#define PG8_WAIT_L(n) asm volatile("s_waitcnt lgkmcnt(" #n ")" ::: "memory")
#define PG8_BAR __builtin_amdgcn_s_barrier()
#define PG8_SCHED __builtin_amdgcn_sched_barrier(0)
    Unit cur, nxt; int ui = 0;
    if (!S.next(0, cur)) return;
    f32x4 acc[2][2][4][2];
#pragma unroll
    for (int a = 0; a < 2; ++a)
#pragma unroll
        for (int b = 0; b < 2; ++b)
#pragma unroll
            for (int m = 0; m < 4; ++m)
#pragma unroll
                for (int n = 0; n < 2; ++n) acc[a][b][m][n] = (f32x4){0.f, 0.f, 0.f, 0.f};
    bf16x8 At[4][2], B0[2][2], B1[2][2];
    if constexpr (Epi::GATHER) PG8_GOFFS(vA, cur);
    const char* cA = PG8_ABASE(cur); const char* cB = (const char*)g.Bt + (size_t)E.b_tile(cur) * tstepB + E.b_koff(cur);
    {
        PG8_STAGE(PG8_SB(0, 0), cB, voffB); PG8_STAGE(PG8_SB(0, 1), cB + hstepB, voffB); PG8_STAGE_A(PG8_SA(0, 0), cA, 0, vA[0]); PG8_STAGE_A(PG8_SA(0, 1), cA, 1, vA[1]);
        if (wr == 1) PG8_BAR;
        PG8_WAIT_V(2); PG8_BAR;
        PG8_STAGE(PG8_SB(1, 0), cB + kstep, voffB); PG8_STAGE_A(PG8_SA(1, 0), cA + kstep, 0, vA[0]); PG8_STAGE(PG8_SB(1, 1), cB + hstepB + kstep, voffB);
        PG8_WAIT_V(6); PG8_BAR;
    }
    for (;;) {
        const bool has_next = S.next(ui + 1, nxt);
        const int ntc = E.ktiles(cur, nt);
        const char* nA = has_next ? PG8_ABASE(nxt) : cA; const char* nB = has_next ? (const char*)g.Bt + (size_t)E.b_tile(nxt) * tstepB + E.b_koff(nxt) : cB;
        if constexpr (Epi::GATHER) { if (has_next) PG8_GOFFS(nvA, nxt); else { _Pragma("unroll") for (int h_ = 0; h_ < 2; ++h_) _Pragma("unroll") for (int i_ = 0; i_ < 2; ++i_) nvA[h_][i_] = vA[h_][i_]; } }
#define PG8_KBODY(t) do { \
            const bool last = (t == ntc - 2); \
            const char* a1 = cA + (size_t)(t + 1) * kstep; \
            const char* a2 = last ? nA : cA + (size_t)(t + 2) * kstep; const char* b2 = last ? nB : cB + (size_t)(t + 2) * kstep; \
            const char* a3 = a2 + kstep; const char* b3 = b2 + kstep; \
            const unsigned x00 = last ? nvA[0][0] : vA[0][0], x01 = last ? nvA[0][1] : vA[0][1], x10 = last ? nvA[1][0] : vA[1][0], x11 = last ? nvA[1][1] : vA[1][1]; \
            const unsigned w0_[2] = {x00, x01}, w1_[2] = {x10, x11}; \
            PG8_LDB(B0, 0, 0); PG8_LDB(B1, 0, 1); PG8_SCHED; PG8_LDA(At, 0, 0); PG8_STAGE_A(PG8_SA(1, 1), a1, 1, vA[1]); \
            PG8_WAIT_V(8); PG8_WAIT_L(0); PG8_BAR; PG8_MMA(0, 0, At, B0); PG8_MMA(0, 1, At, B1); PG8_BAR; PG8_SCHED; \
            PG8_LDA(At, 0, 1); PG8_STAGE(PG8_SB(0, 0), b2, voffB); PG8_STAGE(PG8_SB(0, 1), b2 + hstepB, voffB); PG8_STAGE_A(PG8_SA(0, 0), a2, 0, w0_); \
            PG8_WAIT_V(8); PG8_WAIT_L(0); PG8_BAR; PG8_MMA(1, 0, At, B0); PG8_MMA(1, 1, At, B1); PG8_BAR; PG8_SCHED; \
            PG8_LDB(B0, 1, 0); PG8_LDB(B1, 1, 1); PG8_SCHED; PG8_LDA(At, 1, 0); PG8_STAGE_A(PG8_SA(0, 1), a2, 1, w1_); \
            PG8_WAIT_V(8); PG8_WAIT_L(0); PG8_BAR; PG8_MMA(0, 0, At, B0); PG8_MMA(0, 1, At, B1); PG8_BAR; PG8_SCHED; \
            PG8_LDA(At, 1, 1); PG8_STAGE(PG8_SB(1, 0), b3, voffB); PG8_STAGE(PG8_SB(1, 1), b3 + hstepB, voffB); PG8_STAGE_A(PG8_SA(1, 0), a3, 0, w0_); \
            PG8_WAIT_V(8); PG8_WAIT_L(0); PG8_BAR; PG8_MMA(1, 0, At, B0); PG8_MMA(1, 1, At, B1); PG8_BAR; PG8_SCHED; \
        } while (0)
        { int t = 0;
          if constexpr (Epi::KHOOK) {
              for (; t < 4; t += 2) PG8_KBODY(t);
              E.khook(acc, cur, 4, wr, wc, fr, fq);
              for (; t < 8; t += 2) PG8_KBODY(t);
              E.khook(acc, cur, 8, wr, wc, fr, fq);
          }
          for (; t < ntc; t += 2) PG8_KBODY(t); }
#undef PG8_KBODY
        if constexpr (ALIGN_EPI) { if (wr == 0) PG8_BAR; }
        E(acc, cur, wr, wc, fr, fq);
        if (!has_next) break;
#pragma unroll
        for (int a = 0; a < 2; ++a)
#pragma unroll
            for (int b = 0; b < 2; ++b)
#pragma unroll
                for (int m = 0; m < 4; ++m)
#pragma unroll
                    for (int n = 0; n < 2; ++n) acc[a][b][m][n] = (f32x4){0.f, 0.f, 0.f, 0.f};
        cur = nxt; cA = nA; cB = nB; ++ui;
        if constexpr (Epi::GATHER) { _Pragma("unroll") for (int h_ = 0; h_ < 2; ++h_) _Pragma("unroll") for (int i_ = 0; i_ < 2; ++i_) vA[h_][i_] = nvA[h_][i_]; }
        if constexpr (ALIGN_EPI) { if (wr == 1) PG8_BAR; }
    }
    PG8_WAIT_V(0);
    if constexpr (!ALIGN_EPI) { if (wr == 0) PG8_BAR; }
    PG8_BAR;
#undef PG8_GOFFS
#undef PG8_ABASE
#undef PG8_STAGE_A
#undef PG8_SA
#undef PG8_SB
#undef PG8_STAGE
#undef PG8_LDA
#undef PG8_LDB
#undef PG8_MMA
#undef PG8_WAIT_V
#undef PG8_WAIT_L
#undef PG8_BAR
#undef PG8_SCHED
}
}

namespace fox {
using bf16=__hip_bfloat16;
#define FOX_LAS __attribute__((address_space(3)))
using bf16x8=__attribute__((ext_vector_type(8)))short;
using s16x4=__attribute__((ext_vector_type(4)))short;
using f32x16=__attribute__((ext_vector_type(16)))float;
using u32x4=__attribute__((ext_vector_type(4)))unsigned;
constexpr int BATCH=4,NHEAD=8,SEQ=4096,D=64,DM=6144,DMO=1024;
constexpr int NW=8,QBLK=32,QB=QBLK*NW,KVBLK=64,NQB=SEQ/QB;
__device__ __forceinline__ int crow(int r,int hi){return (r&3)+8*(r>>2)+4*hi;}
#define SBAR() __builtin_amdgcn_sched_barrier(0)
__device__ __forceinline__ void cmask(f32x16&p0,f32x16&p1,int jb,int qrel,int hi){
  const float NEG=-INFINITY; const int x=qrel-64*jb-4*hi;
  #pragma unroll
  for(int r=0;r<16;++r){const int c=(r&3)+8*(r>>2); if(c>x)p0[r]=NEG; if(c+32>x)p1[r]=NEG;}
}

constexpr int NSLOT=3, SLOTB=8192;
constexpr int LDS_K=0, LDS_V=NSLOT*SLOTB, LDS_WS=2*NSLOT*SLOTB, LDS_OST=LDS_WS+NW*64*4, LDS_NCK=LDS_OST+NW*4096, LDS_BYTES=LDS_NCK+(SEQ+64)*4;
constexpr float C2=0.125f*1.4426950408889634f;
__device__ __forceinline__ void glds16(const void*gsrc,unsigned lds_dst){unsigned keep;
  asm volatile("s_mov_b32 %0, m0\n\ts_mov_b32 m0, %2\n\ts_nop 0\n\tglobal_load_lds_dwordx4 %1, off\n\ts_mov_b32 m0, %0":"=&s"(keep):"v"(gsrc),"s"(lds_dst):"memory");}
__device__ __forceinline__ float max3f(float a,float b,float c){float r;asm("v_max3_f32 %0, %1, %2, %3":"=v"(r):"v"(a),"v"(b),"v"(c));return r;}
__device__ __forceinline__ float max2f(float a,float b){float r;asm("v_max_f32_e32 %0, %1, %2":"=v"(r):"v"(a),"v"(b));return r;}
__device__ __forceinline__ float fadd_s(float a,float b){float r;asm("v_add_f32_e32 %0, %1, %2":"=v"(r):"v"(a),"v"(b));return r;}
__device__ __forceinline__ float fsub_s(float a,float b){float r;asm("v_sub_f32_e32 %0, %1, %2":"=v"(r):"v"(a),"v"(b));return r;}
typedef float f32x2_t __attribute__((ext_vector_type(2))); typedef float f32x4_t __attribute__((ext_vector_type(4))); typedef __bf16 bf16x2_t __attribute__((ext_vector_type(2)));
__device__ __forceinline__ unsigned cvtpk_s(float lo,float hi){f32x2_t v={lo,hi};bf16x2_t b=__builtin_convertvector(v,bf16x2_t);return __builtin_bit_cast(unsigned,b);}
#define WAIT_BAR(N) asm volatile("s_waitcnt vmcnt(" #N ") lgkmcnt(0)\n\ts_barrier":::"memory")

__device__ __forceinline__ void qkt(f32x16&p0,f32x16&p1,const char*Kslot,const bf16x8*qr,int r32,int hi){
  const char*kb=Kslot+hi*1024+r32*16;
  #pragma unroll
  for(int d0=0;d0<4;++d0){
    const bf16x8 b0=*reinterpret_cast<const bf16x8*>(kb+d0*2048);
    const bf16x8 b1=*reinterpret_cast<const bf16x8*>(kb+d0*2048+512);
    p0=__builtin_amdgcn_mfma_f32_32x32x16_bf16(b0,qr[d0],p0,0,0,0);p1=__builtin_amdgcn_mfma_f32_32x32x16_bf16(b1,qr[d0],p1,0,0,0);}
}
__device__ __forceinline__ void nck_load(f32x16&c0,f32x16&c1,const FOX_LAS float*nckh,int tile){
  const FOX_LAS float*cp=nckh+tile*64;
  #pragma unroll
  for(int g=0;g<4;++g){ const f32x4_t a=*(const FOX_LAS f32x4_t*)(cp+8*g), b=*(const FOX_LAS f32x4_t*)(cp+32+8*g);
    c0[4*g]=a[0];c0[4*g+1]=a[1];c0[4*g+2]=a[2];c0[4*g+3]=a[3]; c1[4*g]=b[0];c1[4*g+1]=b[1];c1[4*g+2]=b[2];c1[4*g+3]=b[3]; }
}
typedef __attribute__((address_space(3))) const char* lds_cptr;
typedef short v4i16_t __attribute__((ext_vector_type(4)));
__device__ __forceinline__ void kload8(bf16x8*kf,lds_cptr kp){
  kf[0]=*(const __attribute__((address_space(3))) bf16x8*)(kp);      kf[1]=*(const __attribute__((address_space(3))) bf16x8*)(kp+512);
  kf[2]=*(const __attribute__((address_space(3))) bf16x8*)(kp+2048); kf[3]=*(const __attribute__((address_space(3))) bf16x8*)(kp+2560);
  kf[4]=*(const __attribute__((address_space(3))) bf16x8*)(kp+4096); kf[5]=*(const __attribute__((address_space(3))) bf16x8*)(kp+4608);
  kf[6]=*(const __attribute__((address_space(3))) bf16x8*)(kp+6144); kf[7]=*(const __attribute__((address_space(3))) bf16x8*)(kp+6656);
}
__device__ __forceinline__ void kload2(bf16x8*kf,lds_cptr kp,int j){ kf[2*j]=*(const __attribute__((address_space(3))) bf16x8*)(kp+j*2048); kf[2*j+1]=*(const __attribute__((address_space(3))) bf16x8*)(kp+j*2048+512); }
__device__ __forceinline__ s16x4 vtr(lds_cptr p){ return __builtin_bit_cast(s16x4,__builtin_amdgcn_ds_read_tr16_b64_v4i16((__attribute__((address_space(3))) v4i16_t*)p)); }
__device__ __forceinline__ float rowmax(const f32x16&p0,const f32x16&p1){
  float a=max3f(p0[0],p0[1],p1[0]),b=max3f(p0[2],p0[3],p1[1]);a=max3f(a,p1[2],p1[3]);
  #pragma unroll
  for(int r=4;r<16;r+=4){a=max3f(a,p0[r],p0[r+1]);b=max3f(b,p0[r+2],p0[r+3]);a=max3f(a,p1[r],p1[r+1]);b=max3f(b,p1[r+2],p1[r+3]);}
  const float m=max2f(a,b);
  auto rr=__builtin_amdgcn_permlane32_swap(__float_as_uint(m),__float_as_uint(m),false,false);
  return max2f(__uint_as_float(rr[0]),__uint_as_float(rr[1]));
}
__device__ __forceinline__ void pv(f32x16*o,int vb,bf16x8 pa0,bf16x8 pa1,bf16x8 pa2,bf16x8 pa3){
  #pragma unroll
  for(int d0=0;d0<2;++d0){s16x4 lo[4],hi[4];
    #pragma unroll
    for(int ks=0;ks<4;++ks){
      asm volatile("ds_read_b64_tr_b16 %0,%1 offset:%c2":"=&v"(lo[ks]):"v"(vb),"i"(d0*4096+ks*1024):"memory");
      asm volatile("ds_read_b64_tr_b16 %0,%1 offset:%c2":"=&v"(hi[ks]):"v"(vb),"i"(d0*4096+ks*1024+512):"memory");}
    asm volatile("s_waitcnt lgkmcnt(0)":::"memory");SBAR();
    #define PK(k) (bf16x8){lo[k][0],lo[k][1],lo[k][2],lo[k][3],hi[k][0],hi[k][1],hi[k][2],hi[k][3]}
    o[d0]=__builtin_amdgcn_mfma_f32_32x32x16_bf16(pa0,PK(0),o[d0],0,0,0);
    o[d0]=__builtin_amdgcn_mfma_f32_32x32x16_bf16(pa1,PK(1),o[d0],0,0,0);
    o[d0]=__builtin_amdgcn_mfma_f32_32x32x16_bf16(pa2,PK(2),o[d0],0,0,0);
    o[d0]=__builtin_amdgcn_mfma_f32_32x32x16_bf16(pa3,PK(3),o[d0],0,0,0);
    #undef PK
  }
}

#ifndef ATTN_STORE16
#define ATTN_STORE16(p,v) (*(u32x4*)(p)=(v))
#endif
template<int THRL> __device__ __forceinline__ void attn_unit(int b,int h,int qb,const bf16*Q,const bf16*K,const bf16*V,bf16*O,const float*LOGF,char*shm,int tid,float skip_thr){
  const int lane=tid&63,r32=lane&31,hi=lane>>5; const int wid=__builtin_amdgcn_readfirstlane(tid>>6);
  const long rowbase=(long)b*SEQ; const int q0=qb*QB;
  const bf16*Qw=Q+(rowbase+q0+wid*QBLK)*DM+h*D;
  const lds_cptr shm3=(lds_cptr)shm;
  const unsigned lds0=(unsigned)(uintptr_t)shm;
  float*wsf=(float*)(shm+LDS_WS)+wid*64;
  const int NT0=(q0+QB)/KVBLK;
  FOX_LAS float*nckw=(FOX_LAS float*)(shm3+LDS_NCK);
  { const int nkeys=q0+QB; float run=0.f;
    __syncthreads();
    #pragma unroll
    for(int e=0;e<8;++e){const int t_=tid*8+e; const float x_=t_<nkeys?LOGF[(rowbase+t_)*NHEAD+h]:0.f; run+=x_; nckw[t_]=-run;}
    float inc=run;
    #pragma unroll
    for(int o_=1;o_<64;o_<<=1){const float n_=__shfl_up(inc,o_); if(lane>=o_)inc+=n_;}
    FOX_LAS float*wt=(FOX_LAS float*)(shm3+LDS_WS);
    if(lane==63)wt[wid]=inc;
    __syncthreads();
    float off=inc-run;
    for(int w_=0;w_<wid;++w_)off+=wt[w_];
    #pragma unroll
    for(int e=0;e<8;++e){const int t_=tid*8+e; nckw[t_]-=off;}
    __syncthreads();
  }
  int ts;
  { FOX_LAS int*ti=(FOX_LAS int*)(shm3+LDS_WS)+32;
    if(wid==0){ const bool keep=(lane<NT0)&&(nckw[64*lane+63]>=nckw[q0]-skip_thr); const unsigned long long m_=__ballot(keep); if(lane==0)ti[0]=m_?__builtin_ctzll(m_):0; }
    __syncthreads();
    ts=__builtin_amdgcn_readfirstlane(ti[0]); ts&=~1; if(ts>NT0-4)ts=NT0-4;
  }
  const int NT=NT0-ts;
  const bf16*Kh=K+(rowbase+(long)ts*KVBLK)*DM+h*D,*Vh=V+(rowbase+(long)ts*KVBLK)*DM+h*D;
  const bf16*ksrc=Kh+(long)lane*DM+wid*8;
  const bf16*vsrc=Vh+(long)(16*(wid&3)+(lane>>2))*DM+(wid>>2)*32+(lane&3)*8;
  const unsigned kdst=lds0+LDS_K+wid*1024, vdst=lds0+LDS_V+wid*1024;
  #define DMA_K(t,slot) glds16(ksrc+(long)(t)*KVBLK*DM,(unsigned)__builtin_amdgcn_readfirstlane(kdst+(slot)))
  #define DMA_V(t,slot) glds16(vsrc+(long)(t)*KVBLK*DM,(unsigned)__builtin_amdgcn_readfirstlane(vdst+(slot)))
  const int vb0=(int)(lds0+LDS_V)+((lane>>4)&1)*32+(lane&3)*8+(4*hi+((lane&15)>>2))*64;
  const char*Kbase=shm+LDS_K; bf16x8 kf[8];
  const lds_cptr kp0=shm3+LDS_K+hi*1024+r32*16; const lds_cptr vp0=shm3+LDS_V+((lane>>4)&1)*32+(lane&3)*8+(4*hi+((lane&15)>>2))*64;
  const FOX_LAS float*nckh=(const FOX_LAS float*)(shm3+LDS_NCK)+ts*KVBLK+4*hi;
  DMA_K(0,0);DMA_V(0,0);DMA_K(1,SLOTB);
  bf16x8 qr[4];
  #pragma unroll
  for(int d0=0;d0<4;++d0)qr[d0]=*reinterpret_cast<const bf16x8*>(&Qw[(long)r32*DM+d0*16+hi*8]);
  float l_reg=0.f;f32x16 o[2];o[0]=f32x16{};o[1]=f32x16{};
  const int qrel=wid*QBLK+r32;
  float nq=-nckw[q0+qrel];
  #define CMASK(P0,P1,t) do{int jb_=(t)-(NT-4); if(jb_>=0)cmask(P0,P1,jb_,qrel,hi);}while(0)
  bool resc=false;
  #define START(P0,P1) do{ const float rm=rowmax(P0,P1); resc=false; \
    { const float dl=rm; nq=fsub_s(nq,dl); \
      _Pragma("unroll") for(int r=0;r<16;++r){P0[r]=fsub_s(P0[r],dl);P1[r]=fsub_s(P1[r],dl);} } \
    _Pragma("unroll") for(int r=0;r<16;++r)P0[r]=__builtin_amdgcn_exp2f(P0[r]); }while(0)
  #define RESC() do{ if(resc){ asm volatile("s_waitcnt lgkmcnt(0)":::"memory"); \
      _Pragma("unroll") for(int d_=0;d_<2;++d_) _Pragma("unroll") for(int r=0;r<16;++r)o[d_][r]*=wsf[crow(r,hi)]; } }while(0)
  f32x16 pA0,pA1,pB0,pB1;
  int sl_prev=0,sl_cur=0,sl_next=SLOTB;
  #define ROT() do{sl_prev=sl_cur;sl_cur=sl_next;sl_next=(sl_next==(NSLOT-1)*SLOTB)?0:sl_next+SLOTB;}while(0)
  DMA_K(2,2*SLOTB);
  WAIT_BAR(3);
  nck_load(pA0,pA1,nckh,0);
  _Pragma("unroll") for(int r=0;r<16;++r){pA0[r]+=nq;pA1[r]+=nq;}
  qkt(pA0,pA1,Kbase,qr,r32,hi);asm volatile("s_nop 15\n\ts_nop 7":"+v"(pA0),"+v"(pA1));CMASK(pA0,pA1,0);
  START(pA0,pA1);
  _Pragma("unroll") for(int r=0;r<16;++r)pA1[r]=__builtin_amdgcn_exp2f(pA1[r]);
  nck_load(pB0,pB1,nckh,1);
  _Pragma("unroll") for(int r=0;r<16;++r){pB0[r]+=nq;pB1[r]+=nq;}
  WAIT_BAR(0);
  DMA_K(3,0);DMA_V(1,SLOTB);
  ROT();
  kload8(kf,kp0+sl_cur);
  WAIT_BAR(2);
  s16x4 vlo[8],vhi[8]; u32x4 pw0,pw1,pw2,pw3;
  #define PKW(P,B) cvtpk_s(P[B],P[B+1])
  #define PAF(k) __builtin_bit_cast(bf16x8,pw##k)
  #define VFR(i) (bf16x8){vlo[i][0],vlo[i][1],vlo[i][2],vlo[i][3],vhi[i][0],vhi[i][1],vhi[i][2],vhi[i][3]}
  #define PIN(x) asm volatile("":"+v"(x))
  #define MX3(a,b,c) __builtin_fmaxf(__builtin_fmaxf((a),(b)),(c))
  #define GAPA(MF,A0,A1,A2,A3,W0,W1,PW) do{ MF; sacc+=A0; sacc+=A1; sacc+=A2; sacc+=A3; PIN(sacc); W0; W1; PIN(PW); SBAR(); }while(0)
  #define EX(v) __builtin_amdgcn_exp2f(v)
  #define GAPB(MF,X,B,GL_,Y) do{ MF; X[B]=EX(X[B]); X[B+1]=EX(X[B+1]); X[B+2]=EX(X[B+2]); X[B+3]=EX(X[B+3]); PIN(X); if(GL_){ Y[B]+=nq; Y[B+1]+=nq; Y[B+2]+=nq; Y[B+3]+=nq; PIN(Y); } SBAR(); }while(0)
  #define VRD(i) do{ vlo[i]=vtr(vp_+(((i)>>2)*4096+((i)&3)*1024)); vhi[i]=vtr(vp_+(((i)>>2)*4096+((i)&3)*1024+512)); }while(0)
  #define KRD(G,j) do{ if(G){ kload2(kf,kp0+sl_next,j); SBAR(); } }while(0)
  #define STEP(C0,C1,P0,P1,t,GK,GV,GL) do{ SBAR(); \
    const lds_cptr vp_=vp0+sl_prev; \
    VRD(0); SBAR(); float sacc=(P0[0]+P0[1]); \
    GAPA(C0=__builtin_amdgcn_mfma_f32_32x32x16_bf16(kf[0],qr[0],C0,0,0,0), P0[2],P0[3],P0[4],P0[5],     pw0[0]=PKW(P0,0), pw0[1]=PKW(P0,2), pw0); \
    VRD(4); SBAR(); GAPA(C1=__builtin_amdgcn_mfma_f32_32x32x16_bf16(kf[1],qr[0],C1,0,0,0), P0[6],P0[7],P0[8],P0[9],     pw0[2]=PKW(P0,4), pw0[3]=PKW(P0,6), pw0); \
    VRD(1); SBAR(); GAPA(C0=__builtin_amdgcn_mfma_f32_32x32x16_bf16(kf[2],qr[1],C0,0,0,0),   P0[10],P0[11],P0[12],P0[13], pw1[0]=PKW(P0,8), pw1[1]=PKW(P0,10), pw1); \
    VRD(5); SBAR(); GAPA(C1=__builtin_amdgcn_mfma_f32_32x32x16_bf16(kf[3],qr[1],C1,0,0,0),   P0[14],P0[15],P1[0],P1[1],   pw1[2]=PKW(P0,12),pw1[3]=PKW(P0,14), pw1); \
    VRD(2); SBAR(); GAPA(C0=__builtin_amdgcn_mfma_f32_32x32x16_bf16(kf[4],qr[2],C0,0,0,0),   P1[2],P1[3],P1[4],P1[5],     pw2[0]=PKW(P1,0), pw2[1]=PKW(P1,2), pw2); \
    VRD(6); SBAR(); GAPA(C1=__builtin_amdgcn_mfma_f32_32x32x16_bf16(kf[5],qr[2],C1,0,0,0),   P1[6],P1[7],P1[8],P1[9],     pw2[2]=PKW(P1,4), pw2[3]=PKW(P1,6), pw2); \
    VRD(3); SBAR(); GAPA(C0=__builtin_amdgcn_mfma_f32_32x32x16_bf16(kf[6],qr[3],C0,0,0,0),   P1[10],P1[11],P1[12],P1[13], pw3[0]=PKW(P1,8), pw3[1]=PKW(P1,10), pw3); \
    VRD(7); SBAR(); GAPA(C1=__builtin_amdgcn_mfma_f32_32x32x16_bf16(kf[7],qr[3],C1,0,0,0),   P1[14],P1[15],0.f,0.f,       pw3[2]=PKW(P1,12),pw3[3]=PKW(P1,14), pw3); \
    l_reg+=sacc; \
    if(GL){ nck_load(P0,P1,nckh,(t)+1); SBAR(); } \
    if(GK){DMA_K((t)+3,sl_cur);} if(GV){DMA_V((t)+1,sl_next);} \
    CMASK(C0,C1,t); \
    { float a=MX3(C0[0],C0[1],C1[0]),b=MX3(C0[2],C0[3],C1[1]); a=MX3(a,C1[2],C1[3]); \
      _Pragma("unroll") for(int r=4;r<16;r+=4){a=MX3(a,C0[r],C0[r+1]);b=MX3(b,C0[r+2],C0[r+3]);a=MX3(a,C1[r],C1[r+1]);b=MX3(b,C1[r+2],C1[r+3]);} \
      float rm=__builtin_fmaxf(a,b); { auto rr=__builtin_amdgcn_permlane32_swap(__float_as_uint(rm),__float_as_uint(rm),false,false); rm=__builtin_fmaxf(__uint_as_float(rr[0]),__uint_as_float(rr[1])); } \
      resc=false; \
      if(__builtin_expect(__any(rm>(float)THRL),0)){ const float dl=__builtin_fmaxf(rm,0.f); nq-=dl; \
        _Pragma("unroll") for(int r=0;r<16;++r){C0[r]-=dl;C1[r]-=dl;} \
        const float f=__builtin_amdgcn_exp2f(-dl); l_reg*=f; if(hi==0)wsf[r32]=f; resc=true; } } \
    SBAR(); \
    GAPB(o[0]=__builtin_amdgcn_mfma_f32_32x32x16_bf16(PAF(0),VFR(0),o[0],0,0,0), C0,0,GL,P0); \
    GAPB(o[1]=__builtin_amdgcn_mfma_f32_32x32x16_bf16(PAF(0),VFR(4),o[1],0,0,0), C0,4,GL,P0); \
    KRD(GL,0); GAPB(o[0]=__builtin_amdgcn_mfma_f32_32x32x16_bf16(PAF(1),VFR(1),o[0],0,0,0), C0,8,GL,P0); \
    KRD(GL,1); GAPB(o[1]=__builtin_amdgcn_mfma_f32_32x32x16_bf16(PAF(1),VFR(5),o[1],0,0,0), C0,12,GL,P0); \
    KRD(GL,2); GAPB(o[0]=__builtin_amdgcn_mfma_f32_32x32x16_bf16(PAF(2),VFR(2),o[0],0,0,0), C1,0,GL,P1); \
    KRD(GL,3); GAPB(o[1]=__builtin_amdgcn_mfma_f32_32x32x16_bf16(PAF(2),VFR(6),o[1],0,0,0), C1,4,GL,P1); \
    GAPB(o[0]=__builtin_amdgcn_mfma_f32_32x32x16_bf16(PAF(3),VFR(3),o[0],0,0,0), C1,8,GL,P1); \
    GAPB(o[1]=__builtin_amdgcn_mfma_f32_32x32x16_bf16(PAF(3),VFR(7),o[1],0,0,0), C1,12,GL,P1); \
    }while(0)
  int t=1;
  #undef CMASK
  #define CMASK(P0,P1,t) do{}while(0)
  for(;t+5<NT;t+=2){
    STEP(pB0,pB1,pA0,pA1,t,true,true,true);     WAIT_BAR(2); RESC(); ROT();
    STEP(pA0,pA1,pB0,pB1,t+1,true,true,true);   WAIT_BAR(2); RESC(); ROT();
  }
  #undef CMASK
  #define CMASK(P0,P1,t) do{int jb_=(t)-(NT-4); if(jb_>=0)cmask(P0,P1,jb_,qrel,hi);}while(0)
  #define ENDW(tt) do{ if((tt)+3<NT){WAIT_BAR(2);} else if((tt)+2<NT){WAIT_BAR(1);} else {WAIT_BAR(0);} }while(0)
  for(;t+1<NT;t+=2){
    STEP(pB0,pB1,pA0,pA1,t,(t+3<NT),(t+1<NT),(t+1<NT));       ENDW(t);   RESC(); ROT();
    STEP(pA0,pA1,pB0,pB1,t+1,(t+4<NT),(t+2<NT),(t+2<NT));     ENDW(t+1); RESC(); ROT();
  }
  STEP(pB0,pB1,pA0,pA1,NT-1,false,false,false); RESC();
  { float sacc=pB0[0]+pB0[1]; _Pragma("unroll") for(int r=2;r<16;++r)sacc+=pB0[r]; _Pragma("unroll") for(int r=0;r<16;++r)sacc+=pB1[r]; l_reg+=sacc;
    pw0=(u32x4){PKW(pB0,0),PKW(pB0,2),PKW(pB0,4),PKW(pB0,6)};pw1=(u32x4){PKW(pB0,8),PKW(pB0,10),PKW(pB0,12),PKW(pB0,14)};pw2=(u32x4){PKW(pB1,0),PKW(pB1,2),PKW(pB1,4),PKW(pB1,6)};pw3=(u32x4){PKW(pB1,8),PKW(pB1,10),PKW(pB1,12),PKW(pB1,14)};
    SBAR(); pv(o,vb0+sl_cur,PAF(0),PAF(1),PAF(2),PAF(3)); }
  #undef PKW
  #undef PAF
  #undef VFR
  #undef PIN
  #undef MX3
  #undef GAPA
  #undef GAPB
  #undef EX
  #undef VRD
  #undef KRD
  #undef STEP
  #undef ENDW
  {auto rr=__builtin_amdgcn_permlane32_swap(__float_as_uint(l_reg),__float_as_uint(l_reg),false,false);l_reg=__uint_as_float(rr[0])+__uint_as_float(rr[1]);}
  if(hi==0)wsf[32+r32]=l_reg;asm volatile("s_waitcnt lgkmcnt(0)":::"memory");
  float rli[16];
  #pragma unroll
  for(int r=0;r<16;++r)rli[r]=__builtin_amdgcn_rcpf(wsf[32+crow(r,hi)]);
  bf16*Ow=O+(rowbase+q0+wid*QBLK)*DMO+h*D;
  { bf16*stg=(bf16*)(shm+LDS_OST)+wid*2048;
    #pragma unroll
    for(int r=0;r<16;++r){const int orow=crow(r,hi);
      #pragma unroll
      for(int d0=0;d0<2;++d0)stg[orow*64+d0*32+r32]=__float2bfloat16(o[d0][r]*rli[r]);}
    asm volatile("s_waitcnt lgkmcnt(0)":::"memory");
    #pragma unroll
    for(int i=0;i<4;++i){const int row=i*8+(lane>>3),ch=lane&7; const u32x4 v=*(const u32x4*)(stg+row*64+ch*8); ATTN_STORE16(Ow+(long)row*DMO+ch*8,v);} }
  asm volatile("s_waitcnt lgkmcnt(0)\n\ts_barrier":::"memory");
  #undef DMA_K
  #undef DMA_V
  #undef CMASK
  #undef START
  #undef RESC
  #undef ROT
}
constexpr int ATTN_LDS_BYTES=LDS_BYTES;
#undef SBAR
#undef WAIT_BAR
#undef FOX_LAS
}

constexpr int NWAVES = 8, NTHR = 512;
constexpr int DM = 1024, NB = 4, NT = 4096, NL = 4, M = NB * NT;
constexpr int NHR = 4, NHF = 8, HD = 64;
constexpr int INW = 6024, ZW = 6144;
constexpr int ZC_U = 0, ZC_V = 256, ZC_R = 512, ZC_LORA = 1280, ZC_FL = 1408, ZC_Q = 1536, ZC_KF = 2048, ZC_VF = 2560, ZC_GATE = 3072;
constexpr int NE = 32, TOPK = 4, DFF = 1024;
constexpr int RWC = 32, NCH = NT / RWC;
constexpr int MAXTILES = 288, XROWS = MAXTILES * 256;
constexpr float LOG2E = 1.4426950408889634f;
constexpr float QSCALE = 0.125f * LOG2E;

constexpr size_t MiB = 1u << 20;
constexpr size_t WS_CTL = 0, CTL_ZERO_BYTES = 1 * MiB;
constexpr size_t WS_MOD = 1 * MiB;
constexpr size_t WS_WRT = 1 * MiB + 512 * 1024;
constexpr size_t WS_WIN = 2 * MiB;
constexpr size_t WS_WBR = 50 * MiB;
constexpr size_t WS_WO = 58 * MiB;
constexpr size_t WS_WGU = 66 * MiB;
constexpr size_t WS_WD = 578 * MiB;
constexpr size_t WS_XN = 1912 * MiB;
constexpr size_t WS_Z = 866 * MiB;
constexpr size_t WS_FLOGIT = 1058 * MiB;
constexpr size_t WS_LOGF = 1059 * MiB;
constexpr size_t WS_RW = 1060 * MiB;
constexpr size_t WS_Y0 = 1172 * MiB, WS_RT = 1188 * MiB;
constexpr size_t WS_S0END = 1816 * MiB, WS_SST = 1880 * MiB;
constexpr size_t WS_PEND = 1945 * MiB;
constexpr int PIMG_BYTES = 2 * 64 * 64 * 2;
constexpr size_t WS_SSP = 1204 * MiB;
constexpr size_t WS_YMIX = 1252 * MiB;
constexpr size_t WS_MRG = 1284 * MiB;
constexpr size_t WS_MERGED = 1348 * MiB;
constexpr size_t WS_ROWTOK = 1380 * MiB;
constexpr size_t WS_TOKPOS = 1382 * MiB;
constexpr size_t WS_TOKW = 1383 * MiB;
constexpr size_t WS_XS = 1384 * MiB;
constexpr size_t WS_ACT = 1528 * MiB;
constexpr size_t WS_YS = 1672 * MiB;
constexpr size_t WS_END = 1985 * MiB;
constexpr int CW_BAR = 4096;
constexpr int CW_TS = 8192;
constexpr int CW_ATT = 12288;
constexpr int CW_CUR = 16384;

constexpr int RING_BYTES = 131072;
constexpr int LDS_BYTES = 153600;
constexpr int LDSCTL_OFF = LDS_BYTES - 1024;

#define GAS __attribute__((address_space(1)))
#define LAS __attribute__((address_space(3)))
typedef unsigned short bf16;
typedef unsigned v4u __attribute__((ext_vector_type(4)));
typedef unsigned v2u __attribute__((ext_vector_type(2)));
typedef float f32x4 __attribute__((ext_vector_type(4)));
#define LDS_WAIT() asm volatile("s_waitcnt lgkmcnt(0)" ::: "memory")
#define VM_WAIT() asm volatile("s_waitcnt vmcnt(0)" ::: "memory")
__device__ __forceinline__ unsigned f2bf(float f) { unsigned u = __builtin_bit_cast(unsigned, f); return (u + 0x7fffu + ((u >> 16) & 1u)) >> 16; }

typedef float cvt_f32x2_t __attribute__((ext_vector_type(2))); typedef __bf16 cvt_bf16x2_t __attribute__((ext_vector_type(2)));
__device__ __forceinline__ unsigned cvtpk_c(float lo, float hi) { cvt_f32x2_t v = {lo, hi}; cvt_bf16x2_t b = __builtin_convertvector(v, cvt_bf16x2_t); return __builtin_bit_cast(unsigned, b); }
__device__ __forceinline__ unsigned pk2(float lo, float hi) { return cvtpk_c(lo, hi); }
__device__ __forceinline__ float bflo(unsigned w) { return __builtin_bit_cast(float, w << 16); }
__device__ __forceinline__ float bfhi(unsigned w) { return __builtin_bit_cast(float, w & 0xffff0000u); }
__device__ __forceinline__ float bf2f(bf16 h) { return __builtin_bit_cast(float, (unsigned)h << 16); }

#define XB_TMO      128
#define XB_XCNT(j)  (256  + 64 * (j))
#define XB_XSUB(j)  (1280 + 64 * (j))
#define XB_XGEN(j)  (2304 + 64 * (j))
#define XB_TOP      3328
#define XB_TOPGEN   3392
#define XCD_BAR_WORDS 3456
#define XB_SPIN_CAP (1u << 22)

__device__ __forceinline__ unsigned xb_ld(unsigned* p)              { return __hip_atomic_load(p, __ATOMIC_RELAXED, __HIP_MEMORY_SCOPE_AGENT); }
__device__ __forceinline__ unsigned xb_add(unsigned* p, unsigned v) { return __hip_atomic_fetch_add(p, v, __ATOMIC_RELAXED, __HIP_MEMORY_SCOPE_AGENT); }
__device__ __forceinline__ unsigned xb_xcc_id() { return (unsigned)__builtin_amdgcn_s_getreg((3 << 11) | 20) & 0xFu; }
#define XB_SPIN(cond, bar) do { unsigned _sp = 0; while (cond) { __builtin_amdgcn_s_sleep(1); \
    if ((++_sp & 255u) == 0u) { if (xb_ld(&(bar)[XB_TMO])) break; if (_sp > XB_SPIN_CAP) { atomicAdd(&(bar)[XB_TMO], 1u); break; } } } } while (0)

struct XcdBarrier { unsigned* bar; unsigned x; volatile LAS unsigned* st; };

__device__ __forceinline__ XcdBarrier xcd_barrier_post(unsigned* bar, volatile LAS unsigned* st) {
    XcdBarrier b; b.bar = bar; b.x = xb_xcc_id(); b.st = st;
    if (threadIdx.x == 0) (void)xb_add(&bar[XB_XCNT(b.x)], 1u);
    return b;
}
__device__ __forceinline__ void xcd_barrier_complete(unsigned* bar, unsigned x, unsigned& nloc, unsigned& nx) {
    const unsigned G = gridDim.x * gridDim.y * gridDim.z;
    unsigned sum, cnt, mine, sp = 0u;
    for (;;) {
        sum = 0u; cnt = 0u; mine = 0u;
#pragma unroll
        for (unsigned j = 0; j < 16; ++j) { const unsigned c = xb_ld(&bar[XB_XCNT(j)]); sum += c; cnt += (c > 0u) ? 1u : 0u; mine = (j == x) ? c : mine; }
        if (sum == G) break;
        __builtin_amdgcn_s_sleep(1);
        if ((++sp & 255u) == 0u) { if (xb_ld(&bar[XB_TMO])) break; if (sp > XB_SPIN_CAP) { atomicAdd(&bar[XB_TMO], 1u); break; } }
    }
    nloc = mine > 0u ? mine : 1u; nx = cnt > 0u ? cnt : 1u;
}
__device__ __forceinline__ void xcd_barrier(const XcdBarrier& b0, unsigned* barp) {
    XcdBarrier b; b.bar = barp; b.x = xb_xcc_id(); b.st = b0.st;
    asm volatile("s_waitcnt vmcnt(0)" ::: "memory");
    __syncthreads();
    if (threadIdx.x == 0) {
        unsigned* bar = b.bar;
        __builtin_amdgcn_s_waitcnt(0);
        unsigned nloc = b.st[0], nx = b.st[1];
        if (nloc == 0u) { xcd_barrier_complete(bar, b.x, nloc, nx); b.st[0] = nloc; b.st[1] = nx; }
        const unsigned old = xb_add(&bar[XB_XSUB(b.x)], 1u);
        const unsigned gen = old / nloc;
        if (old + 1u == (gen + 1u) * nloc) {
            __builtin_amdgcn_fence(__ATOMIC_RELEASE, "agent");
            asm volatile("s_waitcnt vmcnt(0)" ::: "memory");
            const unsigned og = xb_add(&bar[XB_TOP], 1u);
            const unsigned tg = og / nx;
            if (og + 1u == (tg + 1u) * nx) xb_add(&bar[XB_TOPGEN], 1u);
            else XB_SPIN(xb_ld(&bar[XB_TOPGEN]) == tg, bar);
            __builtin_amdgcn_fence(__ATOMIC_ACQUIRE, "agent");
            xb_add(&bar[XB_XGEN(b.x)], 1u);
            asm volatile("s_waitcnt vmcnt(0)" ::: "memory");
        } else {
            XB_SPIN(xb_ld(&bar[XB_XGEN(b.x)]) == gen, bar);
            __builtin_amdgcn_fence(__ATOMIC_ACQUIRE, "agent");
            asm volatile("s_waitcnt vmcnt(0)" ::: "memory");
        }
    }
    __syncthreads();
}

struct Params { const float* in[30]; float* out; unsigned char* ws; };
typedef const __attribute__((address_space(4))) unsigned long long* kptr_t;
struct Frame {
    LAS unsigned char* lds;
    kptr_t ka;
    int tid, lane, wave, G, gw, ngw, bid;
    __device__ __forceinline__ const float* in(int k) const { return (const float*)(const GAS float*)ka[k]; }
    __device__ __forceinline__ float* out() const { return (float*)(GAS float*)ka[30]; }
    __device__ __forceinline__ unsigned char* ws() const { return (unsigned char*)(GAS unsigned char*)ka[31]; }
};
template <int CTRL> __device__ __forceinline__ float dpp_add(float v) { return v + __builtin_bit_cast(float, __builtin_amdgcn_update_dpp(0, __builtin_bit_cast(int, v), CTRL, 0xf, 0xf, true)); }
__device__ __forceinline__ float wave_sum(float v) {
    v = dpp_add<0xB1>(v); v = dpp_add<0x4E>(v); v = dpp_add<0x141>(v); v = dpp_add<0x140>(v);
    v += __builtin_bit_cast(float, __builtin_amdgcn_update_dpp(0, __builtin_bit_cast(int, v), 0x142, 0xa, 0xf, false));
    v += __builtin_bit_cast(float, __builtin_amdgcn_update_dpp(0, __builtin_bit_cast(int, v), 0x143, 0xc, 0xf, false));
    return __builtin_bit_cast(float, __builtin_amdgcn_readlane(__builtin_bit_cast(int, v), 63));
}
__device__ __forceinline__ float quad_sum(float x) {
    x += __builtin_bit_cast(float, __builtin_amdgcn_update_dpp(0, __builtin_bit_cast(int, x), 0xB1, 0xf, 0xf, true));
    x += __builtin_bit_cast(float, __builtin_amdgcn_update_dpp(0, __builtin_bit_cast(int, x), 0x4E, 0xf, 0xf, true));
    return x;
}
__device__ __forceinline__ float rcp_(float x) { return __builtin_amdgcn_rcpf(x); }
__device__ __forceinline__ float rsq_(float x) { return __builtin_amdgcn_rsqf(x); }
__device__ __forceinline__ float sigmoidf_(float x) { return rcp_(1.f + __expf(-x)); }
__device__ __forceinline__ float sigmoid_fast(float x) { return __builtin_amdgcn_rcpf(1.f + __builtin_amdgcn_exp2f(-1.4426950408889634f * x)); }
__device__ __forceinline__ float gelu_tanh(float x) { const float y = 0.7978845608028654f * (x + 0.044715f * x * x * x); const float t = 1.f - 2.f * rcp_(1.f + __expf(2.f * y)); return 0.5f * x * (1.f + t); }
__device__ __forceinline__ float softplusf_(float x) { return fmaxf(x, 0.f) + __logf(1.f + __expf(-fabsf(x))); }

using pg8::Unit; using pg8::cvt_pk_bf16;
struct EpiBase {
    static constexpr bool KHOOK = false, GATHER = false;
    __device__ __forceinline__ int row_src(const Unit&, int R) const { return R; }
    __device__ __forceinline__ size_t a_koff(const Unit&) const { return 0; }
    __device__ __forceinline__ size_t b_koff(const Unit&) const { return 0; }
    __device__ __forceinline__ int b_tile(const Unit& u) const { return u.pn; }
    __device__ __forceinline__ int ktiles(const Unit&, int nt) const { return nt; }
};
struct EpiZ : EpiBase {
    static constexpr bool PERM = true;
    bf16* Z; float* FL;
    __device__ __forceinline__ void operator()(const f32x4 (&acc)[2][2][4][2], const Unit& u, int wr, int wc, int fr, int fq) const {
        const int row0 = u.pm * 256 + wr * 64 + fr, col0 = u.pn * 256 + wc * 32 + 8 * fq;
#pragma unroll
        for (int ai = 0; ai < 2; ++ai)
#pragma unroll
            for (int m = 0; m < 4; ++m) { const int row = row0 + ai * 128 + m * 16; bf16* rowp = Z + (size_t)row * ZW + col0;
#pragma unroll
                for (int bj = 0; bj < 2; ++bj) { const f32x4 v0 = acc[ai][bj][m][0], v1 = acc[ai][bj][m][1];
                    v4u w; w.x = cvt_pk_bf16(v0[0], v0[1]); w.y = cvt_pk_bf16(v0[2], v0[3]); w.z = cvt_pk_bf16(v1[0], v1[1]); w.w = cvt_pk_bf16(v1[2], v1[3]);
                    *(v4u*)(rowp + bj * 128) = w; }
                if (u.pn == 5 && wc == 0 && fq == 0) { *(f32x4*)(FL + (size_t)row * 8) = acc[ai][1][m][0]; *(f32x4*)(FL + (size_t)row * 8 + 4) = acc[ai][1][m][1]; } }
    }
};
struct EpiMerge : EpiBase {
    static constexpr bool PERM = true;
    const bf16* Z; float* MRG; bf16* MERGED;
    __device__ __forceinline__ int br(const Unit& u) const { return u.pn % 3; }
    __device__ __forceinline__ size_t a_koff(const Unit& u) const { const int b = br(u); return (size_t)(b == 0 ? 0 : (b == 1 ? 256 : 512)) * 2; }
    __device__ __forceinline__ size_t b_koff(const Unit& u) const { return a_koff(u); }
    __device__ __forceinline__ int b_tile(const Unit& u) const { return u.pn / 3; }
    __device__ __forceinline__ int ktiles(const Unit& u, int) const { return br(u) == 2 ? 8 : 4; }
    __device__ __forceinline__ void operator()(const f32x4 (&acc)[2][2][4][2], const Unit& u, int wr, int wc, int fr, int fq) const {
        const int b = br(u), pn = u.pn / 3;
        const int row0 = u.pm * 256 + wr * 64 + fr, col0 = pn * 256 + wc * 32 + 8 * fq;
#pragma unroll
        for (int ai = 0; ai < 2; ++ai)
#pragma unroll
            for (int m = 0; m < 4; ++m) { const int row = row0 + ai * 128 + m * 16;
#pragma unroll
                for (int bj = 0; bj < 2; ++bj) { const int col = col0 + bj * 128;
                    const v4u gz = *(const v4u*)(Z + (size_t)row * ZW + ZC_GATE + b * 1024 + col);
                    f32x4 v0 = acc[ai][bj][m][0], v1 = acc[ai][bj][m][1];
                    v0[0] *= sigmoid_fast(bflo(gz.x)); v0[1] *= sigmoid_fast(bfhi(gz.x)); v0[2] *= sigmoid_fast(bflo(gz.y)); v0[3] *= sigmoid_fast(bfhi(gz.y));
                    v1[0] *= sigmoid_fast(bflo(gz.z)); v1[1] *= sigmoid_fast(bfhi(gz.z)); v1[2] *= sigmoid_fast(bflo(gz.w)); v1[3] *= sigmoid_fast(bfhi(gz.w));
                    float* mp = MRG + (size_t)row * DM + col;
                    if (b > 0) { v0 += *(const f32x4*)mp; v1 += *(const f32x4*)(mp + 4); }
                    if (b < 2) { *(f32x4*)mp = v0; *(f32x4*)(mp + 4) = v1; }
                    else { v4u w; w.x = cvt_pk_bf16(v0[0], v0[1]); w.y = cvt_pk_bf16(v0[2], v0[3]); w.z = cvt_pk_bf16(v1[0], v1[1]); w.w = cvt_pk_bf16(v1[2], v1[3]);
                        *(v4u*)(MERGED + (size_t)row * DM + col) = w; } } }
    }
};
struct EpiMerge2 : EpiBase {
    static constexpr bool PERM = true, KHOOK = true;
    const bf16* Z; bf16* MERGED;
    static __device__ __forceinline__ float en(float z) { return __builtin_amdgcn_exp2f(-1.4426950408889634f * fminf(fmaxf(z, -30.f), 30.f)); }
    __device__ __forceinline__ void khook(f32x4 (&acc)[2][2][4][2], const Unit& u, int t, int wr, int wc, int fr, int fq) const {
        const int ga = (t == 4) ? 0 : 1;
        int row0 = u.pm * 256 + wr * 64 + fr, col0 = u.pn * 256 + wc * 32 + 8 * fq; const bf16* Zl = Z;
        asm volatile("" : "+v"(row0), "+v"(col0), "+s"(Zl));
#pragma unroll
        for (int ai = 0; ai < 2; ++ai)
#pragma unroll
            for (int m = 0; m < 4; ++m) { const int row = row0 + ai * 128 + m * 16;
#pragma unroll
                for (int bj = 0; bj < 2; ++bj) { const bf16* zp = Zl + (size_t)row * ZW + ZC_GATE + ga * 1024 + col0 + bj * 128;
                    const v4u za = *(const v4u*)zp, zb = *(const v4u*)(zp + 1024);
                    f32x4 r0, r1;
                    r0[0] = (1.f + en(bflo(zb.x))) * __builtin_amdgcn_rcpf(1.f + en(bflo(za.x))); r0[1] = (1.f + en(bfhi(zb.x))) * __builtin_amdgcn_rcpf(1.f + en(bfhi(za.x)));
                    r0[2] = (1.f + en(bflo(zb.y))) * __builtin_amdgcn_rcpf(1.f + en(bflo(za.y))); r0[3] = (1.f + en(bfhi(zb.y))) * __builtin_amdgcn_rcpf(1.f + en(bfhi(za.y)));
                    r1[0] = (1.f + en(bflo(zb.z))) * __builtin_amdgcn_rcpf(1.f + en(bflo(za.z))); r1[1] = (1.f + en(bfhi(zb.z))) * __builtin_amdgcn_rcpf(1.f + en(bfhi(za.z)));
                    r1[2] = (1.f + en(bflo(zb.w))) * __builtin_amdgcn_rcpf(1.f + en(bflo(za.w))); r1[3] = (1.f + en(bfhi(zb.w))) * __builtin_amdgcn_rcpf(1.f + en(bfhi(za.w)));
                    acc[ai][bj][m][0] *= r0; acc[ai][bj][m][1] *= r1;
                    asm volatile("" : "+v"(acc[ai][bj][m][0]), "+v"(acc[ai][bj][m][1]) :: "memory"); } }
    }
    __device__ __forceinline__ void operator()(const f32x4 (&acc)[2][2][4][2], const Unit& u, int wr, int wc, int fr, int fq) const {
        int row0 = u.pm * 256 + wr * 64 + fr, col0 = u.pn * 256 + wc * 32 + 8 * fq; const bf16* Zl = Z;
        asm volatile("" : "+v"(row0), "+v"(col0), "+s"(Zl));
#pragma unroll
        for (int ai = 0; ai < 2; ++ai)
#pragma unroll
            for (int m = 0; m < 4; ++m) { const int row = row0 + ai * 128 + m * 16;
#pragma unroll
                for (int bj = 0; bj < 2; ++bj) { const int col = col0 + bj * 128;
                    const v4u gz = *(const v4u*)(Zl + (size_t)row * ZW + ZC_GATE + 2 * 1024 + col);
                    f32x4 v0 = acc[ai][bj][m][0], v1 = acc[ai][bj][m][1];
                    v0[0] *= __builtin_amdgcn_rcpf(1.f + en(bflo(gz.x))); v0[1] *= __builtin_amdgcn_rcpf(1.f + en(bfhi(gz.x))); v0[2] *= __builtin_amdgcn_rcpf(1.f + en(bflo(gz.y))); v0[3] *= __builtin_amdgcn_rcpf(1.f + en(bfhi(gz.y)));
                    v1[0] *= __builtin_amdgcn_rcpf(1.f + en(bflo(gz.z))); v1[1] *= __builtin_amdgcn_rcpf(1.f + en(bfhi(gz.z))); v1[2] *= __builtin_amdgcn_rcpf(1.f + en(bflo(gz.w))); v1[3] *= __builtin_amdgcn_rcpf(1.f + en(bfhi(gz.w)));
                    v4u w; w.x = cvt_pk_bf16(v0[0], v0[1]); w.y = cvt_pk_bf16(v0[2], v0[3]); w.z = cvt_pk_bf16(v1[0], v1[1]); w.w = cvt_pk_bf16(v1[2], v1[3]);
                    *(v4u*)(MERGED + (size_t)row * DM + col) = w; } }
    }
};
struct EpiWo : EpiBase {
    static constexpr bool PERM = false;
    const float* xin; float* xout; const float* gate; float* SSP;
    __device__ __forceinline__ void operator()(const f32x4 (&acc)[2][2][4][2], const Unit& u, int wr, int wc, int fr, int fq) const {
        const int row0 = u.pm * 256 + wr * 64 + fr, col0 = u.pn * 256 + wc * 32 + 4 * fq;
#pragma unroll
        for (int ai = 0; ai < 2; ++ai)
#pragma unroll
            for (int m = 0; m < 4; ++m) { const int row = row0 + ai * 128 + m * 16; const int b = row / NT; float ss = 0.f;
#pragma unroll
                for (int bj = 0; bj < 2; ++bj)
#pragma unroll
                    for (int n = 0; n < 2; ++n) { const int col = col0 + bj * 128 + n * 16;
                        const f32x4 g4 = *(const f32x4*)(gate + (size_t)b * 6144 + col); const f32x4 x4 = *(const f32x4*)(xin + (size_t)row * DM + col);
                        const f32x4 o = x4 + g4 * acc[ai][bj][m][n]; *(f32x4*)(xout + (size_t)row * DM + col) = o; ss += (o[0] * o[0] + o[1] * o[1]) + (o[2] * o[2] + o[3] * o[3]); }
                ss += __shfl_xor(ss, 16); ss += __shfl_xor(ss, 32);
                if (fq == 0) SSP[(size_t)row * 16 + u.pn * 4 + wc] = ss; }
    }
};
struct EpiMoe1 : EpiBase {
    static constexpr bool PERM = true, GATHER = true;
    const float* bgu; bf16* ACT;
    const int* ROWTOK; const LAS int* tb; const LAS int* cnt;
    __device__ __forceinline__ int row_src(const Unit& u, int R) const { const int e = u.pn >> 3; const int r = (u.pm - tb[e]) * 256 + R; return r < cnt[e] ? ROWTOK[e * M + r] : M; }
    typedef float f32x2 __attribute__((ext_vector_type(2)));
    static __device__ __forceinline__ f32x2 act2(f32x2 g, f32x2 u) {
        f32x2 gg, uu; gg.x = fminf(g.x, 7.f); gg.y = fminf(g.y, 7.f); uu.x = __builtin_amdgcn_fmed3f(u.x, -7.f, 7.f); uu.y = __builtin_amdgcn_fmed3f(u.y, -7.f, 7.f);
        const f32x2 t = gg * (-1.702f * 1.4426950408889634f); f32x2 e; e.x = __builtin_amdgcn_exp2f(t.x); e.y = __builtin_amdgcn_exp2f(t.y);
        const f32x2 d = e + 1.0f; f32x2 r; r.x = __builtin_amdgcn_rcpf(d.x); r.y = __builtin_amdgcn_rcpf(d.y);
        return (uu + 1.0f) * (gg * r);
    }
    __device__ __forceinline__ void operator()(const f32x4 (&acc)[2][2][4][2], const Unit& u, int wr, int wc, int fr, int fq) const {
        const int e = u.pn >> 3, ct = u.pn & 7;
        const int row0 = u.pm * 256 + wr * 64 + fr, j0 = ct * 128 + wc * 32 + 8 * fq;
        const float* bg = bgu + (size_t)e * 2048 + j0;
        const f32x4 bg0 = *(const f32x4*)bg, bg1 = *(const f32x4*)(bg + 4), bu0 = *(const f32x4*)(bg + 1024), bu1 = *(const f32x4*)(bg + 1028);
#pragma unroll
        for (int ai = 0; ai < 2; ++ai)
#pragma unroll
            for (int m = 0; m < 4; ++m) { const int row = row0 + ai * 128 + m * 16;
                const f32x4 g0 = acc[ai][0][m][0] + bg0, g1 = acc[ai][0][m][1] + bg1, u0 = acc[ai][1][m][0] + bu0, u1 = acc[ai][1][m][1] + bu1;
                const f32x2 o0 = act2((f32x2){g0[0], g0[1]}, (f32x2){u0[0], u0[1]}), o1 = act2((f32x2){g0[2], g0[3]}, (f32x2){u0[2], u0[3]});
                const f32x2 o2 = act2((f32x2){g1[0], g1[1]}, (f32x2){u1[0], u1[1]}), o3 = act2((f32x2){g1[2], g1[3]}, (f32x2){u1[2], u1[3]});
                v4u w; w.x = cvt_pk_bf16(o0.x, o0.y); w.y = cvt_pk_bf16(o1.x, o1.y); w.z = cvt_pk_bf16(o2.x, o2.y); w.w = cvt_pk_bf16(o3.x, o3.y);
                *(v4u*)(ACT + (size_t)row * DFF + j0) = w; }
    }
};
struct EpiMoe2 : EpiBase {
    static constexpr bool PERM = true;
    const float* bd; bf16* YS;
    __device__ __forceinline__ void operator()(const f32x4 (&acc)[2][2][4][2], const Unit& u, int wr, int wc, int fr, int fq) const {
        const int e = u.pn >> 2, ct = u.pn & 3;
        const int row0 = u.pm * 256 + wr * 64 + fr, col0 = ct * 256 + wc * 32 + 8 * fq;
#pragma unroll
        for (int bj = 0; bj < 2; ++bj) { const float* bp = bd + (size_t)e * 1024 + col0 + bj * 128; const f32x4 b0 = *(const f32x4*)bp, b1 = *(const f32x4*)(bp + 4);
#pragma unroll
            for (int ai = 0; ai < 2; ++ai)
#pragma unroll
                for (int m = 0; m < 4; ++m) { const int row = row0 + ai * 128 + m * 16; const f32x4 v0 = acc[ai][bj][m][0] + b0, v1 = acc[ai][bj][m][1] + b1;
                    v4u w; w.x = cvt_pk_bf16(v0[0], v0[1]); w.y = cvt_pk_bf16(v0[2], v0[3]); w.z = cvt_pk_bf16(v1[0], v1[1]); w.w = cvt_pk_bf16(v1[2], v1[3]);
                    *(v4u*)(YS + (size_t)row * DM + col0 + bj * 128) = w; } }
    }
};

template <class Map>
__device__ __forceinline__ void transpose_item(const float* W, int K, int N, bf16* WT, LAS float* scr, int kb, int nb, int lane, Map map) {
    const int k0 = 64 * kb, n0 = 32 * nb;
    const int sc = map(n0 + (lane & 31));
    { float v[32]; const int scc = sc >= 0 ? sc : 0; const float msk = sc >= 0 ? 1.f : 0.f;
#pragma unroll
      for (int i = 0; i < 32; ++i) v[i] = W[(size_t)(k0 + 2 * i + (lane >> 5)) * N + scc];
#pragma unroll
      for (int i = 0; i < 32; ++i) scr[(2 * i + (lane >> 5)) * 33 + (lane & 31)] = v[i] * msk; }
    LDS_WAIT(); asm volatile("" ::: "memory");
    const int c = lane & 7;
#pragma unroll
    for (int j = 0; j < 4; ++j) { const int n = (lane >> 3) + 8 * j; const LAS float* s = scr + (8 * c) * 33 + n;
        v4u o; o.x = pk2(s[0 * 33], s[1 * 33]); o.y = pk2(s[2 * 33], s[3 * 33]); o.z = pk2(s[4 * 33], s[5 * 33]); o.w = pk2(s[6 * 33], s[7 * 33]);
        *(v4u*)(WT + (size_t)(n0 + n) * K + k0 + 8 * c) = o; }
    LDS_WAIT(); asm volatile("" ::: "memory");
}
struct MapWin { __device__ __forceinline__ int operator()(int d) const {
    if (d < 1408) return d; if (d < 1416) return 2944 + (d - 1408); if (d < 1536) return -1; if (d < 3072) return 1408 + (d - 1536); return 2952 + (d - 3072); } };
struct MapId { __device__ __forceinline__ int operator()(int d) const { return d; } };
struct MapGU { __device__ __forceinline__ int operator()(int d) const { const int ct = d >> 8, w = d & 255; return w < 128 ? ct * 128 + w : 1024 + ct * 128 + (w - 128); } };

__device__ __forceinline__ void p_convert(Frame& F) {
    LAS float* scr = (LAS float*)(F.lds + F.wave * 16384);
    constexpr int I_WIN = 16 * 192, I_SQ = 16 * 32, I_GU = 16 * 64;
    constexpr int N_WIN = NL * I_WIN, N_BR = NL * I_SQ, N_WO = NL * I_SQ, N_GU = NL * NE * I_GU, N_D = NL * NE * I_SQ;
    constexpr int NITEMS = N_WIN + N_BR + N_WO + N_GU + N_D;
    for (int it = F.gw; it < NITEMS; it += F.ngw) {
        int r = it;
        if (r < N_WIN) { const int l = r / I_WIN, q = r % I_WIN; transpose_item(F.in(4) + (size_t)l * DM * INW, DM, INW, (bf16*)(F.ws() + WS_WIN) + (size_t)l * ZW * DM, scr, q / 192, q % 192, F.lane, MapWin()); continue; } r -= N_WIN;
        if (r < N_BR) { const int l = r / I_SQ, q = r % I_SQ; transpose_item(F.in(22) + (size_t)l * DM * DM, DM, DM, (bf16*)(F.ws() + WS_WBR) + (size_t)l * DM * DM, scr, q / 32, q % 32, F.lane, MapId()); continue; } r -= N_BR;
        if (r < N_WO) { const int l = r / I_SQ, q = r % I_SQ; transpose_item(F.in(23) + (size_t)l * DM * DM, DM, DM, (bf16*)(F.ws() + WS_WO) + (size_t)l * DM * DM, scr, q / 32, q % 32, F.lane, MapId()); continue; } r -= N_WO;
        if (r < N_GU) { const int le = r / I_GU, q = r % I_GU; transpose_item(F.in(26) + (size_t)le * DM * 2048, DM, 2048, (bf16*)(F.ws() + WS_WGU) + (size_t)le * 2048 * DM, scr, q / 64, q % 64, F.lane, MapGU()); continue; } r -= N_GU;
        { const int le = r / I_SQ, q = r % I_SQ; transpose_item(F.in(28) + (size_t)le * DFF * DM, DFF, DM, (bf16*)(F.ws() + WS_WD) + (size_t)le * DM * DFF, scr, q / 32, q % 32, F.lane, MapId()); }
    }
}
__device__ __forceinline__ void p_mod(Frame& F) {
    LAS float* sc = (LAS float*)(F.lds);
    LAS float* part = (LAS float*)(F.lds + 16384);
    const float* c = F.in(1);
    for (int i = F.tid; i < NB * DM; i += NTHR) { const float v = c[i]; sc[i] = v * sigmoidf_(v); }
    __syncthreads();
    float* MOD = (float*)(F.ws() + WS_MOD);
    for (int un = F.bid; un < NL * 96; un += F.G) {
        const int l = un / 96, n0 = (un % 96) * 64, n = n0 + F.lane, kq = F.wave;
        const float* W = F.in(2) + (size_t)l * DM * 6144 + n;
        float a0 = 0.f, a1 = 0.f, a2 = 0.f, a3 = 0.f;
#pragma unroll 8
        for (int k = kq * 128; k < kq * 128 + 128; ++k) { const float w = W[(size_t)k * 6144]; a0 += w * sc[k]; a1 += w * sc[1024 + k]; a2 += w * sc[2048 + k]; a3 += w * sc[3072 + k]; }
        part[(kq * 4 + 0) * 64 + F.lane] = a0; part[(kq * 4 + 1) * 64 + F.lane] = a1; part[(kq * 4 + 2) * 64 + F.lane] = a2; part[(kq * 4 + 3) * 64 + F.lane] = a3;
        __syncthreads();
        if (F.tid < 256) { const int b = F.tid >> 6, cn = F.tid & 63; float s = 0.f;
#pragma unroll
            for (int q = 0; q < 8; ++q) s += part[(q * 4 + b) * 64 + cn];
            MOD[((size_t)l * NB + b) * 6144 + n0 + cn] = s + F.in(3)[(size_t)l * 6144 + n0 + cn]; }
        __syncthreads();
    }
}
__device__ __forceinline__ void norm_row_store(const f32x4 (&v)[4], float rs, const float* shift, const float* scale, bf16* orow, int lane) {
#pragma unroll
    for (int j = 0; j < 4; ++j) { const int c = 4 * lane + 256 * j; const f32x4 sh = *(const f32x4*)(shift + c), sc = *(const f32x4*)(scale + c);
        const f32x4 o = v[j] * rs * (sc + 1.f) + sh; v2u w; w.x = pk2(o[0], o[1]); w.y = pk2(o[2], o[3]); *(v2u*)(orow + c) = w; }
}
__device__ __forceinline__ void p_norm_rows(Frame& F, const float* x, const float* modl  , int shift_off, int scale_off) {
    bf16* XN = (bf16*)(F.ws() + WS_XN);
    if (F.gw == 0) { v4u z = {0u, 0u, 0u, 0u}; ((v4u*)(XN + (size_t)M * DM))[F.lane] = z; ((v4u*)(XN + (size_t)M * DM))[64 + F.lane] = z; }
    for (int row = F.gw; row < M; row += F.ngw) {
        const f32x4* xr = (const f32x4*)(x + (size_t)row * DM) + F.lane; f32x4 v[4]; float s = 0.f;
#pragma unroll
        for (int j = 0; j < 4; ++j) { v[j] = xr[64 * j]; s += (v[j][0] * v[j][0] + v[j][1] * v[j][1]) + (v[j][2] * v[j][2] + v[j][3] * v[j][3]); }
        const float rs = rsq_(wave_sum(s) * (1.f / DM) + 1e-6f);
        const float* mb = modl + (size_t)(row / NT) * 6144;
        norm_row_store(v, rs, mb + shift_off, mb + scale_off, XN + (size_t)row * DM, F.lane);
    }
}

__device__ __forceinline__ void ld4bf(const bf16* p, float (&o)[4]) { const v2u w = *(const v2u*)p; o[0] = bflo(w.x); o[1] = bfhi(w.x); o[2] = bflo(w.y); o[3] = bfhi(w.y); }
__device__ __forceinline__ void p_prep(Frame& F, int l, bool dummy, int g_begin, int g_step, int g_end) {
    bf16* Z = (bf16*)(F.ws() + WS_Z); const size_t zd = dummy ? (WS_XS - WS_Z) / 2 : 0;
    float* RWB = (float*)(F.ws() + WS_RW);
    const size_t TS = (size_t)M * 256;
    float *R_ = RWB, *KP_ = RWB + TS, *VV_ = RWB + 2 * TS, *AV_ = RWB + 3 * TS, *BV_ = RWB + 4 * TS, *WD_ = RWB + 5 * TS, *GG_ = RWB + 6 * TS;
    const float* FL = (const float*)(F.ws() + WS_FLOGIT); float* LOGF = (float*)(F.ws() + WS_LOGF);
    const float* vgain = F.in(5) + (size_t)l * 256;
    const float* mu = F.in(8) + (size_t)l * 896;
    const float* w0 = F.in(9) + (size_t)l * 256; const float* w2 = F.in(10) + (size_t)l * 32 * 256;
    const float* a0 = F.in(11) + (size_t)l * 256; const float* a2 = F.in(12) + (size_t)l * 32 * 256;
    const float* g2 = F.in(13) + (size_t)l * 64 * 256;
    const float* k_k = F.in(14) + (size_t)l * 256; const float* k_a = F.in(15) + (size_t)l * 256;
    const float* fbias = F.in(19) + (size_t)l * 8; const float* qgain = F.in(20) + (size_t)l * 64; const float* kgain = F.in(21) + (size_t)l * 64;
    LAS float* wl = (LAS float*)F.lds;
    LAS float* scr = (LAS float*)(F.lds + 131072 + F.wave * 2048);
    const int lane = F.lane, c4 = 4 * lane;
    __syncthreads();
    for (int idx = F.tid; idx < 128 * 64; idx += NTHR) { const int row = idx >> 6, q4 = idx & 63;
        const float* src = row < 32 ? w2 + row * 256 : row < 64 ? a2 + (row - 32) * 256 : g2 + (row - 64) * 256;
        *(LAS f32x4*)(wl + row * 256 + 4 * q4) = *(const f32x4*)(src + 4 * q4); }
    __syncthreads();
    for (int grp = g_begin; grp < g_end; grp += g_step) {
        float k4[4][4];
#pragma unroll
        for (int tk = 0; tk < 4; ++tk) {
            const int tok = 4 * grp + tk; float r4[4], v4[4];
            bf16* zr = Z + (size_t)tok * ZW; const bool hasprev = (tok % NT) != 0; const bf16* zp = hasprev ? zr - ZW : zr; const float pm = hasprev ? 1.f : 0.f;
            { float u[4]; ld4bf(zr + ZC_U + c4, u); v2u w; w.x = pk2(gelu_tanh(u[0]), gelu_tanh(u[1])); w.y = pk2(gelu_tanh(u[2]), gelu_tanh(u[3])); *(v2u*)(zr + zd + ZC_U + c4) = w;
              float v[4]; ld4bf(zr + ZC_V + c4, v); float ss = 0.f;
#pragma unroll
              for (int i = 0; i < 4; ++i) { v[i] = gelu_tanh(v[i]); ss += v[i] * v[i]; }
              const float rs = rsq_(wave_sum(ss) * (1.f / 256.f) + 1e-6f); const f32x4 gn = *(const f32x4*)(vgain + c4);
              w.x = pk2(v[0] * rs * gn[0], v[1] * rs * gn[1]); w.y = pk2(v[2] * rs * gn[2], v[3] * rs * gn[3]); *(v2u*)(zr + zd + ZC_V + c4) = w; }
            { float cur[4], prv[4]; f32x4 m4;
              ld4bf(zr + ZC_R + c4, cur); ld4bf(zp + ZC_R + c4, prv); m4 = *(const f32x4*)(mu + c4);
#pragma unroll
              for (int i = 0; i < 4; ++i) r4[i] = cur[i] + m4[i] * (pm * prv[i] - cur[i]);
              ld4bf(zr + ZC_R + 256 + c4, cur); ld4bf(zp + ZC_R + 256 + c4, prv); m4 = *(const f32x4*)(mu + 256 + c4);
#pragma unroll
              for (int i = 0; i < 4; ++i) k4[tk][i] = cur[i] + m4[i] * (pm * prv[i] - cur[i]);
              ld4bf(zr + ZC_R + 512 + c4, cur); ld4bf(zp + ZC_R + 512 + c4, prv); m4 = *(const f32x4*)(mu + 512 + c4);
#pragma unroll
              for (int i = 0; i < 4; ++i) v4[i] = cur[i] + m4[i] * (pm * prv[i] - cur[i]);
              *(f32x4*)(R_ + (size_t)tok * 256 + c4) = (f32x4){r4[0], r4[1], r4[2], r4[3]}; *(f32x4*)(VV_ + (size_t)tok * 256 + c4) = (f32x4){v4[0], v4[1], v4[2], v4[3]};
              if (lane < 32) { ld4bf(zr + ZC_LORA + c4, cur); ld4bf(zp + ZC_LORA + c4, prv); m4 = *(const f32x4*)(mu + 768 + c4);
                  f32x4 o4;
#pragma unroll
                  for (int i = 0; i < 4; ++i) { const float x = cur[i] + m4[i] * (pm * prv[i] - cur[i]);
                      const float r_ = rcp_(1.f + __expf(lane < 8 ? 2.f * x : -x));
                      o4[i] = lane < 8 ? 1.f - 2.f * r_ : (lane >= 16 ? r_ : x); }
                  *(LAS f32x4*)(scr + tk * 128 + c4) = o4; }
            }
#pragma unroll
            for (int qk = 0; qk < 2; ++qk) {
                bf16* p = zr + (qk == 0 ? ZC_Q : ZC_KF) + 8 * lane; const v4u w = *(const v4u*)p;
                float x[8] = {bflo(w.x), bfhi(w.x), bflo(w.y), bfhi(w.y), bflo(w.z), bfhi(w.z), bflo(w.w), bfhi(w.w)}; float ss = 0.f;
#pragma unroll
                for (int i = 0; i < 8; ++i) ss += x[i] * x[i];
                ss = dpp_add<0xB1>(ss); ss = dpp_add<0x4E>(ss); ss = dpp_add<0x141>(ss);
                const float rs = rsq_(ss * (1.f / 64.f) + 1e-6f) * (qk == 0 ? QSCALE : 1.f);
                const float* gp = (qk == 0 ? qgain : kgain) + 8 * (lane & 7); const f32x4 g0 = *(const f32x4*)gp, g1 = *(const f32x4*)(gp + 4);
                v4u o; o.x = pk2(x[0] * rs * g0[0], x[1] * rs * g0[1]); o.y = pk2(x[2] * rs * g0[2], x[3] * rs * g0[3]); o.z = pk2(x[4] * rs * g1[0], x[5] * rs * g1[1]); o.w = pk2(x[6] * rs * g1[2], x[7] * rs * g1[3]);
                *(v4u*)(p + zd) = o;
            }
            if (lane < 8) { const float f = FL[(size_t)tok * 8 + lane] + fbias[lane]; LOGF[(size_t)tok * 8 + lane] = (fminf(f, 0.f) - __logf(1.f + __expf(-fabsf(f)))) * LOG2E; }
            asm volatile("" ::: "memory");
        }
        LDS_WAIT(); asm volatile("" ::: "memory");
        f32x4 aw[4], aa[4], ag[4];
#pragma unroll
        for (int tk = 0; tk < 4; ++tk) { aw[tk] = (f32x4){0.f, 0.f, 0.f, 0.f}; aa[tk] = aw[tk]; ag[tk] = aw[tk]; }
        int c4m = c4; asm volatile("" : "+v"(c4m));
#pragma unroll 2
        for (int j = 0; j < 32; j += 4) {
            f32x4 wv[4], av_[4];
#pragma unroll
            for (int q = 0; q < 4; ++q) { wv[q] = *(const LAS f32x4*)(wl + (j + q) * 256 + c4m); av_[q] = *(const LAS f32x4*)(wl + (32 + j + q) * 256 + c4m); }
#pragma unroll
            for (int tk = 0; tk < 4; ++tk) { const f32x4 sw = *(const LAS f32x4*)(scr + tk * 128 + j), sa = *(const LAS f32x4*)(scr + tk * 128 + 32 + j);
#pragma unroll
                for (int q = 0; q < 4; ++q) { aw[tk] += sw[q] * wv[q]; aa[tk] += sa[q] * av_[q]; } } }
#pragma unroll 2
        for (int j = 0; j < 64; j += 4) {
            f32x4 gv[4];
#pragma unroll
            for (int q = 0; q < 4; ++q) gv[q] = *(const LAS f32x4*)(wl + (64 + j + q) * 256 + c4m);
#pragma unroll
            for (int tk = 0; tk < 4; ++tk) { const f32x4 sg = *(const LAS f32x4*)(scr + tk * 128 + 64 + j);
#pragma unroll
                for (int q = 0; q < 4; ++q) ag[tk] += sg[q] * gv[q]; } }
        asm volatile("" ::: "memory");
        const f32x4 w04 = *(const f32x4*)(w0 + c4m), a04 = *(const f32x4*)(a0 + c4m), kk4 = *(const f32x4*)(k_k + c4m), ka4 = *(const f32x4*)(k_a + c4m);
#pragma unroll
        for (int tk = 0; tk < 4; ++tk) {
            f32x4 dec, av, kkv, kp; float ss = 0.f;
#pragma unroll
            for (int i = 0; i < 4; ++i) { const float uu = w04[i] + aw[tk][i]; const float wlog = -softplusf_(-uu) - 0.5f; dec[i] = __expf(-__expf(wlog));
                av[i] = sigmoidf_(a04[i] + aa[tk][i]); kkv[i] = k4[tk][i] * kk4[i]; ss += kkv[i] * kkv[i]; kp[i] = k4[tk][i] * (1.f + (av[i] - 1.f) * ka4[i]); }
            ss = dpp_add<0xB1>(ss); ss = dpp_add<0x4E>(ss); ss = dpp_add<0x141>(ss); ss = dpp_add<0x140>(ss);
            const float inv = rsq_(fmaxf(ss, 1e-24f));
            f32x4 nkk, bv;
#pragma unroll
            for (int i = 0; i < 4; ++i) { const float q = kkv[i] * inv; nkk[i] = -q; bv[i] = q * av[i]; }
            const size_t o = (size_t)(4 * grp + tk) * 256 + c4m;
            *(f32x4*)(KP_ + o) = kp;
            *(f32x4*)(AV_ + o) = nkk; *(f32x4*)(BV_ + o) = bv; *(f32x4*)(WD_ + o) = dec; *(f32x4*)(GG_ + o) = ag[tk];
        }
        LDS_WAIT(); asm volatile("" ::: "memory");
    }
}

typedef float f32x2 __attribute__((ext_vector_type(2)));
__device__ __forceinline__ void p_rwkv_pass1(Frame& F, int un_begin, int un_step, int un_end) {
    const float* RWB = (const float*)(F.ws() + WS_RW); const size_t TS = (size_t)M * 256;
    float* Y0 = (float*)(F.ws() + WS_Y0); float* RT = (float*)(F.ws() + WS_RT);
    float* S0E = (float*)(F.ws() + WS_S0END); float* PE = (float*)(F.ws() + WS_PEND);
    LAS float* sh = (LAS float*)F.lds;
    constexpr int NBATCH = RWC / 4;
    const int sub = F.wave >> 2, h = F.wave & 3, i = F.lane, tid0 = F.tid;
    for (int un = un_begin; un < un_end; un += un_step) {
        const int tok0 = un * 2 * RWC;
        int ii = i; asm volatile("" : "+v"(ii));
        const int rg = ii >> 2, cs = ii & 3;
        float S[64], P[64];
#pragma unroll
        for (int j = 0; j < 64; ++j) { S[j] = 0.f; P[j] = (16 * ((j >> 2) & 3) + 4 * cs + (j & 3) == 4 * rg + (j >> 4)) ? 1.f : 0.f; }
#define RW1_SRC(r, batch) (RWB + (size_t)((((tid + 512 * (r)) >> 8) % 6)) * TS + (size_t)(tok0 + ((tid + 512 * (r)) / 1536) * RWC + (batch) * 4 + (((tid + 512 * (r)) >> 6) & 3)) * 256 + ((tid + 512 * (r)) & 63) * 4)
#define RW1_DMA(batch) do { int tid = tid0; asm volatile("" : "+v"(tid)); _Pragma("unroll") for (int r = 0; r < 6; ++r) __builtin_amdgcn_global_load_lds((const unsigned*)RW1_SRC(r, batch), (LAS unsigned*)(F.lds + ((batch) & 1) * 49152 + (F.wave * 64 + 512 * r) * 16), 16, 0, 0); } while (0)
#define FMAC(acc, a, b) asm("v_fmac_f32 %0, %1, %2" : "+v"(acc) : "v"(a), "v"(b))
#define FMA3(d, a, b, c) asm("v_fma_f32 %0, %1, %2, %3" : "=v"(d) : "v"(a), "v"(b), "v"(c))
#define MUL2(d, a, b) asm("v_mul_f32 %0, %1, %2" : "=v"(d) : "v"(a), "v"(b))
        __syncthreads();
        RW1_DMA(0);
        for (int batch = 0; batch < NBATCH; ++batch) {
            if (batch == 0) asm volatile("s_waitcnt vmcnt(0)" ::: "memory");
            else asm volatile("s_waitcnt vmcnt(8)" ::: "memory");
            __syncthreads();
            if (batch + 1 < NBATCH) RW1_DMA(batch + 1);
            const LAS float* cb = sh + (batch & 1) * 12288 + sub * (6 * 4 * 256) + h * 64;
#pragma unroll 1
            for (int st = 0; st < 4; ++st) {
                const LAS float* rr = cb + 0 * 1024 + st * 256; const LAS float* kk = cb + 1 * 1024 + st * 256; const LAS float* vv = cb + 2 * 1024 + st * 256;
                const LAS float* av = cb + 3 * 1024 + st * 256; const LAS float* bv = cb + 4 * 1024 + st * 256; const LAS float* wd = cb + 5 * 1024 + st * 256;
                const f32x4 v4 = *(const LAS f32x4*)(vv + 4 * rg);
                float aS[4] = {0.f, 0.f, 0.f, 0.f}, aP[4] = {0.f, 0.f, 0.f, 0.f};
#pragma unroll
                for (int q = 0; q < 4; ++q) { const f32x4 a4 = *(const LAS f32x4*)(av + 16 * q + 4 * cs);
#pragma unroll
                    for (int e = 0; e < 4; ++e) {
#pragma unroll
                        for (int ri = 0; ri < 4; ++ri) {
                            if (q == 3 && e == 3) { aS[ri] = __builtin_fmaf(S[ri * 16 + 15], a4[3], aS[ri]); aP[ri] = __builtin_fmaf(P[ri * 16 + 15], a4[3], aP[ri]); }
                            else { FMAC(aS[ri], S[ri * 16 + q * 4 + e], a4[e]); FMAC(aP[ri], P[ri * 16 + q * 4 + e], a4[e]); } } } }
                float saS[4], saP[4];
#pragma unroll
                for (int ri = 0; ri < 4; ++ri) { saS[ri] = quad_sum(aS[ri]); saP[ri] = quad_sum(aP[ri]); }
                float yS[4] = {0.f, 0.f, 0.f, 0.f}, yP[4] = {0.f, 0.f, 0.f, 0.f};
#pragma unroll
                for (int q = 0; q < 4; ++q) {
                    const f32x4 w4 = *(const LAS f32x4*)(wd + 16 * q + 4 * cs), b4 = *(const LAS f32x4*)(bv + 16 * q + 4 * cs), k4 = *(const LAS f32x4*)(kk + 16 * q + 4 * cs), r4 = *(const LAS f32x4*)(rr + 16 * q + 4 * cs);
#pragma unroll
                    for (int e = 0; e < 4; ++e) { float tS[4], tP[4];
#pragma unroll
                        for (int ri = 0; ri < 4; ++ri) { MUL2(tS[ri], saS[ri], b4[e]); MUL2(tP[ri], saP[ri], b4[e]); }
#pragma unroll
                        for (int ri = 0; ri < 4; ++ri) FMAC(tS[ri], v4[ri], k4[e]);
#pragma unroll
                        for (int ri = 0; ri < 4; ++ri) { FMA3(S[ri * 16 + q * 4 + e], S[ri * 16 + q * 4 + e], w4[e], tS[ri]); FMA3(P[ri * 16 + q * 4 + e], P[ri * 16 + q * 4 + e], w4[e], tP[ri]); }
#pragma unroll
                        for (int ri = 0; ri < 4; ++ri) {
                            if (q == 3 && e == 3) { yS[ri] = __builtin_fmaf(S[ri * 16 + 15], r4[3], yS[ri]); yP[ri] = __builtin_fmaf(P[ri * 16 + 15], r4[3], yP[ri]); }
                            else { FMAC(yS[ri], S[ri * 16 + q * 4 + e], r4[e]); FMAC(yP[ri], P[ri * 16 + q * 4 + e], r4[e]); } } } }
#pragma unroll
                for (int ri = 0; ri < 4; ++ri) { yS[ri] = quad_sum(yS[ri]); yP[ri] = quad_sum(yP[ri]); }
                const float yo = (cs == 0) ? yS[0] : (cs == 1) ? yS[1] : (cs == 2) ? yS[2] : yS[3], ro = (cs == 0) ? yP[0] : (cs == 1) ? yP[1] : (cs == 2) ? yP[2] : yP[3];
                int il = i; asm volatile("" : "+v"(il));
                const unsigned o = (unsigned)(tok0 + sub * RWC + batch * 4 + st) * 256u + h * 64 + il;
                Y0[o] = yo; RT[o] = ro;
            }
        }
#undef FMAC
#undef FMA3
#undef MUL2
#undef RW1_SRC
#undef RW1_DMA
        const size_t sb = ((size_t)(un * 2 + sub) * 4 + h) * 4096;
        { int i2 = i; asm volatile("" : "+v"(i2)); const int rg = i2 >> 2, cs = i2 & 3;
#pragma unroll
        for (int ri = 0; ri < 4; ++ri) {
#pragma unroll
            for (int q = 0; q < 4; ++q) *(f32x4*)(S0E + sb + (size_t)(4 * rg + ri) * 64 + 16 * q + 4 * cs) = (f32x4){S[ri * 16 + q * 4], S[ri * 16 + q * 4 + 1], S[ri * 16 + q * 4 + 2], S[ri * 16 + q * 4 + 3]}; }
        { bf16* pt = (bf16*)((unsigned char*)PE + ((size_t)(un * 2 + sub) * 4 + h) * PIMG_BYTES) + 4 * rg;
#pragma unroll
          for (int jj = 0; jj < 16; ++jj) { const int j = 16 * (jj >> 2) + 4 * cs + (jj & 3); v2u vh, vl;
              vh.x = pk2(P[jj], P[16 + jj]); vh.y = pk2(P[32 + jj], P[48 + jj]);
              vl.x = pk2(P[jj] - bflo(vh.x), P[16 + jj] - bfhi(vh.x)); vl.y = pk2(P[32 + jj] - bflo(vh.y), P[48 + jj] - bfhi(vh.y));
              *(v2u*)(pt + j * 64) = vh; *(v2u*)(pt + 64 * 64 + j * 64) = vl; } } }
    }
}
__device__ __forceinline__ void p_rwkv_pass2(Frame& F, int first_block, int l) {
    typedef float f32x16 __attribute__((ext_vector_type(16)));
    typedef short bf16x8_t __attribute__((ext_vector_type(8)));
    const float* S0E = (const float*)(F.ws() + WS_S0END); const float* PE = (const float*)(F.ws() + WS_PEND); bf16* SST = (bf16*)(F.ws() + WS_SST);
    constexpr int LP = 72;
    constexpr int IMG = 64 * LP;
    constexpr int LF = 68, IMGF = 64 * LF;
    LAS bf16* SH = (LAS bf16*)F.lds;
    LAS bf16* PT = SH + 4 * IMG;
    LAS float* S0I = (LAS float*)(PT + 4 * IMG);
    const int bh = F.bid - first_block; if (bh < 0 || bh >= NB * NHR) return;
    const int b = bh / NHR, h = bh % NHR, tid = F.tid, lane = F.lane, w = F.wave;
    const int l31 = lane & 31, hi = lane >> 5, tJ = (w >> 1) & 1, tI = w & 1;
    const size_t cbase = ((size_t)(b * NCH) * 4 + h) * 4096;
    const unsigned char* pimg = (const unsigned char*)PE + ((size_t)(b * NCH) * 4 + h) * PIMG_BYTES;
    for (int idx = tid; idx < 2 * IMG; idx += NTHR) SH[idx] = 0;
    for (int ci = tid; ci < PIMG_BYTES / 16; ci += NTHR) *(LAS v4u*)((LAS unsigned char*)PT + (ci >> 3) * 144 + (ci & 7) * 16) = *(const v4u*)(pimg + (size_t)ci * 16);
    for (int idx = tid; idx < 1024; idx += NTHR) *(LAS f32x4*)(S0I + (idx >> 4) * LF + 4 * (idx & 15)) = *(const f32x4*)(S0E + cbase + (size_t)idx * 4);
    __syncthreads();
    (void)l;
    if (w < 4) {
        const LAS bf16* ap0 = PT + (32 * tJ + l31) * LP + 8 * hi; const LAS bf16* bp0 = SH + (32 * tI + l31) * LP + 8 * hi;
        const LAS float* cp0 = S0I + (32 * tI + l31) * LF + 32 * tJ + 4 * hi;
        LAS bf16* sw0 = SH + (32 * tI + l31) * LP + 32 * tJ + 4 * hi;
        for (int c = 0; c < NCH; ++c) {
            const int cb = c & 1;
            f32x16 acc;
#pragma unroll
            for (int g = 0; g < 4; ++g) { const f32x4 t = *(const LAS f32x4*)(cp0 + cb * IMGF + 8 * g); acc[4 * g] = t[0]; acc[4 * g + 1] = t[1]; acc[4 * g + 2] = t[2]; acc[4 * g + 3] = t[3]; }
            const LAS bf16* ap = ap0 + cb * 2 * IMG; const LAS bf16* bp = bp0 + cb * 2 * IMG; bf16x8_t ah[4], al[4], bhh[4], bll[4];
#pragma unroll
            for (int s = 0; s < 4; ++s) { ah[s] = *(const LAS bf16x8_t*)(ap + 16 * s); al[s] = *(const LAS bf16x8_t*)(ap + IMG + 16 * s); bhh[s] = *(const LAS bf16x8_t*)(bp + 16 * s); bll[s] = *(const LAS bf16x8_t*)(bp + IMG + 16 * s); }
#pragma unroll
            for (int s = 0; s < 4; ++s) { acc = __builtin_amdgcn_mfma_f32_32x32x16_bf16(ah[s], bhh[s], acc, 0, 0, 0); acc = __builtin_amdgcn_mfma_f32_32x32x16_bf16(ah[s], bll[s], acc, 0, 0, 0); acc = __builtin_amdgcn_mfma_f32_32x32x16_bf16(al[s], bhh[s], acc, 0, 0, 0); }
            LAS bf16* sw = sw0 + (cb ^ 1) * 2 * IMG;
#pragma unroll
            for (int g = 0; g < 4; ++g) { v2u vh, vl; vh.x = cvtpk_c(acc[4 * g], acc[4 * g + 1]); vh.y = cvtpk_c(acc[4 * g + 2], acc[4 * g + 3]);
                vl.x = cvtpk_c(acc[4 * g] - bflo(vh.x), acc[4 * g + 1] - bfhi(vh.x)); vl.y = cvtpk_c(acc[4 * g + 2] - bflo(vh.y), acc[4 * g + 3] - bfhi(vh.y));
                *(LAS v2u*)(sw + 8 * g) = vh; *(LAS v2u*)(sw + IMG + 8 * g) = vl; }
            asm volatile("s_waitcnt lgkmcnt(0)\n\ts_barrier" ::: "memory");
        }
    } else if (w < 6) {
        const int q = tid - 256;
        v4u pA[8], pB[8]; f32x4 sA[8], sB[8];
#define P2_LD(pv, sv, cc) do { const int cc_ = (cc) < NCH ? (cc) : NCH - 1; \
        _Pragma("unroll") for (int r = 0; r < 8; ++r) pv[r] = *(const v4u*)(pimg + (size_t)cc_ * 4 * PIMG_BYTES + (size_t)(q + 128 * r) * 16); \
        _Pragma("unroll") for (int r = 0; r < 8; ++r) sv[r] = *(const f32x4*)(S0E + cbase + (size_t)cc_ * 16384 + (size_t)(q + 128 * r) * 4); } while (0)
#define P2_ST(pv, sv, c_) do { if ((c_) + 1 < NCH) { const int nb_ = ((c_) & 1) ^ 1; LAS unsigned char* pn = (LAS unsigned char*)(PT + nb_ * 2 * IMG); LAS float* sn_ = S0I + nb_ * IMGF; \
            _Pragma("unroll") for (int r = 0; r < 8; ++r) { const int ci_ = q + 128 * r; *(LAS v4u*)(pn + (ci_ >> 3) * 144 + (ci_ & 7) * 16) = pv[r]; } \
            _Pragma("unroll") for (int r = 0; r < 8; ++r) { const int idx_ = q + 128 * r; *(LAS f32x4*)(sn_ + (idx_ >> 4) * LF + 4 * (idx_ & 15)) = sv[r]; } } \
        P2_LD(pv, sv, (c_) + 3); \
        asm volatile("s_waitcnt lgkmcnt(0)\n\ts_barrier" ::: "memory"); } while (0)
        P2_LD(pA, sA, 1); P2_LD(pB, sB, 2);
        for (int c = 0; c < NCH; c += 2) { P2_ST(pA, sA, c); P2_ST(pB, sB, c + 1); }
#undef P2_LD
#undef P2_ST
    } else {
        const int q = tid - 384;
        for (int c = 0; c < NCH; ++c) {
            const LAS bf16* sc = SH + (c & 1) * 2 * IMG;
#pragma unroll
            for (int r = 0; r < 4; ++r) { const int it_ = q + 128 * r, i_ = it_ >> 3, j8 = it_ & 7;
                *(v4u*)(SST + cbase + (size_t)c * 16384 + (size_t)i_ * 64 + 8 * j8) = *(const LAS v4u*)(sc + i_ * LP + 8 * j8); }
            asm volatile("s_waitcnt lgkmcnt(0)\n\ts_barrier" ::: "memory");
        }
    }
    __syncthreads();
}
__device__ __forceinline__ void p_rwkv_pass3(Frame& F, int l) {
    const float* RWB = (const float*)(F.ws() + WS_RW); const size_t TS = (size_t)M * 256;
    const float *R_ = RWB, *KP_ = RWB + TS, *VV_ = RWB + 2 * TS, *GG_ = RWB + 6 * TS;
    const float* Y0 = (const float*)(F.ws() + WS_Y0); const float* RT = (const float*)(F.ws() + WS_RT); const bf16* SST = (const bf16*)(F.ws() + WS_SST);
    bf16* YMIX = (bf16*)(F.ws() + WS_YMIX);
    const float* r_k = F.in(16) + (size_t)l * 256; const float* gng = F.in(17) + (size_t)l * 256; const float* gnb = F.in(18) + (size_t)l * 256;
    const int h = F.wave >> 1, half = F.wave & 1, i = F.lane, ch = h * 64 + i;
    const float rk = r_k[ch], gg = gng[ch], gb = gnb[ch];
    LAS float* rts = (LAS float*)F.lds;
    for (int un = F.bid; un < NB * NCH; un += F.G) {
        __syncthreads();
#pragma unroll
        for (int r = 0; r < RWC * 64 / NTHR; ++r) { const int idx = F.tid + NTHR * r; *(LAS f32x4*)(rts + idx * 4) = *(const f32x4*)(RT + (size_t)un * RWC * 256 + (size_t)idx * 4); }
        const bf16* srow = SST + ((size_t)un * 4 + h) * 4096 + (size_t)i * 64;
        float s[64];
#pragma unroll
        for (int j = 0; j < 64; j += 8) { const v4u t = *(const v4u*)(srow + j); s[j] = bflo(t.x); s[j + 1] = bfhi(t.x); s[j + 2] = bflo(t.y); s[j + 3] = bfhi(t.y); s[j + 4] = bflo(t.z); s[j + 5] = bfhi(t.z); s[j + 6] = bflo(t.w); s[j + 7] = bfhi(t.w); }
        __syncthreads();
#pragma unroll 1
        for (int t4 = 0; t4 < RWC / 2; t4 += 4) {
            float y0v[4], rv[4], kv[4], vv[4], gt[4];
#pragma unroll
            for (int q = 0; q < 4; ++q) { const size_t o = (size_t)(un * RWC + half * (RWC / 2) + t4 + q) * 256 + ch; y0v[q] = Y0[o]; rv[q] = R_[o]; kv[q] = KP_[o]; vv[q] = VV_[o]; gt[q] = GG_[o]; }
#pragma unroll
            for (int q = 0; q < 4; ++q) {
                const int tl = half * (RWC / 2) + t4 + q; const LAS float* rt = rts + tl * 256 + h * 64;
                float y0 = y0v[q], y1 = 0.f;
#pragma unroll
                for (int j = 0; j < 64; j += 4) { const f32x4 t = *(const LAS f32x4*)(rt + j); y0 += s[j] * t[0] + s[j + 2] * t[2]; y1 += s[j + 1] * t[1] + s[j + 3] * t[3]; }
                const float y = y0 + y1;
                const float mu = wave_sum(y) * (1.f / 64.f); const float d = y - mu; const float var = wave_sum(d * d) * (1.f / 64.f);
                const float yn = d * rsq_(var + 64e-5f) * gg + gb;
                const float dot = wave_sum(rv[q] * kv[q] * rk);
                const float out = (yn + dot * vv[q]) * gt[q];
                YMIX[(size_t)(un * RWC + tl) * DM + 256 + ch] = (bf16)f2bf(out);
            }
        }
    }
    __syncthreads();
}

__device__ __forceinline__ void p_gmlp_unit_valu(Frame& F, int l, int un) {
    const bf16* Z = (const bf16*)(F.ws() + WS_Z); bf16* YMIX = (bf16*)(F.ws() + WS_YMIX);
    const float* Ws = F.in(6) + (size_t)l * 4 * 128 * 128; const float* bs = F.in(7) + (size_t)l * 4 * 128;
    LAS float* WT = (LAS float*)F.lds;
    LAS bf16* Vs = (LAS bf16*)(F.lds + 65536);
    const int t = F.tid & 127, cq = F.tid >> 7;
    const int tok0 = un * 128;
    for (int g = 0; g < 4; ++g) {
        __syncthreads();
        for (int idx = F.tid; idx < 128 * 128; idx += NTHR) { const int tt = idx >> 7, ss = idx & 127; WT[ss * 128 + tt] = Ws[(size_t)g * 16384 + idx]; }
        for (int idx = F.tid; idx < 128 * 8; idx += NTHR) { const int ss = idx >> 3, c8 = idx & 7; *(LAS v4u*)(Vs + ss * 64 + c8 * 8) = *(const v4u*)(Z + (size_t)(tok0 + ss) * ZW + ZC_V + g * 64 + c8 * 8); }
        __syncthreads();
        float acc[16];
#pragma unroll
        for (int q = 0; q < 16; ++q) acc[q] = 0.f;
        const int smax = (t | 63);
        for (int s = 0; s <= smax; ++s) {
            const float w = (s <= t) ? WT[s * 128 + t] : 0.f;
            const v4u a = *(const LAS v4u*)(Vs + s * 64 + cq * 16), b = *(const LAS v4u*)(Vs + s * 64 + cq * 16 + 8);
            acc[0] += w * bflo(a.x); acc[1] += w * bfhi(a.x); acc[2] += w * bflo(a.y); acc[3] += w * bfhi(a.y); acc[4] += w * bflo(a.z); acc[5] += w * bfhi(a.z); acc[6] += w * bflo(a.w); acc[7] += w * bfhi(a.w);
            acc[8] += w * bflo(b.x); acc[9] += w * bfhi(b.x); acc[10] += w * bflo(b.y); acc[11] += w * bfhi(b.y); acc[12] += w * bflo(b.z); acc[13] += w * bfhi(b.z); acc[14] += w * bflo(b.w); acc[15] += w * bfhi(b.w);
        }
        const float bb = bs[g * 128 + t];
        const bf16* up = Z + (size_t)(tok0 + t) * ZW + ZC_U + g * 64 + cq * 16; const v4u u0 = *(const v4u*)up, u1 = *(const v4u*)(up + 8);
        v4u o0, o1;
        o0.x = pk2(bflo(u0.x) * (acc[0] + bb), bfhi(u0.x) * (acc[1] + bb)); o0.y = pk2(bflo(u0.y) * (acc[2] + bb), bfhi(u0.y) * (acc[3] + bb));
        o0.z = pk2(bflo(u0.z) * (acc[4] + bb), bfhi(u0.z) * (acc[5] + bb)); o0.w = pk2(bflo(u0.w) * (acc[6] + bb), bfhi(u0.w) * (acc[7] + bb));
        o1.x = pk2(bflo(u1.x) * (acc[8] + bb), bfhi(u1.x) * (acc[9] + bb)); o1.y = pk2(bflo(u1.y) * (acc[10] + bb), bfhi(u1.y) * (acc[11] + bb));
        o1.z = pk2(bflo(u1.z) * (acc[12] + bb), bfhi(u1.z) * (acc[13] + bb)); o1.w = pk2(bflo(u1.w) * (acc[14] + bb), bfhi(u1.w) * (acc[15] + bb));
        bf16* op = YMIX + (size_t)(tok0 + t) * DM + g * 64 + cq * 16; *(v4u*)op = o0; *(v4u*)(op + 8) = o1;
    }
    __syncthreads();
}

__device__ __forceinline__ void p_gmlp_unit(Frame& F, int l, int un) {
    typedef float f32x16 __attribute__((ext_vector_type(16)));
    typedef short bf16x8_t __attribute__((ext_vector_type(8)));
    const bf16* Z = (const bf16*)(F.ws() + WS_Z); bf16* YMIX = (bf16*)(F.ws() + WS_YMIX);
    const float* Ws = F.in(6) + (size_t)l * 4 * 128 * 128; const float* bs = F.in(7) + (size_t)l * 4 * 128;
    constexpr int LV = 136;
    LAS bf16* Vt = (LAS bf16*)F.lds;
    const int tid = F.tid, lane = F.lane, w = F.wave, l31 = lane & 31, hi = lane >> 5, mt = w >> 1, nt = w & 1;
    const int tok0 = un * 128;
    __syncthreads();
#pragma unroll
    for (int it = 0; it < 8; ++it) { const int s = (tid & 63) + 64 * (it & 1), c8 = (tid >> 6) + 8 * (it >> 1);
        const v4u v = *(const v4u*)(Z + (size_t)(tok0 + s) * ZW + ZC_V + c8 * 8); LAS bf16* d = Vt + (c8 * 8) * LV + s;
        d[0] = (bf16)(v.x & 0xffffu); d[LV] = (bf16)(v.x >> 16); d[2 * LV] = (bf16)(v.y & 0xffffu); d[3 * LV] = (bf16)(v.y >> 16);
        d[4 * LV] = (bf16)(v.z & 0xffffu); d[5 * LV] = (bf16)(v.z >> 16); d[6 * LV] = (bf16)(v.w & 0xffffu); d[7 * LV] = (bf16)(v.w >> 16); }
    __syncthreads();
    const int trow = 32 * mt + l31;
#pragma unroll 1
    for (int g = 0; g < 4; ++g) {
        f32x16 acc;
#pragma unroll
        for (int r = 0; r < 16; ++r) acc[r] = 0.f;
        const float* wrow = Ws + (size_t)g * 16384 + (size_t)trow * 128 + 8 * hi;
        const LAS bf16* bp = Vt + (g * 64 + 32 * nt + l31) * LV + 8 * hi;
        const int nks = 2 * (mt + 1);
#pragma unroll 2
        for (int ks = 0; ks < nks; ++ks) {
            const f32x4 a0 = *(const f32x4*)(wrow + 16 * ks), a1 = *(const f32x4*)(wrow + 16 * ks + 4);
            const int s0 = 16 * ks + 8 * hi;
            v4u ap; ap.x = pk2(s0 + 0 <= trow ? a0[0] : 0.f, s0 + 1 <= trow ? a0[1] : 0.f); ap.y = pk2(s0 + 2 <= trow ? a0[2] : 0.f, s0 + 3 <= trow ? a0[3] : 0.f);
            ap.z = pk2(s0 + 4 <= trow ? a1[0] : 0.f, s0 + 5 <= trow ? a1[1] : 0.f); ap.w = pk2(s0 + 6 <= trow ? a1[2] : 0.f, s0 + 7 <= trow ? a1[3] : 0.f);
            const bf16x8_t bfr = *(const LAS bf16x8_t*)(bp + 16 * ks);
            acc = __builtin_amdgcn_mfma_f32_32x32x16_bf16(__builtin_bit_cast(bf16x8_t, ap), bfr, acc, 0, 0, 0);
        }
        const int c = g * 64 + 32 * nt + l31;
#pragma unroll
        for (int r = 0; r < 16; ++r) { const int t = 32 * mt + (r & 3) + 8 * (r >> 2) + 4 * hi; const size_t tok = (size_t)(tok0 + t);
            const float u = bf2f(Z[tok * ZW + ZC_U + c]); YMIX[tok * DM + c] = (bf16)f2bf(u * (acc[r] + bs[g * 128 + t])); }
    }
    __syncthreads();
}

__device__ __forceinline__ void p_attn_unit_naive(Frame& F, int bh, int qb) {
    const bf16* Z = (const bf16*)(F.ws() + WS_Z); const float* LOGF = (const float*)(F.ws() + WS_LOGF); bf16* YMIX = (bf16*)(F.ws() + WS_YMIX);
    LAS float* Ks = (LAS float*)F.lds;
    LAS float* Vs = (LAS float*)(F.lds + 16384);
    LAS float* CUM = (LAS float*)(F.lds + 32768);
    LAS float* WT = (LAS float*)(F.lds + 49152);
    const int b = bh / NHF, h = bh % NHF, q0 = qb * 256, tid = F.tid, r = tid >> 1, dh = (tid & 1) * 32;
    const int nkeys = q0 + 256;
    const size_t tokb = (size_t)b * NT;
    __syncthreads();
    { float v[8]; float run = 0.f;
#pragma unroll
      for (int e = 0; e < 8; ++e) { const int t = tid * 8 + e; v[e] = t < nkeys ? LOGF[(tokb + t) * 8 + h] : 0.f; run += v[e]; v[e] = run; }
      float inc = run;
#pragma unroll
      for (int o = 1; o < 64; o <<= 1) { const float n = __shfl_up(inc, o); if (F.lane >= o) inc += n; }
      if (F.lane == 63) WT[F.wave] = inc;
      __syncthreads();
      float off = inc - run;
      for (int w = 0; w < F.wave; ++w) off += WT[w];
#pragma unroll
      for (int e = 0; e < 8; ++e) { const int t = tid * 8 + e; if (t < nkeys) CUM[t] = off + v[e]; }
    }
    __syncthreads();
    const int tq = q0 + r;
    float qv[32];
    { const bf16* qp = Z + (tokb + tq) * ZW + ZC_Q + h * 64 + dh;
#pragma unroll
      for (int d = 0; d < 32; d += 8) { const v4u w = *(const v4u*)(qp + d); qv[d] = bflo(w.x); qv[d + 1] = bfhi(w.x); qv[d + 2] = bflo(w.y); qv[d + 3] = bfhi(w.y); qv[d + 4] = bflo(w.z); qv[d + 5] = bfhi(w.z); qv[d + 6] = bflo(w.w); qv[d + 7] = bfhi(w.w); } }
    const float cq = CUM[tq];
    float mrun = -INFINITY, lrun = 0.f; float o[32];
#pragma unroll
    for (int d = 0; d < 32; ++d) o[d] = 0.f;
    for (int kt = 0; kt < nkeys / 64; ++kt) {
        __syncthreads();
        { const int kr = tid >> 3, c8 = (tid & 7) * 8; const bf16* kp = Z + (tokb + kt * 64 + kr) * ZW + h * 64 + c8;
          const v4u kw = *(const v4u*)(kp + ZC_KF), vw = *(const v4u*)(kp + ZC_VF);
          *(LAS f32x4*)(Ks + kr * 64 + c8) = (f32x4){bflo(kw.x), bfhi(kw.x), bflo(kw.y), bfhi(kw.y)}; *(LAS f32x4*)(Ks + kr * 64 + c8 + 4) = (f32x4){bflo(kw.z), bfhi(kw.z), bflo(kw.w), bfhi(kw.w)};
          *(LAS f32x4*)(Vs + kr * 64 + c8) = (f32x4){bflo(vw.x), bfhi(vw.x), bflo(vw.y), bfhi(vw.y)}; *(LAS f32x4*)(Vs + kr * 64 + c8 + 4) = (f32x4){bflo(vw.z), bfhi(vw.z), bflo(vw.w), bfhi(vw.w)}; }
        __syncthreads();
        const int klim = min(64, q0 + 256 - kt * 64);
#pragma unroll 1
        for (int kl = 0; kl < klim; ++kl) {
            const LAS float* kr = Ks + kl * 64 + dh; float a0 = 0.f, a1 = 0.f;
#pragma unroll
            for (int d = 0; d < 32; d += 4) { const f32x4 k4 = *(const LAS f32x4*)(kr + d); a0 += qv[d] * k4[0] + qv[d + 2] * k4[2]; a1 += qv[d + 1] * k4[1] + qv[d + 3] * k4[3]; }
            float part = a0 + a1; part = dpp_add<0xB1>(part);
            const int key = kt * 64 + kl; float sv = part + cq - CUM[key];
            if (key <= tq) {
                if (sv > mrun) { const float scale = exp2f(mrun - sv); lrun *= scale;
#pragma unroll
                    for (int d = 0; d < 32; ++d) o[d] *= scale;
                    mrun = sv; }
                const float p = exp2f(sv - mrun); lrun += p; const LAS float* vr = Vs + kl * 64 + dh;
#pragma unroll
                for (int d = 0; d < 32; d += 4) { const f32x4 v4 = *(const LAS f32x4*)(vr + d); o[d] += p * v4[0]; o[d + 1] += p * v4[1]; o[d + 2] += p * v4[2]; o[d + 3] += p * v4[3]; }
            }
        }
    }
    { const float inv = 1.f / lrun; bf16* op = YMIX + (tokb + tq) * DM + 512 + h * 64 + dh;
#pragma unroll
      for (int d = 0; d < 32; d += 8) { v4u w; w.x = pk2(o[d] * inv, o[d + 1] * inv); w.y = pk2(o[d + 2] * inv, o[d + 3] * inv); w.z = pk2(o[d + 4] * inv, o[d + 5] * inv); w.w = pk2(o[d + 6] * inv, o[d + 7] * inv); *(v4u*)(op + d) = w; } }
    __syncthreads();
}

#ifndef ATTN_NAIVE
#define ATTN_NAIVE 0
#endif
__device__ __forceinline__ void p_attn_unit(Frame& F, int l, int bh, int qb) {
#if ATTN_NAIVE
    p_attn_unit_naive(F, bh, qb);
#else
    const fox::bf16* Zb = (const fox::bf16*)(F.ws() + WS_Z);
    float gq = fabsf(F.in(20)[(size_t)l * 64 + F.lane]), gk = fabsf(F.in(21)[(size_t)l * 64 + F.lane]);
#pragma unroll
    for (int o = 1; o < 64; o <<= 1) { gq = fmaxf(gq, __shfl_xor(gq, o)); gk = fmaxf(gk, __shfl_xor(gk, o)); }
    const float skip_thr = 44.f + 2.f * (64.f * gq * gk * QSCALE * 1.02f);
    fox::attn_unit<20>(bh / NHF, bh % NHF, qb, Zb + ZC_Q, Zb + ZC_KF, Zb + ZC_VF, (fox::bf16*)(F.ws() + WS_YMIX) + 512, (const float*)(F.ws() + WS_LOGF), (char*)F.lds, F.tid, skip_thr);
#endif
}

__device__ __forceinline__ void p_route(Frame& F, int l, int lcur) {
    typedef short bf16x8_t __attribute__((ext_vector_type(8)));
    const float* x = F.out(); const float* modl = (const float*)(F.ws() + WS_MOD) + (size_t)l * NB * 6144;
    bf16* XN = (bf16*)(F.ws() + WS_XN);
    const bf16* wth = (const bf16*)(F.ws() + WS_WRT) + (size_t)l * 2 * NE * DM; const bf16* wtl = wth + NE * DM;
    const float* br = F.in(25) + (size_t)l * NE;
    unsigned* cur = (unsigned*)(F.ws() + WS_CTL) + CW_CUR + lcur * NE * 64;
    int* ROWTOK = (int*)(F.ws() + (lcur == l ? WS_ROWTOK : WS_XS)); int* TOKPOS = (int*)(F.ws() + WS_TOKPOS); float* TOKW = (float*)(F.ws() + WS_TOKW);
    constexpr int WP = 1032;
    LAS bf16* wlds = (LAS bf16*)F.lds;
    LAS float* lg = (LAS float*)(F.lds + 2 * NE * WP * 2 + F.wave * 1152);
    const int lane = F.lane, t = lane & 15, quad = lane >> 4;
    LAS unsigned* lcnt = (LAS unsigned*)(F.lds + 2 * NE * WP * 2 + 8 * 1152);
    static_assert(M / 16 <= 4 * 256, "one token group per wave pair at most");
    __syncthreads();
    if (F.tid < 64) lcnt[F.tid] = 0u;
    { v4u wv[16];
#pragma unroll
      for (int r = 0; r < 16; ++r) { const int ch = F.tid + NTHR * r; wv[r] = *(const v4u*)(wth + (size_t)(ch >> 7) * DM + (ch & 127) * 8); }
#pragma unroll
      for (int r = 0; r < 16; ++r) { const int ch = F.tid + NTHR * r; *(LAS v4u*)(wlds + (ch >> 7) * WP + (ch & 127) * 8) = wv[r]; } }
    __syncthreads();
    const int wq = F.wave & 3, kh = F.wave >> 2;
    const int grp = wq * F.G + F.bid;
    LAS float* part = (LAS float*)(F.lds + 2 * NE * WP * 2 + 8 * 1152 + 256) + wq * 512;
    float tv[4] = {0.f, 0.f, 0.f, 0.f}; int ti[4] = {0, 0, 0, 0};
    f32x4 acc0 = {0.f, 0.f, 0.f, 0.f}, acc1 = acc0;
    if (grp < M / 16) {
        const int row = grp * 16 + t; const float* xr = x + (size_t)row * DM + 8 * quad;
        const float* mb = modl + (size_t)(row / NT) * 6144 + 8 * quad;
        float ss;
        { const f32x4* sp = (const f32x4*)((const float*)(F.ws() + WS_SSP) + (size_t)row * 16); const f32x4 p0 = sp[0], p1 = sp[1], p2 = sp[2], p3 = sp[3];
          ss = (((p0[0] + p0[1]) + (p0[2] + p0[3])) + ((p1[0] + p1[1]) + (p1[2] + p1[3]))) + (((p2[0] + p2[1]) + (p2[2] + p2[3])) + ((p3[0] + p3[1]) + (p3[2] + p3[3]))); }
        const float rs = rsq_(ss * (1.f / DM) + 1e-6f);
        const LAS bf16* wh0 = wlds + t * WP + 8 * quad; const LAS bf16* wl0 = wlds + (NE + t) * WP + 8 * quad;
#pragma unroll 4
        for (int ks = 16 * kh; ks < 16 * kh + 16; ++ks) {
            const f32x4 a = *(const f32x4*)(xr + 32 * ks), b = *(const f32x4*)(xr + 32 * ks + 4);
            const f32x4 sh0 = *(const f32x4*)(mb + 3072 + 32 * ks), sh1 = *(const f32x4*)(mb + 3072 + 32 * ks + 4), sc0 = *(const f32x4*)(mb + 4096 + 32 * ks), sc1 = *(const f32x4*)(mb + 4096 + 32 * ks + 4);
            const f32x4 h0 = a * rs * (sc0 + 1.f) + sh0, h1 = b * rs * (sc1 + 1.f) + sh1;
            v4u hi, lo;
            hi.x = pk2(h0[0], h0[1]); hi.y = pk2(h0[2], h0[3]); hi.z = pk2(h1[0], h1[1]); hi.w = pk2(h1[2], h1[3]);
            lo.x = pk2(h0[0] - bflo(hi.x), h0[1] - bfhi(hi.x)); lo.y = pk2(h0[2] - bflo(hi.y), h0[3] - bfhi(hi.y)); lo.z = pk2(h1[0] - bflo(hi.z), h1[1] - bfhi(hi.z)); lo.w = pk2(h1[2] - bflo(hi.w), h1[3] - bfhi(hi.w));
            *(v4u*)(XN + (size_t)row * DM + 32 * ks + 8 * quad) = hi;
            const bf16x8_t ah = __builtin_bit_cast(bf16x8_t, hi), al = __builtin_bit_cast(bf16x8_t, lo);
            const bf16x8_t bh0 = *(const LAS bf16x8_t*)(wh0 + 32 * ks), bh1 = *(const LAS bf16x8_t*)(wh0 + 16 * WP + 32 * ks), bl0 = *(const LAS bf16x8_t*)(wl0 + 32 * ks), bl1 = *(const LAS bf16x8_t*)(wl0 + 16 * WP + 32 * ks);
            acc0 = __builtin_amdgcn_mfma_f32_16x16x32_bf16(ah, bh0, acc0, 0, 0, 0); acc1 = __builtin_amdgcn_mfma_f32_16x16x32_bf16(ah, bh1, acc1, 0, 0, 0);
            acc0 = __builtin_amdgcn_mfma_f32_16x16x32_bf16(ah, bl0, acc0, 0, 0, 0); acc1 = __builtin_amdgcn_mfma_f32_16x16x32_bf16(ah, bl1, acc1, 0, 0, 0);
            acc0 = __builtin_amdgcn_mfma_f32_16x16x32_bf16(al, bh0, acc0, 0, 0, 0); acc1 = __builtin_amdgcn_mfma_f32_16x16x32_bf16(al, bh1, acc1, 0, 0, 0);
        }
        if (kh == 1) { *(LAS f32x4*)(part + lane * 8) = acc0; *(LAS f32x4*)(part + lane * 8 + 4) = acc1; }
    }
    __syncthreads();
    if (grp < M / 16 && kh == 0) {
        acc0 += *(const LAS f32x4*)(part + lane * 8); acc1 += *(const LAS f32x4*)(part + lane * 8 + 4);
        const float b0 = br[t], b1 = br[16 + t];
#pragma unroll 1
        for (int half = 0; half < 2; ++half) {
            if ((quad >> 1) == half) {
#pragma unroll
                for (int i = 0; i < 4; ++i) { lg[((4 * quad + i) & 7) * 36 + t] = acc0[i] + b0; lg[((4 * quad + i) & 7) * 36 + 16 + t] = acc1[i] + b1; } }
            LDS_WAIT(); asm volatile("" ::: "memory");
            if (lane < 16 && (lane >> 3) == half) {
                float v[32];
#pragma unroll
                for (int q = 0; q < 8; ++q) { const f32x4 t4 = *(const LAS f32x4*)(lg + (lane & 7) * 36 + 4 * q); v[4 * q] = t4[0]; v[4 * q + 1] = t4[1]; v[4 * q + 2] = t4[2]; v[4 * q + 3] = t4[3]; }
#pragma unroll
                for (int k = 0; k < 4; ++k) { float bv = -INFINITY; int bi = 0;
#pragma unroll
                    for (int e = 0; e < 32; ++e) { const bool taken = (k > 0 && ti[0] == e) || (k > 1 && ti[1] == e) || (k > 2 && ti[2] == e); if (!taken && v[e] > bv) { bv = v[e]; bi = e; } }
                    tv[k] = bv; ti[k] = bi; }
            }
            LDS_WAIT(); asm volatile("" ::: "memory");
        }
    }
    const bool owner = (grp < M / 16) && kh == 0 && lane < 16;
    unsigned rank[4] = {0u, 0u, 0u, 0u};
    if (owner) {
#pragma unroll
        for (int k = 0; k < 4; ++k) rank[k] = __hip_atomic_fetch_add(lcnt + ti[k], 1u, __ATOMIC_RELAXED, __HIP_MEMORY_SCOPE_WORKGROUP);
    }
    __syncthreads();
    if (F.tid < NE) { const unsigned n = lcnt[F.tid]; lcnt[32 + F.tid] = n ? __hip_atomic_fetch_add(cur + F.tid * 64, n, __ATOMIC_RELAXED, __HIP_MEMORY_SCOPE_AGENT) : 0u; }
    __syncthreads();
    if (owner) {
        const float e1 = __expf(tv[1] - tv[0]), e2 = __expf(tv[2] - tv[0]), e3 = __expf(tv[3] - tv[0]); const float inv = rcp_(1.f + e1 + e2 + e3);
        const float gt[4] = {inv, e1 * inv, e2 * inv, e3 * inv};
        const int tok = grp * 16 + lane;
#pragma unroll
        for (int k = 0; k < 4; ++k) { const int e = ti[k]; const unsigned slot = lcnt[32 + e] + rank[k]; ROWTOK[e * M + slot] = tok; TOKPOS[tok * 4 + k] = e * M + (int)slot; TOKW[tok * 4 + k] = gt[k]; }
    }
    __syncthreads();
}
__device__ __forceinline__ void p_convert_router(Frame& F) {
    const float* w = F.in(24); bf16* wt = (bf16*)(F.ws() + WS_WRT);
    for (int idx = F.bid * NTHR + F.tid; idx < NL * NE * DM; idx += F.G * NTHR) {
        const int l = idx / (NE * DM), e = (idx / DM) % NE, c = idx % DM;
        const float v = w[((size_t)l * DM + c) * NE + e]; const unsigned hi = f2bf(v); const unsigned lo = f2bf(v - __builtin_bit_cast(float, hi << 16));
        wt[((size_t)(l * 2 + 0) * NE + e) * DM + c] = (bf16)hi; wt[((size_t)(l * 2 + 1) * NE + e) * DM + c] = (bf16)lo;
    }
}
__device__ __forceinline__ void moe_table(Frame& F, int l) {
    LAS int* tb = (LAS int*)(F.lds + LDSCTL_OFF + 64); LAS int* cnt = (LAS int*)(F.lds + LDSCTL_OFF + 256);
    unsigned* cur = (unsigned*)(F.ws() + WS_CTL) + CW_CUR + l * NE * 64;
    __syncthreads();
    if (F.tid < NE) cnt[F.tid] = (int)__hip_atomic_load(cur + F.tid * 64, __ATOMIC_RELAXED, __HIP_MEMORY_SCOPE_AGENT);
    __syncthreads();
    if (F.tid == 0) { int a = 0; for (int e = 0; e < NE; ++e) { tb[e] = a; a += (cnt[e] + 255) >> 8; } tb[NE] = a; }
    __syncthreads();
}
__device__ __forceinline__ void p_gather(Frame& F) {
    const LAS int* tb = (const LAS int*)(F.lds + LDSCTL_OFF + 64); const LAS int* cnt = (const LAS int*)(F.lds + LDSCTL_OFF + 256);
    const bf16* XN = (const bf16*)(F.ws() + WS_XN); bf16* XS = (bf16*)(F.ws() + WS_XS); const int* ROWTOK = (const int*)(F.ws() + WS_ROWTOK);
    const int nrows = tb[NE] * 256;
    for (int R = F.gw; R < nrows; R += F.ngw) {
        const int tg = R >> 8; int e = 0;
#pragma unroll
        for (int k = 1; k < NE; ++k) e += (tb[k] <= tg) ? 1 : 0;
        const int rr = R - tb[e] * 256;
        v4u a = {0u, 0u, 0u, 0u}, b = a;
        if (rr < cnt[e]) { const int tok = ROWTOK[e * M + rr]; const v4u* src = (const v4u*)(XN + (size_t)tok * DM); a = src[F.lane]; b = src[64 + F.lane]; }
        v4u* dst = (v4u*)(XS + (size_t)R * DM); dst[F.lane] = a; dst[64 + F.lane] = b;
    }
}
__device__ __forceinline__ void p_combine(Frame& F, int l, bool dummy) {
    const LAS int* tb = (const LAS int*)(F.lds + LDSCTL_OFF + 64);
    float* x = F.out(); float* xd = dummy ? (float*)(F.ws() + WS_MRG) : x; const float* MOD = (const float*)(F.ws() + WS_MOD); const float* modl = MOD + (size_t)l * NB * 6144;
    const bf16* YS = (const bf16*)(F.ws() + WS_YS); const int* TOKPOS = (const int*)(F.ws() + WS_TOKPOS); const float* TOKW = (const float*)(F.ws() + WS_TOKW);
    bf16* XN = (bf16*)(F.ws() + (dummy ? WS_MERGED : WS_XN));
    const int lane = F.lane;
    for (int row = F.gw; row < M; row += F.ngw) {
        const float* mb = modl + (size_t)(row / NT) * 6144;
        f32x4 acc[4];
#pragma unroll
        for (int j = 0; j < 4; ++j) acc[j] = (f32x4){0.f, 0.f, 0.f, 0.f};
#pragma unroll
        for (int k = 0; k < 4; ++k) { const int pos = TOKPOS[row * 4 + k]; const float w = TOKW[row * 4 + k]; const int e = pos / M, slot = pos % M;
            const bf16* yr = YS + (size_t)(tb[e] * 256 + slot) * DM;
#pragma unroll
            for (int j = 0; j < 4; ++j) { float t[4]; ld4bf(yr + 4 * lane + 256 * j, t); acc[j] += w * (f32x4){t[0], t[1], t[2], t[3]}; } }
        f32x4 v[4]; float s = 0.f;
#pragma unroll
        for (int j = 0; j < 4; ++j) { const int c = 4 * lane + 256 * j; f32x4* xp = (f32x4*)(x + (size_t)row * DM + c); const f32x4 g2 = *(const f32x4*)(mb + 5120 + c);
            v[j] = *xp + g2 * acc[j]; *(f32x4*)(xd + (size_t)row * DM + c) = v[j]; s += (v[j][0] * v[j][0] + v[j][1] * v[j][1]) + (v[j][2] * v[j][2] + v[j][3] * v[j][3]); }
        if (l + 1 < NL) { const float rs = rsq_(wave_sum(s) * (1.f / DM) + 1e-6f); const float* mn = MOD + ((size_t)(l + 1) * NB + row / NT) * 6144;
            norm_row_store(v, rs, mn + 0, mn + 1024, XN + (size_t)row * DM, lane); }
    }
}

__global__ void __launch_bounds__(NTHR, 2) fwd(Params P) {
    extern __shared__ __attribute__((aligned(16))) unsigned char lds[];
    Frame F;
    F.lds = (LAS unsigned char*)lds; F.ka = (kptr_t)__builtin_amdgcn_kernarg_segment_ptr();
    F.tid = threadIdx.x; F.lane = F.tid & 63; F.wave = __builtin_amdgcn_readfirstlane(F.tid >> 6);
    F.G = gridDim.x; F.bid = blockIdx.x; F.gw = blockIdx.x * NWAVES + F.wave; F.ngw = F.G * NWAVES;
    for (int u = F.tid; u < (LDS_BYTES - LDSCTL_OFF) / 4; u += NTHR) ((LAS unsigned*)(F.lds + LDSCTL_OFF))[u] = 0u;
    __syncthreads();
    XcdBarrier bar = xcd_barrier_post((unsigned*)(F.ws() + WS_CTL) + CW_BAR, (volatile LAS unsigned*)(F.lds + LDSCTL_OFF));
#define GRID_BAR() do { PHASE_BEGIN(); xcd_barrier(bar, (unsigned*)(F.ws() + WS_CTL) + CW_BAR); } while (0)
#ifndef PH_MASK
#define PH_MASK 0xFFFFFFFFu
#endif
#define PH(k) if constexpr ((PH_MASK >> (k)) & 1u)
#ifndef REP_MASK
#define REP_MASK 0u
#endif
#define REP(k) for (int _r = 0; _r < ((((REP_MASK) >> (k)) & 1u) ? 2 : 1); ++_r)
#if PROBE_TS
#define TS_NOW() ((unsigned)__builtin_amdgcn_s_memrealtime())
#define TS_E(l, k) do { if (F.tid == 0) atomicMax((unsigned*)(F.ws() + WS_CTL) + CW_TS + (l) * 32 + (k), TS_NOW()); } while (0)
#define TS_X(l, p) do { if (F.tid == 0 && F.bid == 0) ((unsigned*)(F.ws() + WS_CTL))[CW_TS + (l) * 32 + 16 + (p)] = TS_NOW(); } while (0)
#else
#define TS_E(l, k) do { } while (0)
#define TS_X(l, p) do { } while (0)
#endif
#define PHASE_BEGIN() do { kptr_t _k = (kptr_t)__builtin_amdgcn_kernarg_segment_ptr(); int _t = threadIdx.x, _b = blockIdx.x, _g = gridDim.x; asm volatile("" : "+s"(_k), "+v"(_t), "+s"(_b), "+s"(_g)); \
    F.ka = _k; F.tid = _t; F.lane = _t & 63; F.wave = __builtin_amdgcn_readfirstlane(_t >> 6); F.bid = _b; F.G = _g; F.gw = _b * NWAVES + F.wave; F.ngw = _g * NWAVES; } while (0)

    PHASE_BEGIN();
    REP(0) PH(0) { p_convert(F); p_convert_router(F); }
    __syncthreads();
    PHASE_BEGIN();
    PH(1) p_mod(F);
    GRID_BAR();
    PHASE_BEGIN();
    PH(2) p_norm_rows(F, F.in(0), (const float*)(F.ws() + WS_MOD), 0, 1024);
    GRID_BAR();
    TS_X(0, 15);

#define LAYER_BODY(l) do { \
 \
        PHASE_BEGIN(); \
        REP(3) PH(3) { pg8::Gemm g{(const bf16*)(F.ws() + WS_XN), (const bf16*)(F.ws() + WS_WIN) + (size_t)l * ZW * DM, DM, DM, DM}; pg8::StaticOrder S; S.init(M, ZW, F.G, F.bid); \
          EpiZ E; E.Z = (bf16*)(F.ws() + WS_Z); E.FL = (float*)(F.ws() + WS_FLOGIT); \
          pg8::gemm_phase<EpiZ, pg8::StaticOrder, true>(F.lds, g, S, E, F.tid); } \
        TS_E(l, 0); GRID_BAR(); TS_X(l, 0); \
 \
        PHASE_BEGIN(); \
        static_assert(2 * RWC == 64 && (M / 64) == NB * NCH / 2, "prep + pass 1 share the unit: 64 consecutive tokens"); \
        PH(4) for (int un = F.bid; un < M / 64; un += F.G) { \
            p_prep(F, l, false, 16 * un + F.wave, 8, 16 * un + 16); \
            VM_WAIT(); TS_E(l, 14); \
            PH(5) p_rwkv_pass1(F, un, 1, un + 1); \
            __syncthreads(); } \
        TS_E(l, 1); GRID_BAR(); TS_X(l, 1); \
 \
        PHASE_BEGIN(); \
        REP(6) PH(6) { const int nrw = NB * NHR; \
          if (F.bid >= F.G - nrw) { REP(15) PH(15) p_rwkv_pass2(F, F.G - nrw, l); TS_E(l, 3); PHASE_BEGIN(); } \
          { \
 \
              PH(16) { unsigned* qh = (unsigned*)(F.ws() + WS_CTL) + CW_ATT + 64 * l; LAS int* qs = (LAS int*)(F.lds + LDSCTL_OFF + 512); \
                for (;;) { __syncthreads(); if (F.tid == 0) qs[0] = (int)__hip_atomic_fetch_add(qh, 1u, __ATOMIC_RELAXED, __HIP_MEMORY_SCOPE_AGENT); __syncthreads(); \
                    const int idx = __builtin_amdgcn_readfirstlane(qs[0]); if (idx >= 512 + M / 128) break; \
                    if (idx >= M / 128) p_attn_unit(F, l, (idx - M / 128) & 31, 15 - ((idx - M / 128) >> 5)); else { PHASE_BEGIN(); p_gmlp_unit(F, l, idx); } } } PHASE_BEGIN(); TS_E(l, 2); } } \
        GRID_BAR(); TS_X(l, 2); \
 \
        PHASE_BEGIN(); \
        REP(7) PH(7) p_rwkv_pass3(F, l); \
        TS_E(l, 4); GRID_BAR(); TS_X(l, 3); \
 \
        PHASE_BEGIN(); \
        REP(8) PH(8) { pg8::Gemm g{(const bf16*)(F.ws() + WS_YMIX), (const bf16*)(F.ws() + WS_WBR) + (size_t)l * DM * DM, DM, DM, DM}; pg8::StaticOrder S; S.init(M, DM, F.G, F.bid); \
          EpiMerge2 E; E.Z = (const bf16*)(F.ws() + WS_Z); E.MERGED = (bf16*)(F.ws() + WS_MERGED); \
          pg8::gemm_phase<EpiMerge2, pg8::StaticOrder, true>(F.lds, g, S, E, F.tid); } \
        TS_E(l, 5); GRID_BAR(); TS_X(l, 4); \
 \
        PHASE_BEGIN(); \
        PH(9) { pg8::Gemm g{(const bf16*)(F.ws() + WS_MERGED), (const bf16*)(F.ws() + WS_WO) + (size_t)l * DM * DM, DM, DM, DM}; pg8::StaticOrder S; S.init(M, DM, F.G, F.bid); \
          EpiWo E; E.xin = (l == 0) ? F.in(0) : F.out(); E.xout = F.out(); E.gate = (const float*)(F.ws() + WS_MOD) + (size_t)l * NB * 6144 + 2048; E.SSP = (float*)(F.ws() + WS_SSP); \
          pg8::gemm_phase<EpiWo, pg8::StaticOrder, true>(F.lds, g, S, E, F.tid); } \
        TS_E(l, 6); GRID_BAR(); TS_X(l, 5); \
 \
        PHASE_BEGIN(); \
        if constexpr ((REP_MASK >> 10) & 1u) { p_route(F, l, l + 4); __syncthreads(); } \
        PH(10) p_route(F, l, l); \
        TS_E(l, 7); GRID_BAR(); TS_X(l, 6); \
 \
        PHASE_BEGIN(); \
        moe_table(F, l); \
        REP(12) PH(12) { pg8::Gemm g{(const bf16*)(F.ws() + WS_XN), (const bf16*)(F.ws() + WS_WGU) + (size_t)l * NE * 2048 * DM, DM, DM, DM}; \
          pg8::GroupedOrder S; S.tb = (const LAS int*)(F.lds + LDSCTL_OFF + 64); S.nct = 8; S.G = F.G; S.c = F.bid; \
          EpiMoe1 E; E.bgu = F.in(27) + (size_t)l * NE * 2048; E.ACT = (bf16*)(F.ws() + WS_ACT); E.ROWTOK = (const int*)(F.ws() + WS_ROWTOK); E.tb = S.tb; E.cnt = (const LAS int*)(F.lds + LDSCTL_OFF + 256); \
          pg8::gemm_phase<EpiMoe1, pg8::GroupedOrder, true>(F.lds, g, S, E, F.tid); } \
        TS_E(l, 8); GRID_BAR(); TS_X(l, 7); \
 \
        PHASE_BEGIN(); \
        REP(13) PH(13) { pg8::Gemm g{(const bf16*)(F.ws() + WS_ACT), (const bf16*)(F.ws() + WS_WD) + (size_t)l * NE * DM * DFF, DFF, DFF, DFF}; \
          pg8::GroupedOrder S; S.tb = (const LAS int*)(F.lds + LDSCTL_OFF + 64); S.nct = 4; S.G = F.G; S.c = F.bid; \
          EpiMoe2 E; E.bd = F.in(29) + (size_t)l * NE * DM; E.YS = (bf16*)(F.ws() + WS_YS); \
          pg8::gemm_phase<EpiMoe2, pg8::GroupedOrder, true>(F.lds, g, S, E, F.tid); } \
        TS_E(l, 9); GRID_BAR(); TS_X(l, 8); \
 \
        PHASE_BEGIN(); \
        if constexpr ((REP_MASK >> 14) & 1u) { p_combine(F, l, true); } \
        PH(14) p_combine(F, l, false); \
        TS_E(l, 10); GRID_BAR(); TS_X(l, 9); \
    } while (0)
    LAYER_BODY(0); LAYER_BODY(1); LAYER_BODY(2); LAYER_BODY(3);
#undef LAYER_BODY
#if PROBE_TS
    PHASE_BEGIN();
    if (F.bid == 0 && F.tid == 0) {
        unsigned* ts = (unsigned*)(F.ws() + WS_CTL) + CW_TS; unsigned D = 0;
        const int ph_of[11] = {0, 1, 2, 2, 3, 4, 5, 6, 7, 8, 9};
        for (int l = 0; l < NL; ++l) {
            if (PROBE_TS == 14) { D += __hip_atomic_load(ts + l * 32 + 14, __ATOMIC_RELAXED, __HIP_MEMORY_SCOPE_AGENT) - ts[l * 32 + 16 + 0]; }
            else if (PROBE_TS >= 21) { D += __hip_atomic_load(ts + l * 32 + 11 + (PROBE_TS - 21), __ATOMIC_RELAXED, __HIP_MEMORY_SCOPE_AGENT); }
            else if (PROBE_TS <= 11) { const int k = PROBE_TS - 1, p = ph_of[k];
                const unsigned e = __hip_atomic_load(ts + l * 32 + k, __ATOMIC_RELAXED, __HIP_MEMORY_SCOPE_AGENT);
                const unsigned x0 = (p == 0) ? ((l == 0) ? ts[16 + 15] : ts[(l - 1) * 32 + 16 + 9]) : ts[l * 32 + 16 + p - 1];
                D += e - x0;
            } else {
                for (int p = 0; p < 10; ++p) { unsigned e;
                    if (p == 2) { const unsigned e2 = __hip_atomic_load(ts + l * 32 + 2, __ATOMIC_RELAXED, __HIP_MEMORY_SCOPE_AGENT), e3 = __hip_atomic_load(ts + l * 32 + 3, __ATOMIC_RELAXED, __HIP_MEMORY_SCOPE_AGENT); e = (int)(e2 - e3) > 0 ? e2 : e3; }
                    else e = __hip_atomic_load(ts + l * 32 + (p < 2 ? p : p + 1), __ATOMIC_RELAXED, __HIP_MEMORY_SCOPE_AGENT);
                    D += ts[l * 32 + 16 + p] - e; }
            }
        }
        if (PROBE_TS == 13 || (PROBE_TS > 14 && PROBE_TS < 21)) D = 0;
        D *= 8u; const unsigned t_start = TS_NOW();
        while (TS_NOW() - t_start < D) __builtin_amdgcn_s_sleep(32);
    }
#endif
}

extern "C" void kernel_launch(void* const* d_in, const int* in_sizes, int n_in, void* d_out, int out_size, void* d_ws, size_t ws_size, hipStream_t stream) {
    static int grid = 0;
    if (grid == 0) {
        if (n_in != 30 || out_size != M * DM || ws_size < WS_END) { fprintf(stderr, "kernel_launch: unexpected shapes (n_in %d, out %d, ws %zu)\n", n_in, out_size, ws_size); grid = -1; return; }
        int dev = 0, cus = 0, per_cu = 0;
        if (hipGetDevice(&dev) != hipSuccess || hipDeviceGetAttribute(&cus, hipDeviceAttributeMultiprocessorCount, dev) != hipSuccess) { grid = -1; return; }
        if (hipFuncSetAttribute((const void*)fwd, hipFuncAttributeMaxDynamicSharedMemorySize, LDS_BYTES) != hipSuccess) { fprintf(stderr, "kernel_launch: hipFuncSetAttribute failed\n"); grid = -1; return; }
        if (hipOccupancyMaxActiveBlocksPerMultiprocessor(&per_cu, (const void*)fwd, NTHR, LDS_BYTES) != hipSuccess || per_cu < 1) { fprintf(stderr, "kernel_launch: occupancy query says %d\n", per_cu); (void)hipGetLastError(); grid = -1; return; }
        grid = cus;
    }
    if (grid < 0) return;
    if (hipMemsetAsync((char*)d_ws + WS_CTL, 0, CTL_ZERO_BYTES, stream) != hipSuccess) return;
    Params p{};
    for (int i = 0; i < 30; ++i) p.in[i] = (const float*)d_in[i];
    p.out = (float*)d_out; p.ws = (unsigned char*)d_ws;
    hipLaunchKernelGGL(fwd, dim3(grid), dim3(NTHR), LDS_BYTES, stream, p);
}
```

```cpp
#define REP_MASK 0u
#define PROBE_TS 0
#include <hip/hip_runtime.h>
#include <hip/hip_bf16.h>
#include <cmath>
#include <cstdio>
#include <cstdint>

namespace pg8 {
#define PG8_LAS __attribute__((address_space(3)))
typedef unsigned short bf16_t;
typedef short bf16x8 __attribute__((ext_vector_type(8)));
typedef float f32x4 __attribute__((ext_vector_type(4)));
typedef unsigned u32x4 __attribute__((ext_vector_type(4)));
constexpr int BM = 256, BK = 64, HALF = 128, HTB = HALF * BK * 2, STAGE_BYTES = 8 * HTB, NXCD = 8, WGM = 8;

__host__ __device__ __forceinline__ int lds_byte(int r, int c) { const int st = (r >> 4) * 2 + (c >> 5), rr = r & 15, cc = c & 31, ob = rr * 64 + cc * 2; return st * 1024 + (ob ^ (((ob >> 9) & 1) << 5)); }
__host__ __device__ __forceinline__ void stage_rc(int b, int& R, int& C) { const int st = b / 1024, sb = b % 1024, swz = sb ^ (((sb >> 9) & 1) << 5); R = (st >> 1) * 16 + swz / 64; C = (st & 1) * 32 + (swz % 64) / 2; }
__host__ __device__ __forceinline__ int perm32(int rho) { const int n = rho >> 4, i = rho & 15; return 8 * (i >> 2) + 4 * n + (i & 3); }

struct Unit { int pm, pn; };
struct Gemm { const bf16_t* A; const bf16_t* Bt; int lda, ldb, K; };

struct StaticOrder {
    int nM, nN, nwg, G, c;
    __host__ __device__ void init(int M, int N, int G_, int c_) { nM = M / BM; nN = N / BM; nwg = nM * nN; G = G_; c = c_; }
    __host__ __device__ bool next(int i, Unit& u) const {
        const long L = (long)i * G + c; if (L >= nwg) return false;
        int wgid = (int)L; { const int q = nwg / NXCD, r = nwg % NXCD, xcd = wgid % NXCD, off = wgid / NXCD; wgid = (xcd < r ? xcd * (q + 1) : r * (q + 1) + (xcd - r) * q) + off; }
        const int nig = WGM * nN, gid = wgid / nig, fm = gid * WGM, gsz = (nM - fm) < WGM ? (nM - fm) : WGM;
        u.pm = fm + ((wgid % nig) % gsz); u.pn = (wgid % nig) / gsz; return true;
    }
};
template <int NSUB> struct SubOrder {
    StaticOrder S;
    __host__ __device__ void init(int M, int N, int G_, int c_) { S.init(M, N, G_, c_); }
    __host__ __device__ bool next(int i, Unit& u) const { Unit t; if (!S.next(i / NSUB, t)) return false; u.pm = t.pm; u.pn = t.pn * NSUB + (i % NSUB); return true; }
};
struct GroupedOrder {
    const PG8_LAS int* tb; int nct, G, c;
    __device__ __forceinline__ bool next(int i, Unit& u) const {
        const int T = tb[32], x = c & 7, r = c >> 3, per = G >> 3;
        const int t0 = (T * x) >> 3, t1 = (T * (x + 1)) >> 3;
        const int q = r + per * i; const int tl = q / nct, ct = q - tl * nct; const int tg = t0 + tl;
        if (tg >= t1) return false;
        int e = 0;
#pragma unroll
        for (int k = 1; k < 32; ++k) e += (tb[k] <= tg) ? 1 : 0;
        u.pm = __builtin_amdgcn_readfirstlane(tg); u.pn = __builtin_amdgcn_readfirstlane(e * nct + ct); return true;
    }
};

typedef float pk_f32x2_t __attribute__((ext_vector_type(2))); typedef __bf16 pk_bf16x2_t __attribute__((ext_vector_type(2)));
__device__ __forceinline__ unsigned cvt_pk_bf16(float lo, float hi) { pk_f32x2_t v = {lo, hi}; pk_bf16x2_t b = __builtin_convertvector(v, pk_bf16x2_t); return __builtin_bit_cast(unsigned, b); }

template <class Epi, class Sched, bool ALIGN_EPI>
__device__ __forceinline__ void gemm_phase(PG8_LAS unsigned char* lds, const Gemm g, const Sched& S, const Epi& E, const int tid) {
    const int wid = __builtin_amdgcn_readfirstlane(tid >> 6), lane = tid & 63, wr = wid >> 2, wc = wid & 3, fr = lane & 15, fq = lane >> 4;
    const int K = g.K, nt = K / BK;
    unsigned vA[2][2], nvA[2][2], voffB[2];
    int stR[2], stC[2];
#pragma unroll
    for (int i = 0; i < 2; ++i) { int R, C; stage_rc(tid * 16 + i * 8192, R, C); const int Rb = Epi::PERM ? ((R & ~31) + perm32(R & 31)) : R; stR[i] = R; stC[i] = C;
        vA[0][i] = (unsigned)(R * g.lda + C) * 2u; vA[1][i] = (unsigned)((R + HALF) * g.lda + C) * 2u; nvA[0][i] = vA[0][i]; nvA[1][i] = vA[1][i]; voffB[i] = (unsigned)(Rb * g.ldb + C) * 2u; }
#define PG8_GOFFS(dst, un) do { _Pragma("unroll") for (int h_ = 0; h_ < 2; ++h_) _Pragma("unroll") for (int i_ = 0; i_ < 2; ++i_) dst[h_][i_] = (unsigned)(E.row_src(un, stR[i_] + HALF * h_) * g.lda + stC[i_]) * 2u; } while (0)
#define PG8_ABASE(un) ((const char*)g.A + (Epi::GATHER ? (size_t)0 : (size_t)(un).pm * tstepA) + E.a_koff(un))
#define PG8_STAGE_A(bufoff, gbase, h, vsel) do { if constexpr (Epi::GATHER) { PG8_STAGE(bufoff, gbase, vsel); } else { PG8_STAGE(bufoff, (gbase) + ((h) ? hstepA : (size_t)0), vA[0]); } } while (0)
    const size_t kstep = (size_t)(BK * 2);
    const size_t hstepA = (size_t)HALF * g.lda * 2, hstepB = (size_t)HALF * g.ldb * 2;
    const size_t tstepA = 2 * hstepA, tstepB = 2 * hstepB;
    const unsigned ldsw = (unsigned)wid * 1024u;
    const int aoff = lds_byte(wr * 64 + fr, fq * 8), boff = lds_byte(wc * 32 + fr, fq * 8);
#define PG8_SA(b, h) (((b) * 2 + (h)) * HTB)
#define PG8_SB(b, h) ((4 + (b) * 2 + (h)) * HTB)
#define PG8_STAGE(bufoff, gbase, voff) do { _Pragma("unroll") for (int _i = 0; _i < 2; ++_i) \
        __builtin_amdgcn_global_load_lds((const unsigned*)((const char*)(gbase) + (voff)[_i]), (PG8_LAS unsigned*)(lds + (bufoff) + ldsw + _i * 8192), 16, 0, 0); } while (0)
#define PG8_LDA(dst, b, h) do { _Pragma("unroll") for (int m = 0; m < 4; ++m) _Pragma("unroll") for (int k = 0; k < 2; ++k) dst[m][k] = *(const PG8_LAS bf16x8*)(lds + PG8_SA(b, h) + aoff + m * 2048 + k * 1024); } while (0)
#define PG8_LDB(dst, b, h) do { _Pragma("unroll") for (int n = 0; n < 2; ++n) _Pragma("unroll") for (int k = 0; k < 2; ++k) dst[n][k] = *(const PG8_LAS bf16x8*)(lds + PG8_SB(b, h) + boff + n * 2048 + k * 1024); } while (0)
#define PG8_MMA(ai, bj, At, Bt) do { __builtin_amdgcn_s_setprio(1); _Pragma("unroll") for (int m = 0; m < 4; ++m) _Pragma("unroll") for (int n = 0; n < 2; ++n) _Pragma("unroll") for (int k = 0; k < 2; ++k) \
        acc[ai][bj][m][n] = __builtin_amdgcn_mfma_f32_16x16x32_bf16(Bt[n][k], At[m][k], acc[ai][bj][m][n], 0, 0, 0); __builtin_amdgcn_s_setprio(0); } while (0)
#define PG8_WAIT_V(n) asm volatile("s_waitcnt vmcnt(" #n ")" ::: "memory")
#define PG8_WAIT_L(n) asm volatile("s_waitcnt lgkmcnt(" #n ")" ::: "memory")
#define PG8_BAR __builtin_amdgcn_s_barrier()
#define PG8_SCHED __builtin_amdgcn_sched_barrier(0)
    Unit cur, nxt; int ui = 0;
    if (!S.next(0, cur)) return;
    f32x4 acc[2][2][4][2];
#pragma unroll
    for (int a = 0; a < 2; ++a)
#pragma unroll
        for (int b = 0; b < 2; ++b)
#pragma unroll
            for (int m = 0; m < 4; ++m)
#pragma unroll
                for (int n = 0; n < 2; ++n) acc[a][b][m][n] = (f32x4){0.f, 0.f, 0.f, 0.f};
    bf16x8 At[4][2], B0[2][2], B1[2][2];
    if constexpr (Epi::GATHER) PG8_GOFFS(vA, cur);
    const char* cA = PG8_ABASE(cur); const char* cB = (const char*)g.Bt + (size_t)E.b_tile(cur) * tstepB + E.b_koff(cur);
    {
        PG8_STAGE(PG8_SB(0, 0), cB, voffB); PG8_STAGE(PG8_SB(0, 1), cB + hstepB, voffB); PG8_STAGE_A(PG8_SA(0, 0), cA, 0, vA[0]); PG8_STAGE_A(PG8_SA(0, 1), cA, 1, vA[1]);
        if (wr == 1) PG8_BAR;
        PG8_WAIT_V(2); PG8_BAR;
        PG8_STAGE(PG8_SB(1, 0), cB + kstep, voffB); PG8_STAGE_A(PG8_SA(1, 0), cA + kstep, 0, vA[0]); PG8_STAGE(PG8_SB(1, 1), cB + hstepB + kstep, voffB);
        PG8_WAIT_V(6); PG8_BAR;
    }
    for (;;) {
        const bool has_next = S.next(ui + 1, nxt);
        const int ntc = E.ktiles(cur, nt);
        const char* nA = has_next ? PG8_ABASE(nxt) : cA; const char* nB = has_next ? (const char*)g.Bt + (size_t)E.b_tile(nxt) * tstepB + E.b_koff(nxt) : cB;
        if constexpr (Epi::GATHER) { if (has_next) PG8_GOFFS(nvA, nxt); else { _Pragma("unroll") for (int h_ = 0; h_ < 2; ++h_) _Pragma("unroll") for (int i_ = 0; i_ < 2; ++i_) nvA[h_][i_] = vA[h_][i_]; } }
#define PG8_KBODY(t) do { \
            const bool last = (t == ntc - 2); \
            const char* a1 = cA + (size_t)(t + 1) * kstep; \
            const char* a2 = last ? nA : cA + (size_t)(t + 2) * kstep; const char* b2 = last ? nB : cB + (size_t)(t + 2) * kstep; \
            const char* a3 = a2 + kstep; const char* b3 = b2 + kstep; \
            const unsigned x00 = last ? nvA[0][0] : vA[0][0], x01 = last ? nvA[0][1] : vA[0][1], x10 = last ? nvA[1][0] : vA[1][0], x11 = last ? nvA[1][1] : vA[1][1]; \
            const unsigned w0_[2] = {x00, x01}, w1_[2] = {x10, x11}; \
            PG8_LDB(B0, 0, 0); PG8_LDB(B1, 0, 1); PG8_SCHED; PG8_LDA(At, 0, 0); PG8_STAGE_A(PG8_SA(1, 1), a1, 1, vA[1]); \
            PG8_WAIT_V(8); PG8_WAIT_L(0); PG8_BAR; PG8_MMA(0, 0, At, B0); PG8_MMA(0, 1, At, B1); PG8_BAR; PG8_SCHED; \
            PG8_LDA(At, 0, 1); PG8_STAGE(PG8_SB(0, 0), b2, voffB); PG8_STAGE(PG8_SB(0, 1), b2 + hstepB, voffB); PG8_STAGE_A(PG8_SA(0, 0), a2, 0, w0_); \
            PG8_WAIT_V(8); PG8_WAIT_L(0); PG8_BAR; PG8_MMA(1, 0, At, B0); PG8_MMA(1, 1, At, B1); PG8_BAR; PG8_SCHED; \
            PG8_LDB(B0, 1, 0); PG8_LDB(B1, 1, 1); PG8_SCHED; PG8_LDA(At, 1, 0); PG8_STAGE_A(PG8_SA(0, 1), a2, 1, w1_); \
            PG8_WAIT_V(8); PG8_WAIT_L(0); PG8_BAR; PG8_MMA(0, 0, At, B0); PG8_MMA(0, 1, At, B1); PG8_BAR; PG8_SCHED; \
            PG8_LDA(At, 1, 1); PG8_STAGE(PG8_SB(1, 0), b3, voffB); PG8_STAGE(PG8_SB(1, 1), b3 + hstepB, voffB); PG8_STAGE_A(PG8_SA(1, 0), a3, 0, w0_); \
            PG8_WAIT_V(8); PG8_WAIT_L(0); PG8_BAR; PG8_MMA(1, 0, At, B0); PG8_MMA(1, 1, At, B1); PG8_BAR; PG8_SCHED; \
        } while (0)
        { int t = 0;
          if constexpr (Epi::KHOOK) {
              for (; t < 4; t += 2) PG8_KBODY(t);
              E.khook(acc, cur, 4, wr, wc, fr, fq);
              for (; t < 8; t += 2) PG8_KBODY(t);
              E.khook(acc, cur, 8, wr, wc, fr, fq);
          }
          for (; t < ntc; t += 2) PG8_KBODY(t); }
#undef PG8_KBODY
        if constexpr (ALIGN_EPI) { if (wr == 0) PG8_BAR; }
        E(acc, cur, wr, wc, fr, fq);
        if (!has_next) break;
#pragma unroll
        for (int a = 0; a < 2; ++a)
#pragma unroll
            for (int b = 0; b < 2; ++b)
#pragma unroll
                for (int m = 0; m < 4; ++m)
#pragma unroll
                    for (int n = 0; n < 2; ++n) acc[a][b][m][n] = (f32x4){0.f, 0.f, 0.f, 0.f};
        cur = nxt; cA = nA; cB = nB; ++ui;
        if constexpr (Epi::GATHER) { _Pragma("unroll") for (int h_ = 0; h_ < 2; ++h_) _Pragma("unroll") for (int i_ = 0; i_ < 2; ++i_) vA[h_][i_] = nvA[h_][i_]; }
        if constexpr (ALIGN_EPI) { if (wr == 1) PG8_BAR; }
    }
    PG8_WAIT_V(0);
    if constexpr (!ALIGN_EPI) { if (wr == 0) PG8_BAR; }
    PG8_BAR;
#undef PG8_GOFFS
#undef PG8_ABASE
#undef PG8_STAGE_A
#undef PG8_SA
#undef PG8_SB
#undef PG8_STAGE
#undef PG8_LDA
#undef PG8_LDB
#undef PG8_MMA
#undef PG8_WAIT_V
#undef PG8_WAIT_L
#undef PG8_BAR
#undef PG8_SCHED
}
}

namespace fox {
using bf16=__hip_bfloat16;
#define FOX_LAS __attribute__((address_space(3)))
using bf16x8=__attribute__((ext_vector_type(8)))short;
using s16x4=__attribute__((ext_vector_type(4)))short;
using f32x16=__attribute__((ext_vector_type(16)))float;
using u32x4=__attribute__((ext_vector_type(4)))unsigned;
constexpr int BATCH=4,NHEAD=8,SEQ=4096,D=64,DM=6144,DMO=1024;
constexpr int NW=8,QBLK=32,QB=QBLK*NW,KVBLK=64,NQB=SEQ/QB;
__device__ __forceinline__ int crow(int r,int hi){return (r&3)+8*(r>>2)+4*hi;}
#define SBAR() __builtin_amdgcn_sched_barrier(0)
__device__ __forceinline__ void cmask(f32x16&p0,f32x16&p1,int jb,int qrel,int hi){
  const float NEG=-INFINITY; const int x=qrel-64*jb-4*hi;
  #pragma unroll
  for(int r=0;r<16;++r){const int c=(r&3)+8*(r>>2); if(c>x)p0[r]=NEG; if(c+32>x)p1[r]=NEG;}
}

constexpr int NSLOT=3, SLOTB=8192;
constexpr int LDS_K=0, LDS_V=NSLOT*SLOTB, LDS_WS=2*NSLOT*SLOTB, LDS_OST=LDS_WS+NW*64*4, LDS_NCK=LDS_OST+NW*4096, LDS_BYTES=LDS_NCK+(SEQ+64)*4;
constexpr float C2=0.125f*1.4426950408889634f;
__device__ __forceinline__ void glds16(const void*gsrc,unsigned lds_dst){unsigned keep;
  asm volatile("s_mov_b32 %0, m0\n\ts_mov_b32 m0, %2\n\ts_nop 0\n\tglobal_load_lds_dwordx4 %1, off\n\ts_mov_b32 m0, %0":"=&s"(keep):"v"(gsrc),"s"(lds_dst):"memory");}
__device__ __forceinline__ float max3f(float a,float b,float c){float r;asm("v_max3_f32 %0, %1, %2, %3":"=v"(r):"v"(a),"v"(b),"v"(c));return r;}
__device__ __forceinline__ float max2f(float a,float b){float r;asm("v_max_f32_e32 %0, %1, %2":"=v"(r):"v"(a),"v"(b));return r;}
__device__ __forceinline__ float fadd_s(float a,float b){float r;asm("v_add_f32_e32 %0, %1, %2":"=v"(r):"v"(a),"v"(b));return r;}
__device__ __forceinline__ float fsub_s(float a,float b){float r;asm("v_sub_f32_e32 %0, %1, %2":"=v"(r):"v"(a),"v"(b));return r;}
typedef float f32x2_t __attribute__((ext_vector_type(2))); typedef float f32x4_t __attribute__((ext_vector_type(4))); typedef __bf16 bf16x2_t __attribute__((ext_vector_type(2)));
__device__ __forceinline__ unsigned cvtpk_s(float lo,float hi){f32x2_t v={lo,hi};bf16x2_t b=__builtin_convertvector(v,bf16x2_t);return __builtin_bit_cast(unsigned,b);}
#define WAIT_BAR(N) asm volatile("s_waitcnt vmcnt(" #N ") lgkmcnt(0)\n\ts_barrier":::"memory")

__device__ __forceinline__ void qkt(f32x16&p0,f32x16&p1,const char*Kslot,const bf16x8*qr,int r32,int hi){
  const char*kb=Kslot+hi*1024+r32*16;
  #pragma unroll
  for(int d0=0;d0<4;++d0){
    const bf16x8 b0=*reinterpret_cast<const bf16x8*>(kb+d0*2048);
    const bf16x8 b1=*reinterpret_cast<const bf16x8*>(kb+d0*2048+512);
    p0=__builtin_amdgcn_mfma_f32_32x32x16_bf16(b0,qr[d0],p0,0,0,0);p1=__builtin_amdgcn_mfma_f32_32x32x16_bf16(b1,qr[d0],p1,0,0,0);}
}
__device__ __forceinline__ void nck_load(f32x16&c0,f32x16&c1,const FOX_LAS float*nckh,int tile){
  const FOX_LAS float*cp=nckh+tile*64;
  #pragma unroll
  for(int g=0;g<4;++g){ const f32x4_t a=*(const FOX_LAS f32x4_t*)(cp+8*g), b=*(const FOX_LAS f32x4_t*)(cp+32+8*g);
    c0[4*g]=a[0];c0[4*g+1]=a[1];c0[4*g+2]=a[2];c0[4*g+3]=a[3]; c1[4*g]=b[0];c1[4*g+1]=b[1];c1[4*g+2]=b[2];c1[4*g+3]=b[3]; }
}
typedef __attribute__((address_space(3))) const char* lds_cptr;
typedef short v4i16_t __attribute__((ext_vector_type(4)));
__device__ __forceinline__ void kload8(bf16x8*kf,lds_cptr kp){
  kf[0]=*(const __attribute__((address_space(3))) bf16x8*)(kp);      kf[1]=*(const __attribute__((address_space(3))) bf16x8*)(kp+512);
  kf[2]=*(const __attribute__((address_space(3))) bf16x8*)(kp+2048); kf[3]=*(const __attribute__((address_space(3))) bf16x8*)(kp+2560);
  kf[4]=*(const __attribute__((address_space(3))) bf16x8*)(kp+4096); kf[5]=*(const __attribute__((address_space(3))) bf16x8*)(kp+4608);
  kf[6]=*(const __attribute__((address_space(3))) bf16x8*)(kp+6144); kf[7]=*(const __attribute__((address_space(3))) bf16x8*)(kp+6656);
}
__device__ __forceinline__ void kload2(bf16x8*kf,lds_cptr kp,int j){ kf[2*j]=*(const __attribute__((address_space(3))) bf16x8*)(kp+j*2048); kf[2*j+1]=*(const __attribute__((address_space(3))) bf16x8*)(kp+j*2048+512); }
__device__ __forceinline__ s16x4 vtr(lds_cptr p){ return __builtin_bit_cast(s16x4,__builtin_amdgcn_ds_read_tr16_b64_v4i16((__attribute__((address_space(3))) v4i16_t*)p)); }
__device__ __forceinline__ float rowmax(const f32x16&p0,const f32x16&p1){
  float a=max3f(p0[0],p0[1],p1[0]),b=max3f(p0[2],p0[3],p1[1]);a=max3f(a,p1[2],p1[3]);
  #pragma unroll
  for(int r=4;r<16;r+=4){a=max3f(a,p0[r],p0[r+1]);b=max3f(b,p0[r+2],p0[r+3]);a=max3f(a,p1[r],p1[r+1]);b=max3f(b,p1[r+2],p1[r+3]);}
  const float m=max2f(a,b);
  auto rr=__builtin_amdgcn_permlane32_swap(__float_as_uint(m),__float_as_uint(m),false,false);
  return max2f(__uint_as_float(rr[0]),__uint_as_float(rr[1]));
}
__device__ __forceinline__ void pv(f32x16*o,int vb,bf16x8 pa0,bf16x8 pa1,bf16x8 pa2,bf16x8 pa3){
  #pragma unroll
  for(int d0=0;d0<2;++d0){s16x4 lo[4],hi[4];
    #pragma unroll
    for(int ks=0;ks<4;++ks){
      asm volatile("ds_read_b64_tr_b16 %0,%1 offset:%c2":"=&v"(lo[ks]):"v"(vb),"i"(d0*4096+ks*1024):"memory");
      asm volatile("ds_read_b64_tr_b16 %0,%1 offset:%c2":"=&v"(hi[ks]):"v"(vb),"i"(d0*4096+ks*1024+512):"memory");}
    asm volatile("s_waitcnt lgkmcnt(0)":::"memory");SBAR();
    #define PK(k) (bf16x8){lo[k][0],lo[k][1],lo[k][2],lo[k][3],hi[k][0],hi[k][1],hi[k][2],hi[k][3]}
    o[d0]=__builtin_amdgcn_mfma_f32_32x32x16_bf16(pa0,PK(0),o[d0],0,0,0);
    o[d0]=__builtin_amdgcn_mfma_f32_32x32x16_bf16(pa1,PK(1),o[d0],0,0,0);
    o[d0]=__builtin_amdgcn_mfma_f32_32x32x16_bf16(pa2,PK(2),o[d0],0,0,0);
    o[d0]=__builtin_amdgcn_mfma_f32_32x32x16_bf16(pa3,PK(3),o[d0],0,0,0);
    #undef PK
  }
}

#ifndef ATTN_STORE16
#define ATTN_STORE16(p,v) (*(u32x4*)(p)=(v))
#endif
template<int THRL> __device__ __forceinline__ void attn_unit(int b,int h,int qb,const bf16*Q,const bf16*K,const bf16*V,bf16*O,const float*LOGF,char*shm,int tid,float skip_thr){
  const int lane=tid&63,r32=lane&31,hi=lane>>5; const int wid=__builtin_amdgcn_readfirstlane(tid>>6);
  const long rowbase=(long)b*SEQ; const int q0=qb*QB;
  const bf16*Qw=Q+(rowbase+q0+wid*QBLK)*DM+h*D;
  const lds_cptr shm3=(lds_cptr)shm;
  const unsigned lds0=(unsigned)(uintptr_t)shm;
  float*wsf=(float*)(shm+LDS_WS)+wid*64;
  const int NT0=(q0+QB)/KVBLK;
  FOX_LAS float*nckw=(FOX_LAS float*)(shm3+LDS_NCK);
  { const int nkeys=q0+QB; float run=0.f;
    __syncthreads();
    #pragma unroll
    for(int e=0;e<8;++e){const int t_=tid*8+e; const float x_=t_<nkeys?LOGF[(rowbase+t_)*NHEAD+h]:0.f; run+=x_; nckw[t_]=-run;}
    float inc=run;
    #pragma unroll
    for(int o_=1;o_<64;o_<<=1){const float n_=__shfl_up(inc,o_); if(lane>=o_)inc+=n_;}
    FOX_LAS float*wt=(FOX_LAS float*)(shm3+LDS_WS);
    if(lane==63)wt[wid]=inc;
    __syncthreads();
    float off=inc-run;
    for(int w_=0;w_<wid;++w_)off+=wt[w_];
    #pragma unroll
    for(int e=0;e<8;++e){const int t_=tid*8+e; nckw[t_]-=off;}
    __syncthreads();
  }
  int ts;
  { FOX_LAS int*ti=(FOX_LAS int*)(shm3+LDS_WS)+32;
    if(wid==0){ const bool keep=(lane<NT0)&&(nckw[64*lane+63]>=nckw[q0]-skip_thr); const unsigned long long m_=__ballot(keep); if(lane==0)ti[0]=m_?__builtin_ctzll(m_):0; }
    __syncthreads();
    ts=__builtin_amdgcn_readfirstlane(ti[0]); ts&=~1; if(ts>NT0-4)ts=NT0-4;
  }
  const int NT=NT0-ts;
  const bf16*Kh=K+(rowbase+(long)ts*KVBLK)*DM+h*D,*Vh=V+(rowbase+(long)ts*KVBLK)*DM+h*D;
  const bf16*ksrc=Kh+(long)lane*DM+wid*8;
  const bf16*vsrc=Vh+(long)(16*(wid&3)+(lane>>2))*DM+(wid>>2)*32+(lane&3)*8;
  const unsigned kdst=lds0+LDS_K+wid*1024, vdst=lds0+LDS_V+wid*1024;
  #define DMA_K(t,slot) glds16(ksrc+(long)(t)*KVBLK*DM,(unsigned)__builtin_amdgcn_readfirstlane(kdst+(slot)))
  #define DMA_V(t,slot) glds16(vsrc+(long)(t)*KVBLK*DM,(unsigned)__builtin_amdgcn_readfirstlane(vdst+(slot)))
  const int vb0=(int)(lds0+LDS_V)+((lane>>4)&1)*32+(lane&3)*8+(4*hi+((lane&15)>>2))*64;
  const char*Kbase=shm+LDS_K; bf16x8 kf[8];
  const lds_cptr kp0=shm3+LDS_K+hi*1024+r32*16; const lds_cptr vp0=shm3+LDS_V+((lane>>4)&1)*32+(lane&3)*8+(4*hi+((lane&15)>>2))*64;
  const FOX_LAS float*nckh=(const FOX_LAS float*)(shm3+LDS_NCK)+ts*KVBLK+4*hi;
  DMA_K(0,0);DMA_V(0,0);DMA_K(1,SLOTB);
  bf16x8 qr[4];
  #pragma unroll
  for(int d0=0;d0<4;++d0)qr[d0]=*reinterpret_cast<const bf16x8*>(&Qw[(long)r32*DM+d0*16+hi*8]);
  float l_reg=0.f;f32x16 o[2];o[0]=f32x16{};o[1]=f32x16{};
  const int qrel=wid*QBLK+r32;
  float nq=-nckw[q0+qrel];
  #define CMASK(P0,P1,t) do{int jb_=(t)-(NT-4); if(jb_>=0)cmask(P0,P1,jb_,qrel,hi);}while(0)
  bool resc=false;
  #define START(P0,P1) do{ const float rm=rowmax(P0,P1); resc=false; \
    { const float dl=rm; nq=fsub_s(nq,dl); \
      _Pragma("unroll") for(int r=0;r<16;++r){P0[r]=fsub_s(P0[r],dl);P1[r]=fsub_s(P1[r],dl);} } \
    _Pragma("unroll") for(int r=0;r<16;++r)P0[r]=__builtin_amdgcn_exp2f(P0[r]); }while(0)
  #define RESC() do{ if(resc){ asm volatile("s_waitcnt lgkmcnt(0)":::"memory"); \
      _Pragma("unroll") for(int d_=0;d_<2;++d_) _Pragma("unroll") for(int r=0;r<16;++r)o[d_][r]*=wsf[crow(r,hi)]; } }while(0)
  f32x16 pA0,pA1,pB0,pB1;
  int sl_prev=0,sl_cur=0,sl_next=SLOTB;
  #define ROT() do{sl_prev=sl_cur;sl_cur=sl_next;sl_next=(sl_next==(NSLOT-1)*SLOTB)?0:sl_next+SLOTB;}while(0)
  DMA_K(2,2*SLOTB);
  WAIT_BAR(3);
  nck_load(pA0,pA1,nckh,0);
  _Pragma("unroll") for(int r=0;r<16;++r){pA0[r]+=nq;pA1[r]+=nq;}
  qkt(pA0,pA1,Kbase,qr,r32,hi);asm volatile("s_nop 15\n\ts_nop 7":"+v"(pA0),"+v"(pA1));CMASK(pA0,pA1,0);
  START(pA0,pA1);
  _Pragma("unroll") for(int r=0;r<16;++r)pA1[r]=__builtin_amdgcn_exp2f(pA1[r]);
  nck_load(pB0,pB1,nckh,1);
  _Pragma("unroll") for(int r=0;r<16;++r){pB0[r]+=nq;pB1[r]+=nq;}
  WAIT_BAR(0);
  DMA_K(3,0);DMA_V(1,SLOTB);
  ROT();
  kload8(kf,kp0+sl_cur);
  WAIT_BAR(2);
  s16x4 vlo[8],vhi[8]; u32x4 pw0,pw1,pw2,pw3;
  #define PKW(P,B) cvtpk_s(P[B],P[B+1])
  #define PAF(k) __builtin_bit_cast(bf16x8,pw##k)
  #define VFR(i) (bf16x8){vlo[i][0],vlo[i][1],vlo[i][2],vlo[i][3],vhi[i][0],vhi[i][1],vhi[i][2],vhi[i][3]}
  #define PIN(x) asm volatile("":"+v"(x))
  #define MX3(a,b,c) __builtin_fmaxf(__builtin_fmaxf((a),(b)),(c))
  #define GAPA(MF,A0,A1,A2,A3,W0,W1,PW) do{ MF; sacc+=A0; sacc+=A1; sacc+=A2; sacc+=A3; PIN(sacc); W0; W1; PIN(PW); SBAR(); }while(0)
  #define EX(v) __builtin_amdgcn_exp2f(v)
  #define GAPB(MF,X,B,GL_,Y) do{ MF; X[B]=EX(X[B]); X[B+1]=EX(X[B+1]); X[B+2]=EX(X[B+2]); X[B+3]=EX(X[B+3]); PIN(X); if(GL_){ Y[B]+=nq; Y[B+1]+=nq; Y[B+2]+=nq; Y[B+3]+=nq; PIN(Y); } SBAR(); }while(0)
  #define VRD(i) do{ vlo[i]=vtr(vp_+(((i)>>2)*4096+((i)&3)*1024)); vhi[i]=vtr(vp_+(((i)>>2)*4096+((i)&3)*1024+512)); }while(0)
  #define KRD(G,j) do{ if(G){ kload2(kf,kp0+sl_next,j); SBAR(); } }while(0)
  #define STEP(C0,C1,P0,P1,t,GK,GV,GL) do{ SBAR(); \
    const lds_cptr vp_=vp0+sl_prev; \
    VRD(0); SBAR(); float sacc=(P0[0]+P0[1]); \
    GAPA(C0=__builtin_amdgcn_mfma_f32_32x32x16_bf16(kf[0],qr[0],C0,0,0,0), P0[2],P0[3],P0[4],P0[5],     pw0[0]=PKW(P0,0), pw0[1]=PKW(P0,2), pw0); \
    VRD(4); SBAR(); GAPA(C1=__builtin_amdgcn_mfma_f32_32x32x16_bf16(kf[1],qr[0],C1,0,0,0), P0[6],P0[7],P0[8],P0[9],     pw0[2]=PKW(P0,4), pw0[3]=PKW(P0,6), pw0); \
    VRD(1); SBAR(); GAPA(C0=__builtin_amdgcn_mfma_f32_32x32x16_bf16(kf[2],qr[1],C0,0,0,0),   P0[10],P0[11],P0[12],P0[13], pw1[0]=PKW(P0,8), pw1[1]=PKW(P0,10), pw1); \
    VRD(5); SBAR(); GAPA(C1=__builtin_amdgcn_mfma_f32_32x32x16_bf16(kf[3],qr[1],C1,0,0,0),   P0[14],P0[15],P1[0],P1[1],   pw1[2]=PKW(P0,12),pw1[3]=PKW(P0,14), pw1); \
    VRD(2); SBAR(); GAPA(C0=__builtin_amdgcn_mfma_f32_32x32x16_bf16(kf[4],qr[2],C0,0,0,0),   P1[2],P1[3],P1[4],P1[5],     pw2[0]=PKW(P1,0), pw2[1]=PKW(P1,2), pw2); \
    VRD(6); SBAR(); GAPA(C1=__builtin_amdgcn_mfma_f32_32x32x16_bf16(kf[5],qr[2],C1,0,0,0),   P1[6],P1[7],P1[8],P1[9],     pw2[2]=PKW(P1,4), pw2[3]=PKW(P1,6), pw2); \
    VRD(3); SBAR(); GAPA(C0=__builtin_amdgcn_mfma_f32_32x32x16_bf16(kf[6],qr[3],C0,0,0,0),   P1[10],P1[11],P1[12],P1[13], pw3[0]=PKW(P1,8), pw3[1]=PKW(P1,10), pw3); \
    VRD(7); SBAR(); GAPA(C1=__builtin_amdgcn_mfma_f32_32x32x16_bf16(kf[7],qr[3],C1,0,0,0),   P1[14],P1[15],0.f,0.f,       pw3[2]=PKW(P1,12),pw3[3]=PKW(P1,14), pw3); \
    l_reg+=sacc; \
    if(GL){ nck_load(P0,P1,nckh,(t)+1); SBAR(); } \
    if(GK){DMA_K((t)+3,sl_cur);} if(GV){DMA_V((t)+1,sl_next);} \
    CMASK(C0,C1,t); \
    { float a=MX3(C0[0],C0[1],C1[0]),b=MX3(C0[2],C0[3],C1[1]); a=MX3(a,C1[2],C1[3]); \
      _Pragma("unroll") for(int r=4;r<16;r+=4){a=MX3(a,C0[r],C0[r+1]);b=MX3(b,C0[r+2],C0[r+3]);a=MX3(a,C1[r],C1[r+1]);b=MX3(b,C1[r+2],C1[r+3]);} \
      float rm=__builtin_fmaxf(a,b); { auto rr=__builtin_amdgcn_permlane32_swap(__float_as_uint(rm),__float_as_uint(rm),false,false); rm=__builtin_fmaxf(__uint_as_float(rr[0]),__uint_as_float(rr[1])); } \
      resc=false; \
      if(__builtin_expect(__any(rm>(float)THRL),0)){ const float dl=__builtin_fmaxf(rm,0.f); nq-=dl; \
        _Pragma("unroll") for(int r=0;r<16;++r){C0[r]-=dl;C1[r]-=dl;} \
        const float f=__builtin_amdgcn_exp2f(-dl); l_reg*=f; if(hi==0)wsf[r32]=f; resc=true; } } \
    SBAR(); \
    GAPB(o[0]=__builtin_amdgcn_mfma_f32_32x32x16_bf16(PAF(0),VFR(0),o[0],0,0,0), C0,0,GL,P0); \
    GAPB(o[1]=__builtin_amdgcn_mfma_f32_32x32x16_bf16(PAF(0),VFR(4),o[1],0,0,0), C0,4,GL,P0); \
    KRD(GL,0); GAPB(o[0]=__builtin_amdgcn_mfma_f32_32x32x16_bf16(PAF(1),VFR(1),o[0],0,0,0), C0,8,GL,P0); \
    KRD(GL,1); GAPB(o[1]=__builtin_amdgcn_mfma_f32_32x32x16_bf16(PAF(1),VFR(5),o[1],0,0,0), C0,12,GL,P0); \
    KRD(GL,2); GAPB(o[0]=__builtin_amdgcn_mfma_f32_32x32x16_bf16(PAF(2),VFR(2),o[0],0,0,0), C1,0,GL,P1); \
    KRD(GL,3); GAPB(o[1]=__builtin_amdgcn_mfma_f32_32x32x16_bf16(PAF(2),VFR(6),o[1],0,0,0), C1,4,GL,P1); \
    GAPB(o[0]=__builtin_amdgcn_mfma_f32_32x32x16_bf16(PAF(3),VFR(3),o[0],0,0,0), C1,8,GL,P1); \
    GAPB(o[1]=__builtin_amdgcn_mfma_f32_32x32x16_bf16(PAF(3),VFR(7),o[1],0,0,0), C1,12,GL,P1); \
    }while(0)
  int t=1;
  #undef CMASK
  #define CMASK(P0,P1,t) do{}while(0)
  for(;t+5<NT;t+=2){
    STEP(pB0,pB1,pA0,pA1,t,true,true,true);     WAIT_BAR(2); RESC(); ROT();
    STEP(pA0,pA1,pB0,pB1,t+1,true,true,true);   WAIT_BAR(2); RESC(); ROT();
  }
  #undef CMASK
  #define CMASK(P0,P1,t) do{int jb_=(t)-(NT-4); if(jb_>=0)cmask(P0,P1,jb_,qrel,hi);}while(0)
  #define ENDW(tt) do{ if((tt)+3<NT){WAIT_BAR(2);} else if((tt)+2<NT){WAIT_BAR(1);} else {WAIT_BAR(0);} }while(0)
  for(;t+1<NT;t+=2){
    STEP(pB0,pB1,pA0,pA1,t,(t+3<NT),(t+1<NT),(t+1<NT));       ENDW(t);   RESC(); ROT();
    STEP(pA0,pA1,pB0,pB1,t+1,(t+4<NT),(t+2<NT),(t+2<NT));     ENDW(t+1); RESC(); ROT();
  }
  STEP(pB0,pB1,pA0,pA1,NT-1,false,false,false); RESC();
  { float sacc=pB0[0]+pB0[1]; _Pragma("unroll") for(int r=2;r<16;++r)sacc+=pB0[r]; _Pragma("unroll") for(int r=0;r<16;++r)sacc+=pB1[r]; l_reg+=sacc;
    pw0=(u32x4){PKW(pB0,0),PKW(pB0,2),PKW(pB0,4),PKW(pB0,6)};pw1=(u32x4){PKW(pB0,8),PKW(pB0,10),PKW(pB0,12),PKW(pB0,14)};pw2=(u32x4){PKW(pB1,0),PKW(pB1,2),PKW(pB1,4),PKW(pB1,6)};pw3=(u32x4){PKW(pB1,8),PKW(pB1,10),PKW(pB1,12),PKW(pB1,14)};
    SBAR(); pv(o,vb0+sl_cur,PAF(0),PAF(1),PAF(2),PAF(3)); }
  #undef PKW
  #undef PAF
  #undef VFR
  #undef PIN
  #undef MX3
  #undef GAPA
  #undef GAPB
  #undef EX
  #undef VRD
  #undef KRD
  #undef STEP
  #undef ENDW
  {auto rr=__builtin_amdgcn_permlane32_swap(__float_as_uint(l_reg),__float_as_uint(l_reg),false,false);l_reg=__uint_as_float(rr[0])+__uint_as_float(rr[1]);}
  if(hi==0)wsf[32+r32]=l_reg;asm volatile("s_waitcnt lgkmcnt(0)":::"memory");
  float rli[16];
  #pragma unroll
  for(int r=0;r<16;++r)rli[r]=__builtin_amdgcn_rcpf(wsf[32+crow(r,hi)]);
  bf16*Ow=O+(rowbase+q0+wid*QBLK)*DMO+h*D;
  { bf16*stg=(bf16*)(shm+LDS_OST)+wid*2048;
    #pragma unroll
    for(int r=0;r<16;++r){const int orow=crow(r,hi);
      #pragma unroll
      for(int d0=0;d0<2;++d0)stg[orow*64+d0*32+r32]=__float2bfloat16(o[d0][r]*rli[r]);}
    asm volatile("s_waitcnt lgkmcnt(0)":::"memory");
    #pragma unroll
    for(int i=0;i<4;++i){const int row=i*8+(lane>>3),ch=lane&7; const u32x4 v=*(const u32x4*)(stg+row*64+ch*8); ATTN_STORE16(Ow+(long)row*DMO+ch*8,v);} }
  asm volatile("s_waitcnt lgkmcnt(0)\n\ts_barrier":::"memory");
  #undef DMA_K
  #undef DMA_V
  #undef CMASK
  #undef START
  #undef RESC
  #undef ROT
}
constexpr int ATTN_LDS_BYTES=LDS_BYTES;
#undef SBAR
#undef WAIT_BAR
#undef FOX_LAS
}

constexpr int NWAVES = 8, NTHR = 512;
constexpr int DM = 1024, NB = 4, NT = 4096, NL = 4, M = NB * NT;
constexpr int NHR = 4, NHF = 8, HD = 64;
constexpr int INW = 6024, ZW = 6144;
constexpr int ZC_U = 0, ZC_V = 256, ZC_R = 512, ZC_LORA = 1280, ZC_FL = 1408, ZC_Q = 1536, ZC_KF = 2048, ZC_VF = 2560, ZC_GATE = 3072;
constexpr int NE = 32, TOPK = 4, DFF = 1024;
constexpr int RWC = 32, NCH = NT / RWC;
constexpr int MAXTILES = 288, XROWS = MAXTILES * 256;
constexpr float LOG2E = 1.4426950408889634f;
constexpr float QSCALE = 0.125f * LOG2E;

constexpr size_t MiB = 1u << 20;
constexpr size_t WS_CTL = 0, CTL_ZERO_BYTES = 1 * MiB;
constexpr size_t WS_MOD = 1 * MiB;
constexpr size_t WS_WRT = 1 * MiB + 512 * 1024;
constexpr size_t WS_WIN = 2 * MiB;
constexpr size_t WS_WBR = 50 * MiB;
constexpr size_t WS_WO = 58 * MiB;
constexpr size_t WS_WGU = 66 * MiB;
constexpr size_t WS_WD = 578 * MiB;
constexpr size_t WS_XN = 1912 * MiB;
constexpr size_t WS_Z = 866 * MiB;
constexpr size_t WS_FLOGIT = 1058 * MiB;
constexpr size_t WS_LOGF = 1059 * MiB;
constexpr size_t WS_RW = 1060 * MiB;
constexpr size_t WS_Y0 = 1172 * MiB, WS_RT = 1188 * MiB;
constexpr size_t WS_S0END = 1816 * MiB, WS_SST = 1880 * MiB;
constexpr size_t WS_PEND = 1945 * MiB;
constexpr int PIMG_BYTES = 2 * 64 * 64 * 2;
constexpr size_t WS_SSP = 1204 * MiB;
constexpr size_t WS_YMIX = 1252 * MiB;
constexpr size_t WS_MRG = 1284 * MiB;
constexpr size_t WS_MERGED = 1348 * MiB;
constexpr size_t WS_ROWTOK = 1380 * MiB;
constexpr size_t WS_TOKPOS = 1382 * MiB;
constexpr size_t WS_TOKW = 1383 * MiB;
constexpr size_t WS_XS = 1384 * MiB;
constexpr size_t WS_ACT = 1528 * MiB;
constexpr size_t WS_YS = 1672 * MiB;
constexpr size_t WS_END = 1985 * MiB;
constexpr int CW_BAR = 4096;
constexpr int CW_TS = 8192;
constexpr int CW_ATT = 12288;
constexpr int CW_CUR = 16384;

constexpr int RING_BYTES = 131072;
constexpr int LDS_BYTES = 153600;
constexpr int LDSCTL_OFF = LDS_BYTES - 1024;

#define GAS __attribute__((address_space(1)))
#define LAS __attribute__((address_space(3)))
typedef unsigned short bf16;
typedef unsigned v4u __attribute__((ext_vector_type(4)));
typedef unsigned v2u __attribute__((ext_vector_type(2)));
typedef float f32x4 __attribute__((ext_vector_type(4)));
#define LDS_WAIT() asm volatile("s_waitcnt lgkmcnt(0)" ::: "memory")
#define VM_WAIT() asm volatile("s_waitcnt vmcnt(0)" ::: "memory")
__device__ __forceinline__ unsigned f2bf(float f) { unsigned u = __builtin_bit_cast(unsigned, f); return (u + 0x7fffu + ((u >> 16) & 1u)) >> 16; }

typedef float cvt_f32x2_t __attribute__((ext_vector_type(2))); typedef __bf16 cvt_bf16x2_t __attribute__((ext_vector_type(2)));
__device__ __forceinline__ unsigned cvtpk_c(float lo, float hi) { cvt_f32x2_t v = {lo, hi}; cvt_bf16x2_t b = __builtin_convertvector(v, cvt_bf16x2_t); return __builtin_bit_cast(unsigned, b); }
__device__ __forceinline__ unsigned pk2(float lo, float hi) { return cvtpk_c(lo, hi); }
__device__ __forceinline__ float bflo(unsigned w) { return __builtin_bit_cast(float, w << 16); }
__device__ __forceinline__ float bfhi(unsigned w) { return __builtin_bit_cast(float, w & 0xffff0000u); }
__device__ __forceinline__ float bf2f(bf16 h) { return __builtin_bit_cast(float, (unsigned)h << 16); }

#define XB_TMO      128
#define XB_XCNT(j)  (256  + 64 * (j))
#define XB_XSUB(j)  (1280 + 64 * (j))
#define XB_XGEN(j)  (2304 + 64 * (j))
#define XB_TOP      3328
#define XB_TOPGEN   3392
#define XCD_BAR_WORDS 3456
#define XB_SPIN_CAP (1u << 22)

__device__ __forceinline__ unsigned xb_ld(unsigned* p)              { return __hip_atomic_load(p, __ATOMIC_RELAXED, __HIP_MEMORY_SCOPE_AGENT); }
__device__ __forceinline__ unsigned xb_add(unsigned* p, unsigned v) { return __hip_atomic_fetch_add(p, v, __ATOMIC_RELAXED, __HIP_MEMORY_SCOPE_AGENT); }
__device__ __forceinline__ unsigned xb_xcc_id() { return (unsigned)__builtin_amdgcn_s_getreg((3 << 11) | 20) & 0xFu; }
#define XB_SPIN(cond, bar) do { unsigned _sp = 0; while (cond) { __builtin_amdgcn_s_sleep(1); \
    if ((++_sp & 255u) == 0u) { if (xb_ld(&(bar)[XB_TMO])) break; if (_sp > XB_SPIN_CAP) { atomicAdd(&(bar)[XB_TMO], 1u); break; } } } } while (0)

struct XcdBarrier { unsigned* bar; unsigned x; volatile LAS unsigned* st; };

__device__ __forceinline__ XcdBarrier xcd_barrier_post(unsigned* bar, volatile LAS unsigned* st) {
    XcdBarrier b; b.bar = bar; b.x = xb_xcc_id(); b.st = st;
    if (threadIdx.x == 0) (void)xb_add(&bar[XB_XCNT(b.x)], 1u);
    return b;
}
__device__ __forceinline__ void xcd_barrier_complete(unsigned* bar, unsigned x, unsigned& nloc, unsigned& nx) {
    const unsigned G = gridDim.x * gridDim.y * gridDim.z;
    unsigned sum, cnt, mine, sp = 0u;
    for (;;) {
        sum = 0u; cnt = 0u; mine = 0u;
#pragma unroll
        for (unsigned j = 0; j < 16; ++j) { const unsigned c = xb_ld(&bar[XB_XCNT(j)]); sum += c; cnt += (c > 0u) ? 1u : 0u; mine = (j == x) ? c : mine; }
        if (sum == G) break;
        __builtin_amdgcn_s_sleep(1);
        if ((++sp & 255u) == 0u) { if (xb_ld(&bar[XB_TMO])) break; if (sp > XB_SPIN_CAP) { atomicAdd(&bar[XB_TMO], 1u); break; } }
    }
    nloc = mine > 0u ? mine : 1u; nx = cnt > 0u ? cnt : 1u;
}
__device__ __forceinline__ void xcd_barrier(const XcdBarrier& b0, unsigned* barp) {
    XcdBarrier b; b.bar = barp; b.x = xb_xcc_id(); b.st = b0.st;
    asm volatile("s_waitcnt vmcnt(0)" ::: "memory");
    __syncthreads();
    if (threadIdx.x == 0) {
        unsigned* bar = b.bar;
        __builtin_amdgcn_s_waitcnt(0);
        unsigned nloc = b.st[0], nx = b.st[1];
        if (nloc == 0u) { xcd_barrier_complete(bar, b.x, nloc, nx); b.st[0] = nloc; b.st[1] = nx; }
        const unsigned old = xb_add(&bar[XB_XSUB(b.x)], 1u);
        const unsigned gen = old / nloc;
        if (old + 1u == (gen + 1u) * nloc) {
            __builtin_amdgcn_fence(__ATOMIC_RELEASE, "agent");
            asm volatile("s_waitcnt vmcnt(0)" ::: "memory");
            const unsigned og = xb_add(&bar[XB_TOP], 1u);
            const unsigned tg = og / nx;
            if (og + 1u == (tg + 1u) * nx) xb_add(&bar[XB_TOPGEN], 1u);
            else XB_SPIN(xb_ld(&bar[XB_TOPGEN]) == tg, bar);
            __builtin_amdgcn_fence(__ATOMIC_ACQUIRE, "agent");
            xb_add(&bar[XB_XGEN(b.x)], 1u);
            asm volatile("s_waitcnt vmcnt(0)" ::: "memory");
        } else {
            XB_SPIN(xb_ld(&bar[XB_XGEN(b.x)]) == gen, bar);
            __builtin_amdgcn_fence(__ATOMIC_ACQUIRE, "agent");
            asm volatile("s_waitcnt vmcnt(0)" ::: "memory");
        }
    }
    __syncthreads();
}

struct Params { const float* in[30]; float* out; unsigned char* ws; };
typedef const __attribute__((address_space(4))) unsigned long long* kptr_t;
struct Frame {
    LAS unsigned char* lds;
    kptr_t ka;
    int tid, lane, wave, G, gw, ngw, bid;
    __device__ __forceinline__ const float* in(int k) const { return (const float*)(const GAS float*)ka[k]; }
    __device__ __forceinline__ float* out() const { return (float*)(GAS float*)ka[30]; }
    __device__ __forceinline__ unsigned char* ws() const { return (unsigned char*)(GAS unsigned char*)ka[31]; }
};
template <int CTRL> __device__ __forceinline__ float dpp_add(float v) { return v + __builtin_bit_cast(float, __builtin_amdgcn_update_dpp(0, __builtin_bit_cast(int, v), CTRL, 0xf, 0xf, true)); }
__device__ __forceinline__ float wave_sum(float v) {
    v = dpp_add<0xB1>(v); v = dpp_add<0x4E>(v); v = dpp_add<0x141>(v); v = dpp_add<0x140>(v);
    v += __builtin_bit_cast(float, __builtin_amdgcn_update_dpp(0, __builtin_bit_cast(int, v), 0x142, 0xa, 0xf, false));
    v += __builtin_bit_cast(float, __builtin_amdgcn_update_dpp(0, __builtin_bit_cast(int, v), 0x143, 0xc, 0xf, false));
    return __builtin_bit_cast(float, __builtin_amdgcn_readlane(__builtin_bit_cast(int, v), 63));
}
__device__ __forceinline__ float quad_sum(float x) {
    x += __builtin_bit_cast(float, __builtin_amdgcn_update_dpp(0, __builtin_bit_cast(int, x), 0xB1, 0xf, 0xf, true));
    x += __builtin_bit_cast(float, __builtin_amdgcn_update_dpp(0, __builtin_bit_cast(int, x), 0x4E, 0xf, 0xf, true));
    return x;
}
__device__ __forceinline__ float rcp_(float x) { return __builtin_amdgcn_rcpf(x); }
__device__ __forceinline__ float rsq_(float x) { return __builtin_amdgcn_rsqf(x); }
__device__ __forceinline__ float sigmoidf_(float x) { return rcp_(1.f + __expf(-x)); }
__device__ __forceinline__ float sigmoid_fast(float x) { return __builtin_amdgcn_rcpf(1.f + __builtin_amdgcn_exp2f(-1.4426950408889634f * x)); }
__device__ __forceinline__ float gelu_tanh(float x) { const float y = 0.7978845608028654f * (x + 0.044715f * x * x * x); const float t = 1.f - 2.f * rcp_(1.f + __expf(2.f * y)); return 0.5f * x * (1.f + t); }
__device__ __forceinline__ float softplusf_(float x) { return fmaxf(x, 0.f) + __logf(1.f + __expf(-fabsf(x))); }

using pg8::Unit; using pg8::cvt_pk_bf16;
struct EpiBase {
    static constexpr bool KHOOK = false, GATHER = false;
    __device__ __forceinline__ int row_src(const Unit&, int R) const { return R; }
    __device__ __forceinline__ size_t a_koff(const Unit&) const { return 0; }
    __device__ __forceinline__ size_t b_koff(const Unit&) const { return 0; }
    __device__ __forceinline__ int b_tile(const Unit& u) const { return u.pn; }
    __device__ __forceinline__ int ktiles(const Unit&, int nt) const { return nt; }
};
struct EpiZ : EpiBase {
    static constexpr bool PERM = true;
    bf16* Z; float* FL;
    __device__ __forceinline__ void operator()(const f32x4 (&acc)[2][2][4][2], const Unit& u, int wr, int wc, int fr, int fq) const {
        const int row0 = u.pm * 256 + wr * 64 + fr, col0 = u.pn * 256 + wc * 32 + 8 * fq;
#pragma unroll
        for (int ai = 0; ai < 2; ++ai)
#pragma unroll
            for (int m = 0; m < 4; ++m) { const int row = row0 + ai * 128 + m * 16; bf16* rowp = Z + (size_t)row * ZW + col0;
#pragma unroll
                for (int bj = 0; bj < 2; ++bj) { const f32x4 v0 = acc[ai][bj][m][0], v1 = acc[ai][bj][m][1];
                    v4u w; w.x = cvt_pk_bf16(v0[0], v0[1]); w.y = cvt_pk_bf16(v0[2], v0[3]); w.z = cvt_pk_bf16(v1[0], v1[1]); w.w = cvt_pk_bf16(v1[2], v1[3]);
                    *(v4u*)(rowp + bj * 128) = w; }
                if (u.pn == 5 && wc == 0 && fq == 0) { *(f32x4*)(FL + (size_t)row * 8) = acc[ai][1][m][0]; *(f32x4*)(FL + (size_t)row * 8 + 4) = acc[ai][1][m][1]; } }
    }
};
struct EpiMerge : EpiBase {
    static constexpr bool PERM = true;
    const bf16* Z; float* MRG; bf16* MERGED;
    __device__ __forceinline__ int br(const Unit& u) const { return u.pn % 3; }
    __device__ __forceinline__ size_t a_koff(const Unit& u) const { const int b = br(u); return (size_t)(b == 0 ? 0 : (b == 1 ? 256 : 512)) * 2; }
    __device__ __forceinline__ size_t b_koff(const Unit& u) const { return a_koff(u); }
    __device__ __forceinline__ int b_tile(const Unit& u) const { return u.pn / 3; }
    __device__ __forceinline__ int ktiles(const Unit& u, int) const { return br(u) == 2 ? 8 : 4; }
    __device__ __forceinline__ void operator()(const f32x4 (&acc)[2][2][4][2], const Unit& u, int wr, int wc, int fr, int fq) const {
        const int b = br(u), pn = u.pn / 3;
        const int row0 = u.pm * 256 + wr * 64 + fr, col0 = pn * 256 + wc * 32 + 8 * fq;
#pragma unroll
        for (int ai = 0; ai < 2; ++ai)
#pragma unroll
            for (int m = 0; m < 4; ++m) { const int row = row0 + ai * 128 + m * 16;
#pragma unroll
                for (int bj = 0; bj < 2; ++bj) { const int col = col0 + bj * 128;
                    const v4u gz = *(const v4u*)(Z + (size_t)row * ZW + ZC_GATE + b * 1024 + col);
                    f32x4 v0 = acc[ai][bj][m][0], v1 = acc[ai][bj][m][1];
                    v0[0] *= sigmoid_fast(bflo(gz.x)); v0[1] *= sigmoid_fast(bfhi(gz.x)); v0[2] *= sigmoid_fast(bflo(gz.y)); v0[3] *= sigmoid_fast(bfhi(gz.y));
                    v1[0] *= sigmoid_fast(bflo(gz.z)); v1[1] *= sigmoid_fast(bfhi(gz.z)); v1[2] *= sigmoid_fast(bflo(gz.w)); v1[3] *= sigmoid_fast(bfhi(gz.w));
                    float* mp = MRG + (size_t)row * DM + col;
                    if (b > 0) { v0 += *(const f32x4*)mp; v1 += *(const f32x4*)(mp + 4); }
                    if (b < 2) { *(f32x4*)mp = v0; *(f32x4*)(mp + 4) = v1; }
                    else { v4u w; w.x = cvt_pk_bf16(v0[0], v0[1]); w.y = cvt_pk_bf16(v0[2], v0[3]); w.z = cvt_pk_bf16(v1[0], v1[1]); w.w = cvt_pk_bf16(v1[2], v1[3]);
                        *(v4u*)(MERGED + (size_t)row * DM + col) = w; } } }
    }
};
struct EpiMerge2 : EpiBase {
    static constexpr bool PERM = true, KHOOK = true;
    const bf16* Z; bf16* MERGED;
    static __device__ __forceinline__ float en(float z) { return __builtin_amdgcn_exp2f(-1.4426950408889634f * fminf(fmaxf(z, -30.f), 30.f)); }
    __device__ __forceinline__ void khook(f32x4 (&acc)[2][2][4][2], const Unit& u, int t, int wr, int wc, int fr, int fq) const {
        const int ga = (t == 4) ? 0 : 1;
        int row0 = u.pm * 256 + wr * 64 + fr, col0 = u.pn * 256 + wc * 32 + 8 * fq; const bf16* Zl = Z;
        asm volatile("" : "+v"(row0), "+v"(col0), "+s"(Zl));
#pragma unroll
        for (int ai = 0; ai < 2; ++ai)
#pragma unroll
            for (int m = 0; m < 4; ++m) { const int row = row0 + ai * 128 + m * 16;
#pragma unroll
                for (int bj = 0; bj < 2; ++bj) { const bf16* zp = Zl + (size_t)row * ZW + ZC_GATE + ga * 1024 + col0 + bj * 128;
                    const v4u za = *(const v4u*)zp, zb = *(const v4u*)(zp + 1024);
                    f32x4 r0, r1;
                    r0[0] = (1.f + en(bflo(zb.x))) * __builtin_amdgcn_rcpf(1.f + en(bflo(za.x))); r0[1] = (1.f + en(bfhi(zb.x))) * __builtin_amdgcn_rcpf(1.f + en(bfhi(za.x)));
                    r0[2] = (1.f + en(bflo(zb.y))) * __builtin_amdgcn_rcpf(1.f + en(bflo(za.y))); r0[3] = (1.f + en(bfhi(zb.y))) * __builtin_amdgcn_rcpf(1.f + en(bfhi(za.y)));
                    r1[0] = (1.f + en(bflo(zb.z))) * __builtin_amdgcn_rcpf(1.f + en(bflo(za.z))); r1[1] = (1.f + en(bfhi(zb.z))) * __builtin_amdgcn_rcpf(1.f + en(bfhi(za.z)));
                    r1[2] = (1.f + en(bflo(zb.w))) * __builtin_amdgcn_rcpf(1.f + en(bflo(za.w))); r1[3] = (1.f + en(bfhi(zb.w))) * __builtin_amdgcn_rcpf(1.f + en(bfhi(za.w)));
                    acc[ai][bj][m][0] *= r0; acc[ai][bj][m][1] *= r1;
                    asm volatile("" : "+v"(acc[ai][bj][m][0]), "+v"(acc[ai][bj][m][1]) :: "memory"); } }
    }
    __device__ __forceinline__ void operator()(const f32x4 (&acc)[2][2][4][2], const Unit& u, int wr, int wc, int fr, int fq) const {
        int row0 = u.pm * 256 + wr * 64 + fr, col0 = u.pn * 256 + wc * 32 + 8 * fq; const bf16* Zl = Z;
        asm volatile("" : "+v"(row0), "+v"(col0), "+s"(Zl));
#pragma unroll
        for (int ai = 0; ai < 2; ++ai)
#pragma unroll
            for (int m = 0; m < 4; ++m) { const int row = row0 + ai * 128 + m * 16;
#pragma unroll
                for (int bj = 0; bj < 2; ++bj) { const int col = col0 + bj * 128;
                    const v4u gz = *(const v4u*)(Zl + (size_t)row * ZW + ZC_GATE + 2 * 1024 + col);
                    f32x4 v0 = acc[ai][bj][m][0], v1 = acc[ai][bj][m][1];
                    v0[0] *= __builtin_amdgcn_rcpf(1.f + en(bflo(gz.x))); v0[1] *= __builtin_amdgcn_rcpf(1.f + en(bfhi(gz.x))); v0[2] *= __builtin_amdgcn_rcpf(1.f + en(bflo(gz.y))); v0[3] *= __builtin_amdgcn_rcpf(1.f + en(bfhi(gz.y)));
                    v1[0] *= __builtin_amdgcn_rcpf(1.f + en(bflo(gz.z))); v1[1] *= __builtin_amdgcn_rcpf(1.f + en(bfhi(gz.z))); v1[2] *= __builtin_amdgcn_rcpf(1.f + en(bflo(gz.w))); v1[3] *= __builtin_amdgcn_rcpf(1.f + en(bfhi(gz.w)));
                    v4u w; w.x = cvt_pk_bf16(v0[0], v0[1]); w.y = cvt_pk_bf16(v0[2], v0[3]); w.z = cvt_pk_bf16(v1[0], v1[1]); w.w = cvt_pk_bf16(v1[2], v1[3]);
                    *(v4u*)(MERGED + (size_t)row * DM + col) = w; } }
    }
};
struct EpiWo : EpiBase {
    static constexpr bool PERM = false;
    const float* xin; float* xout; const float* gate; float* SSP;
    __device__ __forceinline__ void operator()(const f32x4 (&acc)[2][2][4][2], const Unit& u, int wr, int wc, int fr, int fq) const {
        const int row0 = u.pm * 256 + wr * 64 + fr, col0 = u.pn * 256 + wc * 32 + 4 * fq;
#pragma unroll
        for (int ai = 0; ai < 2; ++ai)
#pragma unroll
            for (int m = 0; m < 4; ++m) { const int row = row0 + ai * 128 + m * 16; const int b = row / NT; float ss = 0.f;
#pragma unroll
                for (int bj = 0; bj < 2; ++bj)
#pragma unroll
                    for (int n = 0; n < 2; ++n) { const int col = col0 + bj * 128 + n * 16;
                        const f32x4 g4 = *(const f32x4*)(gate + (size_t)b * 6144 + col); const f32x4 x4 = *(const f32x4*)(xin + (size_t)row * DM + col);
                        const f32x4 o = x4 + g4 * acc[ai][bj][m][n]; *(f32x4*)(xout + (size_t)row * DM + col) = o; ss += (o[0] * o[0] + o[1] * o[1]) + (o[2] * o[2] + o[3] * o[3]); }
                ss += __shfl_xor(ss, 16); ss += __shfl_xor(ss, 32);
                if (fq == 0) SSP[(size_t)row * 16 + u.pn * 4 + wc] = ss; }
    }
};
struct EpiMoe1 : EpiBase {
    static constexpr bool PERM = true, GATHER = true;
    const float* bgu; bf16* ACT;
    const int* ROWTOK; const LAS int* tb; const LAS int* cnt;
    __device__ __forceinline__ int row_src(const Unit& u, int R) const { const int e = u.pn >> 3; const int r = (u.pm - tb[e]) * 256 + R; return r < cnt[e] ? ROWTOK[e * M + r] : M; }
    typedef float f32x2 __attribute__((ext_vector_type(2)));
    static __device__ __forceinline__ f32x2 act2(f32x2 g, f32x2 u) {
        f32x2 gg, uu; gg.x = fminf(g.x, 7.f); gg.y = fminf(g.y, 7.f); uu.x = __builtin_amdgcn_fmed3f(u.x, -7.f, 7.f); uu.y = __builtin_amdgcn_fmed3f(u.y, -7.f, 7.f);
        const f32x2 t = gg * (-1.702f * 1.4426950408889634f); f32x2 e; e.x = __builtin_amdgcn_exp2f(t.x); e.y = __builtin_amdgcn_exp2f(t.y);
        const f32x2 d = e + 1.0f; f32x2 r; r.x = __builtin_amdgcn_rcpf(d.x); r.y = __builtin_amdgcn_rcpf(d.y);
        return (uu + 1.0f) * (gg * r);
    }
    __device__ __forceinline__ void operator()(const f32x4 (&acc)[2][2][4][2], const Unit& u, int wr, int wc, int fr, int fq) const {
        const int e = u.pn >> 3, ct = u.pn & 7;
        const int row0 = u.pm * 256 + wr * 64 + fr, j0 = ct * 128 + wc * 32 + 8 * fq;
        const float* bg = bgu + (size_t)e * 2048 + j0;
        const f32x4 bg0 = *(const f32x4*)bg, bg1 = *(const f32x4*)(bg + 4), bu0 = *(const f32x4*)(bg + 1024), bu1 = *(const f32x4*)(bg + 1028);
#pragma unroll
        for (int ai = 0; ai < 2; ++ai)
#pragma unroll
            for (int m = 0; m < 4; ++m) { const int row = row0 + ai * 128 + m * 16;
                const f32x4 g0 = acc[ai][0][m][0] + bg0, g1 = acc[ai][0][m][1] + bg1, u0 = acc[ai][1][m][0] + bu0, u1 = acc[ai][1][m][1] + bu1;
                const f32x2 o0 = act2((f32x2){g0[0], g0[1]}, (f32x2){u0[0], u0[1]}), o1 = act2((f32x2){g0[2], g0[3]}, (f32x2){u0[2], u0[3]});
                const f32x2 o2 = act2((f32x2){g1[0], g1[1]}, (f32x2){u1[0], u1[1]}), o3 = act2((f32x2){g1[2], g1[3]}, (f32x2){u1[2], u1[3]});
                v4u w; w.x = cvt_pk_bf16(o0.x, o0.y); w.y = cvt_pk_bf16(o1.x, o1.y); w.z = cvt_pk_bf16(o2.x, o2.y); w.w = cvt_pk_bf16(o3.x, o3.y);
                *(v4u*)(ACT + (size_t)row * DFF + j0) = w; }
    }
};
struct EpiMoe2 : EpiBase {
    static constexpr bool PERM = true;
    const float* bd; bf16* YS;
    __device__ __forceinline__ void operator()(const f32x4 (&acc)[2][2][4][2], const Unit& u, int wr, int wc, int fr, int fq) const {
        const int e = u.pn >> 2, ct = u.pn & 3;
        const int row0 = u.pm * 256 + wr * 64 + fr, col0 = ct * 256 + wc * 32 + 8 * fq;
#pragma unroll
        for (int bj = 0; bj < 2; ++bj) { const float* bp = bd + (size_t)e * 1024 + col0 + bj * 128; const f32x4 b0 = *(const f32x4*)bp, b1 = *(const f32x4*)(bp + 4);
#pragma unroll
            for (int ai = 0; ai < 2; ++ai)
#pragma unroll
                for (int m = 0; m < 4; ++m) { const int row = row0 + ai * 128 + m * 16; const f32x4 v0 = acc[ai][bj][m][0] + b0, v1 = acc[ai][bj][m][1] + b1;
                    v4u w; w.x = cvt_pk_bf16(v0[0], v0[1]); w.y = cvt_pk_bf16(v0[2], v0[3]); w.z = cvt_pk_bf16(v1[0], v1[1]); w.w = cvt_pk_bf16(v1[2], v1[3]);
                    *(v4u*)(YS + (size_t)row * DM + col0 + bj * 128) = w; } }
    }
};

template <class Map>
__device__ __forceinline__ void transpose_item(const float* W, int K, int N, bf16* WT, LAS float* scr, int kb, int nb, int lane, Map map) {
    const int k0 = 64 * kb, n0 = 32 * nb;
    const int sc = map(n0 + (lane & 31));
    { float v[32]; const int scc = sc >= 0 ? sc : 0; const float msk = sc >= 0 ? 1.f : 0.f;
#pragma unroll
      for (int i = 0; i < 32; ++i) v[i] = W[(size_t)(k0 + 2 * i + (lane >> 5)) * N + scc];
#pragma unroll
      for (int i = 0; i < 32; ++i) scr[(2 * i + (lane >> 5)) * 33 + (lane & 31)] = v[i] * msk; }
    LDS_WAIT(); asm volatile("" ::: "memory");
    const int c = lane & 7;
#pragma unroll
    for (int j = 0; j < 4; ++j) { const int n = (lane >> 3) + 8 * j; const LAS float* s = scr + (8 * c) * 33 + n;
        v4u o; o.x = pk2(s[0 * 33], s[1 * 33]); o.y = pk2(s[2 * 33], s[3 * 33]); o.z = pk2(s[4 * 33], s[5 * 33]); o.w = pk2(s[6 * 33], s[7 * 33]);
        *(v4u*)(WT + (size_t)(n0 + n) * K + k0 + 8 * c) = o; }
    LDS_WAIT(); asm volatile("" ::: "memory");
}
struct MapWin { __device__ __forceinline__ int operator()(int d) const {
    if (d < 1408) return d; if (d < 1416) return 2944 + (d - 1408); if (d < 1536) return -1; if (d < 3072) return 1408 + (d - 1536); return 2952 + (d - 3072); } };
struct MapId { __device__ __forceinline__ int operator()(int d) const { return d; } };
struct MapGU { __device__ __forceinline__ int operator()(int d) const { const int ct = d >> 8, w = d & 255; return w < 128 ? ct * 128 + w : 1024 + ct * 128 + (w - 128); } };

__device__ __forceinline__ void p_convert(Frame& F) {
    LAS float* scr = (LAS float*)(F.lds + F.wave * 16384);
    constexpr int I_WIN = 16 * 192, I_SQ = 16 * 32, I_GU = 16 * 64;
    constexpr int N_WIN = NL * I_WIN, N_BR = NL * I_SQ, N_WO = NL * I_SQ, N_GU = NL * NE * I_GU, N_D = NL * NE * I_SQ;
    constexpr int NITEMS = N_WIN + N_BR + N_WO + N_GU + N_D;
    for (int it = F.gw; it < NITEMS; it += F.ngw) {
        int r = it;
        if (r < N_WIN) { const int l = r / I_WIN, q = r % I_WIN; transpose_item(F.in(4) + (size_t)l * DM * INW, DM, INW, (bf16*)(F.ws() + WS_WIN) + (size_t)l * ZW * DM, scr, q / 192, q % 192, F.lane, MapWin()); continue; } r -= N_WIN;
        if (r < N_BR) { const int l = r / I_SQ, q = r % I_SQ; transpose_item(F.in(22) + (size_t)l * DM * DM, DM, DM, (bf16*)(F.ws() + WS_WBR) + (size_t)l * DM * DM, scr, q / 32, q % 32, F.lane, MapId()); continue; } r -= N_BR;
        if (r < N_WO) { const int l = r / I_SQ, q = r % I_SQ; transpose_item(F.in(23) + (size_t)l * DM * DM, DM, DM, (bf16*)(F.ws() + WS_WO) + (size_t)l * DM * DM, scr, q / 32, q % 32, F.lane, MapId()); continue; } r -= N_WO;
        if (r < N_GU) { const int le = r / I_GU, q = r % I_GU; transpose_item(F.in(26) + (size_t)le * DM * 2048, DM, 2048, (bf16*)(F.ws() + WS_WGU) + (size_t)le * 2048 * DM, scr, q / 64, q % 64, F.lane, MapGU()); continue; } r -= N_GU;
        { const int le = r / I_SQ, q = r % I_SQ; transpose_item(F.in(28) + (size_t)le * DFF * DM, DFF, DM, (bf16*)(F.ws() + WS_WD) + (size_t)le * DM * DFF, scr, q / 32, q % 32, F.lane, MapId()); }
    }
}
__device__ __forceinline__ void p_mod(Frame& F) {
    LAS float* sc = (LAS float*)(F.lds);
    LAS float* part = (LAS float*)(F.lds + 16384);
    const float* c = F.in(1);
    for (int i = F.tid; i < NB * DM; i += NTHR) { const float v = c[i]; sc[i] = v * sigmoidf_(v); }
    __syncthreads();
    float* MOD = (float*)(F.ws() + WS_MOD);
    for (int un = F.bid; un < NL * 96; un += F.G) {
        const int l = un / 96, n0 = (un % 96) * 64, n = n0 + F.lane, kq = F.wave;
        const float* W = F.in(2) + (size_t)l * DM * 6144 + n;
        float a0 = 0.f, a1 = 0.f, a2 = 0.f, a3 = 0.f;
#pragma unroll 8
        for (int k = kq * 128; k < kq * 128 + 128; ++k) { const float w = W[(size_t)k * 6144]; a0 += w * sc[k]; a1 += w * sc[1024 + k]; a2 += w * sc[2048 + k]; a3 += w * sc[3072 + k]; }
        part[(kq * 4 + 0) * 64 + F.lane] = a0; part[(kq * 4 + 1) * 64 + F.lane] = a1; part[(kq * 4 + 2) * 64 + F.lane] = a2; part[(kq * 4 + 3) * 64 + F.lane] = a3;
        __syncthreads();
        if (F.tid < 256) { const int b = F.tid >> 6, cn = F.tid & 63; float s = 0.f;
#pragma unroll
            for (int q = 0; q < 8; ++q) s += part[(q * 4 + b) * 64 + cn];
            MOD[((size_t)l * NB + b) * 6144 + n0 + cn] = s + F.in(3)[(size_t)l * 6144 + n0 + cn]; }
        __syncthreads();
    }
}
__device__ __forceinline__ void norm_row_store(const f32x4 (&v)[4], float rs, const float* shift, const float* scale, bf16* orow, int lane) {
#pragma unroll
    for (int j = 0; j < 4; ++j) { const int c = 4 * lane + 256 * j; const f32x4 sh = *(const f32x4*)(shift + c), sc = *(const f32x4*)(scale + c);
        const f32x4 o = v[j] * rs * (sc + 1.f) + sh; v2u w; w.x = pk2(o[0], o[1]); w.y = pk2(o[2], o[3]); *(v2u*)(orow + c) = w; }
}
__device__ __forceinline__ void p_norm_rows(Frame& F, const float* x, const float* modl  , int shift_off, int scale_off) {
    bf16* XN = (bf16*)(F.ws() + WS_XN);
    if (F.gw == 0) { v4u z = {0u, 0u, 0u, 0u}; ((v4u*)(XN + (size_t)M * DM))[F.lane] = z; ((v4u*)(XN + (size_t)M * DM))[64 + F.lane] = z; }
    for (int row = F.gw; row < M; row += F.ngw) {
        const f32x4* xr = (const f32x4*)(x + (size_t)row * DM) + F.lane; f32x4 v[4]; float s = 0.f;
#pragma unroll
        for (int j = 0; j < 4; ++j) { v[j] = xr[64 * j]; s += (v[j][0] * v[j][0] + v[j][1] * v[j][1]) + (v[j][2] * v[j][2] + v[j][3] * v[j][3]); }
        const float rs = rsq_(wave_sum(s) * (1.f / DM) + 1e-6f);
        const float* mb = modl + (size_t)(row / NT) * 6144;
        norm_row_store(v, rs, mb + shift_off, mb + scale_off, XN + (size_t)row * DM, F.lane);
    }
}

__device__ __forceinline__ void ld4bf(const bf16* p, float (&o)[4]) { const v2u w = *(const v2u*)p; o[0] = bflo(w.x); o[1] = bfhi(w.x); o[2] = bflo(w.y); o[3] = bfhi(w.y); }
__device__ __forceinline__ void p_prep(Frame& F, int l, bool dummy, int g_begin, int g_step, int g_end) {
    bf16* Z = (bf16*)(F.ws() + WS_Z); const size_t zd = dummy ? (WS_XS - WS_Z) / 2 : 0;
    float* RWB = (float*)(F.ws() + WS_RW);
    const size_t TS = (size_t)M * 256;
    float *R_ = RWB, *KP_ = RWB + TS, *VV_ = RWB + 2 * TS, *AV_ = RWB + 3 * TS, *BV_ = RWB + 4 * TS, *WD_ = RWB + 5 * TS, *GG_ = RWB + 6 * TS;
    const float* FL = (const float*)(F.ws() + WS_FLOGIT); float* LOGF = (float*)(F.ws() + WS_LOGF);
    const float* vgain = F.in(5) + (size_t)l * 256;
    const float* mu = F.in(8) + (size_t)l * 896;
    const float* w0 = F.in(9) + (size_t)l * 256; const float* w2 = F.in(10) + (size_t)l * 32 * 256;
    const float* a0 = F.in(11) + (size_t)l * 256; const float* a2 = F.in(12) + (size_t)l * 32 * 256;
    const float* g2 = F.in(13) + (size_t)l * 64 * 256;
    const float* k_k = F.in(14) + (size_t)l * 256; const float* k_a = F.in(15) + (size_t)l * 256;
    const float* fbias = F.in(19) + (size_t)l * 8; const float* qgain = F.in(20) + (size_t)l * 64; const float* kgain = F.in(21) + (size_t)l * 64;
    LAS float* wl = (LAS float*)F.lds;
    LAS float* scr = (LAS float*)(F.lds + 131072 + F.wave * 2048);
    const int lane = F.lane, c4 = 4 * lane;
    __syncthreads();
    for (int idx = F.tid; idx < 128 * 64; idx += NTHR) { const int row = idx >> 6, q4 = idx & 63;
        const float* src = row < 32 ? w2 + row * 256 : row < 64 ? a2 + (row - 32) * 256 : g2 + (row - 64) * 256;
        *(LAS f32x4*)(wl + row * 256 + 4 * q4) = *(const f32x4*)(src + 4 * q4); }
    __syncthreads();
    for (int grp = g_begin; grp < g_end; grp += g_step) {
        float k4[4][4];
#pragma unroll
        for (int tk = 0; tk < 4; ++tk) {
            const int tok = 4 * grp + tk; float r4[4], v4[4];
            bf16* zr = Z + (size_t)tok * ZW; const bool hasprev = (tok % NT) != 0; const bf16* zp = hasprev ? zr - ZW : zr; const float pm = hasprev ? 1.f : 0.f;
            { float u[4]; ld4bf(zr + ZC_U + c4, u); v2u w; w.x = pk2(gelu_tanh(u[0]), gelu_tanh(u[1])); w.y = pk2(gelu_tanh(u[2]), gelu_tanh(u[3])); *(v2u*)(zr + zd + ZC_U + c4) = w;
              float v[4]; ld4bf(zr + ZC_V + c4, v); float ss = 0.f;
#pragma unroll
              for (int i = 0; i < 4; ++i) { v[i] = gelu_tanh(v[i]); ss += v[i] * v[i]; }
              const float rs = rsq_(wave_sum(ss) * (1.f / 256.f) + 1e-6f); const f32x4 gn = *(const f32x4*)(vgain + c4);
              w.x = pk2(v[0] * rs * gn[0], v[1] * rs * gn[1]); w.y = pk2(v[2] * rs * gn[2], v[3] * rs * gn[3]); *(v2u*)(zr + zd + ZC_V + c4) = w; }
            { float cur[4], prv[4]; f32x4 m4;
              ld4bf(zr + ZC_R + c4, cur); ld4bf(zp + ZC_R + c4, prv); m4 = *(const f32x4*)(mu + c4);
#pragma unroll
              for (int i = 0; i < 4; ++i) r4[i] = cur[i] + m4[i] * (pm * prv[i] - cur[i]);
              ld4bf(zr + ZC_R + 256 + c4, cur); ld4bf(zp + ZC_R + 256 + c4, prv); m4 = *(const f32x4*)(mu + 256 + c4);
#pragma unroll
              for (int i = 0; i < 4; ++i) k4[tk][i] = cur[i] + m4[i] * (pm * prv[i] - cur[i]);
              ld4bf(zr + ZC_R + 512 + c4, cur); ld4bf(zp + ZC_R + 512 + c4, prv); m4 = *(const f32x4*)(mu + 512 + c4);
#pragma unroll
              for (int i = 0; i < 4; ++i) v4[i] = cur[i] + m4[i] * (pm * prv[i] - cur[i]);
              *(f32x4*)(R_ + (size_t)tok * 256 + c4) = (f32x4){r4[0], r4[1], r4[2], r4[3]}; *(f32x4*)(VV_ + (size_t)tok * 256 + c4) = (f32x4){v4[0], v4[1], v4[2], v4[3]};
              if (lane < 32) { ld4bf(zr + ZC_LORA + c4, cur); ld4bf(zp + ZC_LORA + c4, prv); m4 = *(const f32x4*)(mu + 768 + c4);
                  f32x4 o4;
#pragma unroll
                  for (int i = 0; i < 4; ++i) { const float x = cur[i] + m4[i] * (pm * prv[i] - cur[i]);
                      const float r_ = rcp_(1.f + __expf(lane < 8 ? 2.f * x : -x));
                      o4[i] = lane < 8 ? 1.f - 2.f * r_ : (lane >= 16 ? r_ : x); }
                  *(LAS f32x4*)(scr + tk * 128 + c4) = o4; }
            }
#pragma unroll
            for (int qk = 0; qk < 2; ++qk) {
                bf16* p = zr + (qk == 0 ? ZC_Q : ZC_KF) + 8 * lane; const v4u w = *(const v4u*)p;
                float x[8] = {bflo(w.x), bfhi(w.x), bflo(w.y), bfhi(w.y), bflo(w.z), bfhi(w.z), bflo(w.w), bfhi(w.w)}; float ss = 0.f;
#pragma unroll
                for (int i = 0; i < 8; ++i) ss += x[i] * x[i];
                ss = dpp_add<0xB1>(ss); ss = dpp_add<0x4E>(ss); ss = dpp_add<0x141>(ss);
                const float rs = rsq_(ss * (1.f / 64.f) + 1e-6f) * (qk == 0 ? QSCALE : 1.f);
                const float* gp = (qk == 0 ? qgain : kgain) + 8 * (lane & 7); const f32x4 g0 = *(const f32x4*)gp, g1 = *(const f32x4*)(gp + 4);
                v4u o; o.x = pk2(x[0] * rs * g0[0], x[1] * rs * g0[1]); o.y = pk2(x[2] * rs * g0[2], x[3] * rs * g0[3]); o.z = pk2(x[4] * rs * g1[0], x[5] * rs * g1[1]); o.w = pk2(x[6] * rs * g1[2], x[7] * rs * g1[3]);
                *(v4u*)(p + zd) = o;
            }
            if (lane < 8) { const float f = FL[(size_t)tok * 8 + lane] + fbias[lane]; LOGF[(size_t)tok * 8 + lane] = (fminf(f, 0.f) - __logf(1.f + __expf(-fabsf(f)))) * LOG2E; }
            asm volatile("" ::: "memory");
        }
        LDS_WAIT(); asm volatile("" ::: "memory");
        f32x4 aw[4], aa[4], ag[4];
#pragma unroll
        for (int tk = 0; tk < 4; ++tk) { aw[tk] = (f32x4){0.f, 0.f, 0.f, 0.f}; aa[tk] = aw[tk]; ag[tk] = aw[tk]; }
        int c4m = c4; asm volatile("" : "+v"(c4m));
#pragma unroll 2
        for (int j = 0; j < 32; j += 4) {
            f32x4 wv[4], av_[4];
#pragma unroll
            for (int q = 0; q < 4; ++q) { wv[q] = *(const LAS f32x4*)(wl + (j + q) * 256 + c4m); av_[q] = *(const LAS f32x4*)(wl + (32 + j + q) * 256 + c4m); }
#pragma unroll
            for (int tk = 0; tk < 4; ++tk) { const f32x4 sw = *(const LAS f32x4*)(scr + tk * 128 + j), sa = *(const LAS f32x4*)(scr + tk * 128 + 32 + j);
#pragma unroll
                for (int q = 0; q < 4; ++q) { aw[tk] += sw[q] * wv[q]; aa[tk] += sa[q] * av_[q]; } } }
#pragma unroll 2
        for (int j = 0; j < 64; j += 4) {
            f32x4 gv[4];
#pragma unroll
            for (int q = 0; q < 4; ++q) gv[q] = *(const LAS f32x4*)(wl + (64 + j + q) * 256 + c4m);
#pragma unroll
            for (int tk = 0; tk < 4; ++tk) { const f32x4 sg = *(const LAS f32x4*)(scr + tk * 128 + 64 + j);
#pragma unroll
                for (int q = 0; q < 4; ++q) ag[tk] += sg[q] * gv[q]; } }
        asm volatile("" ::: "memory");
        const f32x4 w04 = *(const f32x4*)(w0 + c4m), a04 = *(const f32x4*)(a0 + c4m), kk4 = *(const f32x4*)(k_k + c4m), ka4 = *(const f32x4*)(k_a + c4m);
#pragma unroll
        for (int tk = 0; tk < 4; ++tk) {
            f32x4 dec, av, kkv, kp; float ss = 0.f;
#pragma unroll
            for (int i = 0; i < 4; ++i) { const float uu = w04[i] + aw[tk][i]; const float wlog = -softplusf_(-uu) - 0.5f; dec[i] = __expf(-__expf(wlog));
                av[i] = sigmoidf_(a04[i] + aa[tk][i]); kkv[i] = k4[tk][i] * kk4[i]; ss += kkv[i] * kkv[i]; kp[i] = k4[tk][i] * (1.f + (av[i] - 1.f) * ka4[i]); }
            ss = dpp_add<0xB1>(ss); ss = dpp_add<0x4E>(ss); ss = dpp_add<0x141>(ss); ss = dpp_add<0x140>(ss);
            const float inv = rsq_(fmaxf(ss, 1e-24f));
            f32x4 nkk, bv;
#pragma unroll
            for (int i = 0; i < 4; ++i) { const float q = kkv[i] * inv; nkk[i] = -q; bv[i] = q * av[i]; }
            const size_t o = (size_t)(4 * grp + tk) * 256 + c4m;
            *(f32x4*)(KP_ + o) = kp;
            *(f32x4*)(AV_ + o) = nkk; *(f32x4*)(BV_ + o) = bv; *(f32x4*)(WD_ + o) = dec; *(f32x4*)(GG_ + o) = ag[tk];
        }
        LDS_WAIT(); asm volatile("" ::: "memory");
    }
}

typedef float f32x2 __attribute__((ext_vector_type(2)));
__device__ __forceinline__ void p_rwkv_pass1(Frame& F, int un_begin, int un_step, int un_end) {
    const float* RWB = (const float*)(F.ws() + WS_RW); const size_t TS = (size_t)M * 256;
    float* Y0 = (float*)(F.ws() + WS_Y0); float* RT = (float*)(F.ws() + WS_RT);
    float* S0E = (float*)(F.ws() + WS_S0END); float* PE = (float*)(F.ws() + WS_PEND);
    LAS float* sh = (LAS float*)F.lds;
    constexpr int NBATCH = RWC / 4;
    const int sub = F.wave >> 2, h = F.wave & 3, i = F.lane, tid0 = F.tid;
    for (int un = un_begin; un < un_end; un += un_step) {
        const int tok0 = un * 2 * RWC;
        int ii = i; asm volatile("" : "+v"(ii));
        const int rg = ii >> 2, cs = ii & 3;
        float S[64], P[64];
#pragma unroll
        for (int j = 0; j < 64; ++j) { S[j] = 0.f; P[j] = (16 * ((j >> 2) & 3) + 4 * cs + (j & 3) == 4 * rg + (j >> 4)) ? 1.f : 0.f; }
#define RW1_SRC(r, batch) (RWB + (size_t)((((tid + 512 * (r)) >> 8) % 6)) * TS + (size_t)(tok0 + ((tid + 512 * (r)) / 1536) * RWC + (batch) * 4 + (((tid + 512 * (r)) >> 6) & 3)) * 256 + ((tid + 512 * (r)) & 63) * 4)
#define RW1_DMA(batch) do { int tid = tid0; asm volatile("" : "+v"(tid)); _Pragma("unroll") for (int r = 0; r < 6; ++r) __builtin_amdgcn_global_load_lds((const unsigned*)RW1_SRC(r, batch), (LAS unsigned*)(F.lds + ((batch) & 1) * 49152 + (F.wave * 64 + 512 * r) * 16), 16, 0, 0); } while (0)
#define FMAC(acc, a, b) asm("v_fmac_f32 %0, %1, %2" : "+v"(acc) : "v"(a), "v"(b))
#define FMA3(d, a, b, c) asm("v_fma_f32 %0, %1, %2, %3" : "=v"(d) : "v"(a), "v"(b), "v"(c))
#define MUL2(d, a, b) asm("v_mul_f32 %0, %1, %2" : "=v"(d) : "v"(a), "v"(b))
        __syncthreads();
        RW1_DMA(0);
        for (int batch = 0; batch < NBATCH; ++batch) {
            if (batch == 0) asm volatile("s_waitcnt vmcnt(0)" ::: "memory");
            else asm volatile("s_waitcnt vmcnt(8)" ::: "memory");
            __syncthreads();
            if (batch + 1 < NBATCH) RW1_DMA(batch + 1);
            const LAS float* cb = sh + (batch & 1) * 12288 + sub * (6 * 4 * 256) + h * 64;
#pragma unroll 1
            for (int st = 0; st < 4; ++st) {
                const LAS float* rr = cb + 0 * 1024 + st * 256; const LAS float* kk = cb + 1 * 1024 + st * 256; const LAS float* vv = cb + 2 * 1024 + st * 256;
                const LAS float* av = cb + 3 * 1024 + st * 256; const LAS float* bv = cb + 4 * 1024 + st * 256; const LAS float* wd = cb + 5 * 1024 + st * 256;
                const f32x4 v4 = *(const LAS f32x4*)(vv + 4 * rg);
                float aS[4] = {0.f, 0.f, 0.f, 0.f}, aP[4] = {0.f, 0.f, 0.f, 0.f};
#pragma unroll
                for (int q = 0; q < 4; ++q) { const f32x4 a4 = *(const LAS f32x4*)(av + 16 * q + 4 * cs);
#pragma unroll
                    for (int e = 0; e < 4; ++e) {
#pragma unroll
                        for (int ri = 0; ri < 4; ++ri) {
                            if (q == 3 && e == 3) { aS[ri] = __builtin_fmaf(S[ri * 16 + 15], a4[3], aS[ri]); aP[ri] = __builtin_fmaf(P[ri * 16 + 15], a4[3], aP[ri]); }
                            else { FMAC(aS[ri], S[ri * 16 + q * 4 + e], a4[e]); FMAC(aP[ri], P[ri * 16 + q * 4 + e], a4[e]); } } } }
                float saS[4], saP[4];
#pragma unroll
                for (int ri = 0; ri < 4; ++ri) { saS[ri] = quad_sum(aS[ri]); saP[ri] = quad_sum(aP[ri]); }
                float yS[4] = {0.f, 0.f, 0.f, 0.f}, yP[4] = {0.f, 0.f, 0.f, 0.f};
#pragma unroll
                for (int q = 0; q < 4; ++q) {
                    const f32x4 w4 = *(const LAS f32x4*)(wd + 16 * q + 4 * cs), b4 = *(const LAS f32x4*)(bv + 16 * q + 4 * cs), k4 = *(const LAS f32x4*)(kk + 16 * q + 4 * cs), r4 = *(const LAS f32x4*)(rr + 16 * q + 4 * cs);
#pragma unroll
                    for (int e = 0; e < 4; ++e) { float tS[4], tP[4];
#pragma unroll
                        for (int ri = 0; ri < 4; ++ri) { MUL2(tS[ri], saS[ri], b4[e]); MUL2(tP[ri], saP[ri], b4[e]); }
#pragma unroll
                        for (int ri = 0; ri < 4; ++ri) FMAC(tS[ri], v4[ri], k4[e]);
#pragma unroll
                        for (int ri = 0; ri < 4; ++ri) { FMA3(S[ri * 16 + q * 4 + e], S[ri * 16 + q * 4 + e], w4[e], tS[ri]); FMA3(P[ri * 16 + q * 4 + e], P[ri * 16 + q * 4 + e], w4[e], tP[ri]); }
#pragma unroll
                        for (int ri = 0; ri < 4; ++ri) {
                            if (q == 3 && e == 3) { yS[ri] = __builtin_fmaf(S[ri * 16 + 15], r4[3], yS[ri]); yP[ri] = __builtin_fmaf(P[ri * 16 + 15], r4[3], yP[ri]); }
                            else { FMAC(yS[ri], S[ri * 16 + q * 4 + e], r4[e]); FMAC(yP[ri], P[ri * 16 + q * 4 + e], r4[e]); } } } }
#pragma unroll
                for (int ri = 0; ri < 4; ++ri) { yS[ri] = quad_sum(yS[ri]); yP[ri] = quad_sum(yP[ri]); }
                const float yo = (cs == 0) ? yS[0] : (cs == 1) ? yS[1] : (cs == 2) ? yS[2] : yS[3], ro = (cs == 0) ? yP[0] : (cs == 1) ? yP[1] : (cs == 2) ? yP[2] : yP[3];
                int il = i; asm volatile("" : "+v"(il));
                const unsigned o = (unsigned)(tok0 + sub * RWC + batch * 4 + st) * 256u + h * 64 + il;
                Y0[o] = yo; RT[o] = ro;
            }
        }
#undef FMAC
#undef FMA3
#undef MUL2
#undef RW1_SRC
#undef RW1_DMA
        const size_t sb = ((size_t)(un * 2 + sub) * 4 + h) * 4096;
        { int i2 = i; asm volatile("" : "+v"(i2)); const int rg = i2 >> 2, cs = i2 & 3;
#pragma unroll
        for (int ri = 0; ri < 4; ++ri) {
#pragma unroll
            for (int q = 0; q < 4; ++q) *(f32x4*)(S0E + sb + (size_t)(4 * rg + ri) * 64 + 16 * q + 4 * cs) = (f32x4){S[ri * 16 + q * 4], S[ri * 16 + q * 4 + 1], S[ri * 16 + q * 4 + 2], S[ri * 16 + q * 4 + 3]}; }
        { bf16* pt = (bf16*)((unsigned char*)PE + ((size_t)(un * 2 + sub) * 4 + h) * PIMG_BYTES) + 4 * rg;
#pragma unroll
          for (int jj = 0; jj < 16; ++jj) { const int j = 16 * (jj >> 2) + 4 * cs + (jj & 3); v2u vh, vl;
              vh.x = pk2(P[jj], P[16 + jj]); vh.y = pk2(P[32 + jj], P[48 + jj]);
              vl.x = pk2(P[jj] - bflo(vh.x), P[16 + jj] - bfhi(vh.x)); vl.y = pk2(P[32 + jj] - bflo(vh.y), P[48 + jj] - bfhi(vh.y));
              *(v2u*)(pt + j * 64) = vh; *(v2u*)(pt + 64 * 64 + j * 64) = vl; } } }
    }
}
__device__ __forceinline__ void p_rwkv_pass2(Frame& F, int first_block, int l) {
    typedef float f32x16 __attribute__((ext_vector_type(16)));
    typedef short bf16x8_t __attribute__((ext_vector_type(8)));
    const float* S0E = (const float*)(F.ws() + WS_S0END); const float* PE = (const float*)(F.ws() + WS_PEND); bf16* SST = (bf16*)(F.ws() + WS_SST);
    constexpr int LP = 72;
    constexpr int IMG = 64 * LP;
    constexpr int LF = 68, IMGF = 64 * LF;
    LAS bf16* SH = (LAS bf16*)F.lds;
    LAS bf16* PT = SH + 4 * IMG;
    LAS float* S0I = (LAS float*)(PT + 4 * IMG);
    const int bh = F.bid - first_block; if (bh < 0 || bh >= NB * NHR) return;
    const int b = bh / NHR, h = bh % NHR, tid = F.tid, lane = F.lane, w = F.wave;
    const int l31 = lane & 31, hi = lane >> 5, tJ = (w >> 1) & 1, tI = w & 1;
    const size_t cbase = ((size_t)(b * NCH) * 4 + h) * 4096;
    const unsigned char* pimg = (const unsigned char*)PE + ((size_t)(b * NCH) * 4 + h) * PIMG_BYTES;
    for (int idx = tid; idx < 2 * IMG; idx += NTHR) SH[idx] = 0;
    for (int ci = tid; ci < PIMG_BYTES / 16; ci += NTHR) *(LAS v4u*)((LAS unsigned char*)PT + (ci >> 3) * 144 + (ci & 7) * 16) = *(const v4u*)(pimg + (size_t)ci * 16);
    for (int idx = tid; idx < 1024; idx += NTHR) *(LAS f32x4*)(S0I + (idx >> 4) * LF + 4 * (idx & 15)) = *(const f32x4*)(S0E + cbase + (size_t)idx * 4);
    __syncthreads();
    (void)l;
    if (w < 4) {
        const LAS bf16* ap0 = PT + (32 * tJ + l31) * LP + 8 * hi; const LAS bf16* bp0 = SH + (32 * tI + l31) * LP + 8 * hi;
        const LAS float* cp0 = S0I + (32 * tI + l31) * LF + 32 * tJ + 4 * hi;
        LAS bf16* sw0 = SH + (32 * tI + l31) * LP + 32 * tJ + 4 * hi;
        for (int c = 0; c < NCH; ++c) {
            const int cb = c & 1;
            f32x16 acc;
#pragma unroll
            for (int g = 0; g < 4; ++g) { const f32x4 t = *(const LAS f32x4*)(cp0 + cb * IMGF + 8 * g); acc[4 * g] = t[0]; acc[4 * g + 1] = t[1]; acc[4 * g + 2] = t[2]; acc[4 * g + 3] = t[3]; }
            const LAS bf16* ap = ap0 + cb * 2 * IMG; const LAS bf16* bp = bp0 + cb * 2 * IMG; bf16x8_t ah[4], al[4], bhh[4], bll[4];
#pragma unroll
            for (int s = 0; s < 4; ++s) { ah[s] = *(const LAS bf16x8_t*)(ap + 16 * s); al[s] = *(const LAS bf16x8_t*)(ap + IMG + 16 * s); bhh[s] = *(const LAS bf16x8_t*)(bp + 16 * s); bll[s] = *(const LAS bf16x8_t*)(bp + IMG + 16 * s); }
#pragma unroll
            for (int s = 0; s < 4; ++s) { acc = __builtin_amdgcn_mfma_f32_32x32x16_bf16(ah[s], bhh[s], acc, 0, 0, 0); acc = __builtin_amdgcn_mfma_f32_32x32x16_bf16(ah[s], bll[s], acc, 0, 0, 0); acc = __builtin_amdgcn_mfma_f32_32x32x16_bf16(al[s], bhh[s], acc, 0, 0, 0); }
            LAS bf16* sw = sw0 + (cb ^ 1) * 2 * IMG;
#pragma unroll
            for (int g = 0; g < 4; ++g) { v2u vh, vl; vh.x = cvtpk_c(acc[4 * g], acc[4 * g + 1]); vh.y = cvtpk_c(acc[4 * g + 2], acc[4 * g + 3]);
                vl.x = cvtpk_c(acc[4 * g] - bflo(vh.x), acc[4 * g + 1] - bfhi(vh.x)); vl.y = cvtpk_c(acc[4 * g + 2] - bflo(vh.y), acc[4 * g + 3] - bfhi(vh.y));
                *(LAS v2u*)(sw + 8 * g) = vh; *(LAS v2u*)(sw + IMG + 8 * g) = vl; }
            asm volatile("s_waitcnt lgkmcnt(0)\n\ts_barrier" ::: "memory");
        }
    } else if (w < 6) {
        const int q = tid - 256;
        v4u pA[8], pB[8]; f32x4 sA[8], sB[8];
#define P2_LD(pv, sv, cc) do { const int cc_ = (cc) < NCH ? (cc) : NCH - 1; \
        _Pragma("unroll") for (int r = 0; r < 8; ++r) pv[r] = *(const v4u*)(pimg + (size_t)cc_ * 4 * PIMG_BYTES + (size_t)(q + 128 * r) * 16); \
        _Pragma("unroll") for (int r = 0; r < 8; ++r) sv[r] = *(const f32x4*)(S0E + cbase + (size_t)cc_ * 16384 + (size_t)(q + 128 * r) * 4); } while (0)
#define P2_ST(pv, sv, c_) do { if ((c_) + 1 < NCH) { const int nb_ = ((c_) & 1) ^ 1; LAS unsigned char* pn = (LAS unsigned char*)(PT + nb_ * 2 * IMG); LAS float* sn_ = S0I + nb_ * IMGF; \
            _Pragma("unroll") for (int r = 0; r < 8; ++r) { const int ci_ = q + 128 * r; *(LAS v4u*)(pn + (ci_ >> 3) * 144 + (ci_ & 7) * 16) = pv[r]; } \
            _Pragma("unroll") for (int r = 0; r < 8; ++r) { const int idx_ = q + 128 * r; *(LAS f32x4*)(sn_ + (idx_ >> 4) * LF + 4 * (idx_ & 15)) = sv[r]; } } \
        P2_LD(pv, sv, (c_) + 3); \
        asm volatile("s_waitcnt lgkmcnt(0)\n\ts_barrier" ::: "memory"); } while (0)
        P2_LD(pA, sA, 1); P2_LD(pB, sB, 2);
        for (int c = 0; c < NCH; c += 2) { P2_ST(pA, sA, c); P2_ST(pB, sB, c + 1); }
#undef P2_LD
#undef P2_ST
    } else {
        const int q = tid - 384;
        for (int c = 0; c < NCH; ++c) {
            const LAS bf16* sc = SH + (c & 1) * 2 * IMG;
#pragma unroll
            for (int r = 0; r < 4; ++r) { const int it_ = q + 128 * r, i_ = it_ >> 3, j8 = it_ & 7;
                *(v4u*)(SST + cbase + (size_t)c * 16384 + (size_t)i_ * 64 + 8 * j8) = *(const LAS v4u*)(sc + i_ * LP + 8 * j8); }
            asm volatile("s_waitcnt lgkmcnt(0)\n\ts_barrier" ::: "memory");
        }
    }
    __syncthreads();
}
__device__ __forceinline__ void p_rwkv_pass3(Frame& F, int l) {
    const float* RWB = (const float*)(F.ws() + WS_RW); const size_t TS = (size_t)M * 256;
    const float *R_ = RWB, *KP_ = RWB + TS, *VV_ = RWB + 2 * TS, *GG_ = RWB + 6 * TS;
    const float* Y0 = (const float*)(F.ws() + WS_Y0); const float* RT = (const float*)(F.ws() + WS_RT); const bf16* SST = (const bf16*)(F.ws() + WS_SST);
    bf16* YMIX = (bf16*)(F.ws() + WS_YMIX);
    const float* r_k = F.in(16) + (size_t)l * 256; const float* gng = F.in(17) + (size_t)l * 256; const float* gnb = F.in(18) + (size_t)l * 256;
    const int h = F.wave >> 1, half = F.wave & 1, i = F.lane, ch = h * 64 + i;
    const float rk = r_k[ch], gg = gng[ch], gb = gnb[ch];
    LAS float* rts = (LAS float*)F.lds;
    for (int un = F.bid; un < NB * NCH; un += F.G) {
        __syncthreads();
#pragma unroll
        for (int r = 0; r < RWC * 64 / NTHR; ++r) { const int idx = F.tid + NTHR * r; *(LAS f32x4*)(rts + idx * 4) = *(const f32x4*)(RT + (size_t)un * RWC * 256 + (size_t)idx * 4); }
        const bf16* srow = SST + ((size_t)un * 4 + h) * 4096 + (size_t)i * 64;
        float s[64];
#pragma unroll
        for (int j = 0; j < 64; j += 8) { const v4u t = *(const v4u*)(srow + j); s[j] = bflo(t.x); s[j + 1] = bfhi(t.x); s[j + 2] = bflo(t.y); s[j + 3] = bfhi(t.y); s[j + 4] = bflo(t.z); s[j + 5] = bfhi(t.z); s[j + 6] = bflo(t.w); s[j + 7] = bfhi(t.w); }
        __syncthreads();
#pragma unroll 1
        for (int t4 = 0; t4 < RWC / 2; t4 += 4) {
            float y0v[4], rv[4], kv[4], vv[4], gt[4];
#pragma unroll
            for (int q = 0; q < 4; ++q) { const size_t o = (size_t)(un * RWC + half * (RWC / 2) + t4 + q) * 256 + ch; y0v[q] = Y0[o]; rv[q] = R_[o]; kv[q] = KP_[o]; vv[q] = VV_[o]; gt[q] = GG_[o]; }
#pragma unroll
            for (int q = 0; q < 4; ++q) {
                const int tl = half * (RWC / 2) + t4 + q; const LAS float* rt = rts + tl * 256 + h * 64;
                float y0 = y0v[q], y1 = 0.f;
#pragma unroll
                for (int j = 0; j < 64; j += 4) { const f32x4 t = *(const LAS f32x4*)(rt + j); y0 += s[j] * t[0] + s[j + 2] * t[2]; y1 += s[j + 1] * t[1] + s[j + 3] * t[3]; }
                const float y = y0 + y1;
                const float mu = wave_sum(y) * (1.f / 64.f); const float d = y - mu; const float var = wave_sum(d * d) * (1.f / 64.f);
                const float yn = d * rsq_(var + 64e-5f) * gg + gb;
                const float dot = wave_sum(rv[q] * kv[q] * rk);
                const float out = (yn + dot * vv[q]) * gt[q];
                YMIX[(size_t)(un * RWC + tl) * DM + 256 + ch] = (bf16)f2bf(out);
            }
        }
    }
    __syncthreads();
}

__device__ __forceinline__ void p_gmlp_unit_valu(Frame& F, int l, int un) {
    const bf16* Z = (const bf16*)(F.ws() + WS_Z); bf16* YMIX = (bf16*)(F.ws() + WS_YMIX);
    const float* Ws = F.in(6) + (size_t)l * 4 * 128 * 128; const float* bs = F.in(7) + (size_t)l * 4 * 128;
    LAS float* WT = (LAS float*)F.lds;
    LAS bf16* Vs = (LAS bf16*)(F.lds + 65536);
    const int t = F.tid & 127, cq = F.tid >> 7;
    const int tok0 = un * 128;
    for (int g = 0; g < 4; ++g) {
        __syncthreads();
        for (int idx = F.tid; idx < 128 * 128; idx += NTHR) { const int tt = idx >> 7, ss = idx & 127; WT[ss * 128 + tt] = Ws[(size_t)g * 16384 + idx]; }
        for (int idx = F.tid; idx < 128 * 8; idx += NTHR) { const int ss = idx >> 3, c8 = idx & 7; *(LAS v4u*)(Vs + ss * 64 + c8 * 8) = *(const v4u*)(Z + (size_t)(tok0 + ss) * ZW + ZC_V + g * 64 + c8 * 8); }
        __syncthreads();
        float acc[16];
#pragma unroll
        for (int q = 0; q < 16; ++q) acc[q] = 0.f;
        const int smax = (t | 63);
        for (int s = 0; s <= smax; ++s) {
            const float w = (s <= t) ? WT[s * 128 + t] : 0.f;
            const v4u a = *(const LAS v4u*)(Vs + s * 64 + cq * 16), b = *(const LAS v4u*)(Vs + s * 64 + cq * 16 + 8);
            acc[0] += w * bflo(a.x); acc[1] += w * bfhi(a.x); acc[2] += w * bflo(a.y); acc[3] += w * bfhi(a.y); acc[4] += w * bflo(a.z); acc[5] += w * bfhi(a.z); acc[6] += w * bflo(a.w); acc[7] += w * bfhi(a.w);
            acc[8] += w * bflo(b.x); acc[9] += w * bfhi(b.x); acc[10] += w * bflo(b.y); acc[11] += w * bfhi(b.y); acc[12] += w * bflo(b.z); acc[13] += w * bfhi(b.z); acc[14] += w * bflo(b.w); acc[15] += w * bfhi(b.w);
        }
        const float bb = bs[g * 128 + t];
        const bf16* up = Z + (size_t)(tok0 + t) * ZW + ZC_U + g * 64 + cq * 16; const v4u u0 = *(const v4u*)up, u1 = *(const v4u*)(up + 8);
        v4u o0, o1;
        o0.x = pk2(bflo(u0.x) * (acc[0] + bb), bfhi(u0.x) * (acc[1] + bb)); o0.y = pk2(bflo(u0.y) * (acc[2] + bb), bfhi(u0.y) * (acc[3] + bb));
        o0.z = pk2(bflo(u0.z) * (acc[4] + bb), bfhi(u0.z) * (acc[5] + bb)); o0.w = pk2(bflo(u0.w) * (acc[6] + bb), bfhi(u0.w) * (acc[7] + bb));
        o1.x = pk2(bflo(u1.x) * (acc[8] + bb), bfhi(u1.x) * (acc[9] + bb)); o1.y = pk2(bflo(u1.y) * (acc[10] + bb), bfhi(u1.y) * (acc[11] + bb));
        o1.z = pk2(bflo(u1.z) * (acc[12] + bb), bfhi(u1.z) * (acc[13] + bb)); o1.w = pk2(bflo(u1.w) * (acc[14] + bb), bfhi(u1.w) * (acc[15] + bb));
        bf16* op = YMIX + (size_t)(tok0 + t) * DM + g * 64 + cq * 16; *(v4u*)op = o0; *(v4u*)(op + 8) = o1;
    }
    __syncthreads();
}

__device__ __forceinline__ void p_gmlp_unit(Frame& F, int l, int un) {
    typedef float f32x16 __attribute__((ext_vector_type(16)));
    typedef short bf16x8_t __attribute__((ext_vector_type(8)));
    const bf16* Z = (const bf16*)(F.ws() + WS_Z); bf16* YMIX = (bf16*)(F.ws() + WS_YMIX);
    const float* Ws = F.in(6) + (size_t)l * 4 * 128 * 128; const float* bs = F.in(7) + (size_t)l * 4 * 128;
    constexpr int LV = 136;
    LAS bf16* Vt = (LAS bf16*)F.lds;
    const int tid = F.tid, lane = F.lane, w = F.wave, l31 = lane & 31, hi = lane >> 5, mt = w >> 1, nt = w & 1;
    const int tok0 = un * 128;
    __syncthreads();
#pragma unroll
    for (int it = 0; it < 8; ++it) { const int s = (tid & 63) + 64 * (it & 1), c8 = (tid >> 6) + 8 * (it >> 1);
        const v4u v = *(const v4u*)(Z + (size_t)(tok0 + s) * ZW + ZC_V + c8 * 8); LAS bf16* d = Vt + (c8 * 8) * LV + s;
        d[0] = (bf16)(v.x & 0xffffu); d[LV] = (bf16)(v.x >> 16); d[2 * LV] = (bf16)(v.y & 0xffffu); d[3 * LV] = (bf16)(v.y >> 16);
        d[4 * LV] = (bf16)(v.z & 0xffffu); d[5 * LV] = (bf16)(v.z >> 16); d[6 * LV] = (bf16)(v.w & 0xffffu); d[7 * LV] = (bf16)(v.w >> 16); }
    __syncthreads();
    const int trow = 32 * mt + l31;
#pragma unroll 1
    for (int g = 0; g < 4; ++g) {
        f32x16 acc;
#pragma unroll
        for (int r = 0; r < 16; ++r) acc[r] = 0.f;
        const float* wrow = Ws + (size_t)g * 16384 + (size_t)trow * 128 + 8 * hi;
        const LAS bf16* bp = Vt + (g * 64 + 32 * nt + l31) * LV + 8 * hi;
        const int nks = 2 * (mt + 1);
#pragma unroll 2
        for (int ks = 0; ks < nks; ++ks) {
            const f32x4 a0 = *(const f32x4*)(wrow + 16 * ks), a1 = *(const f32x4*)(wrow + 16 * ks + 4);
            const int s0 = 16 * ks + 8 * hi;
            v4u ap; ap.x = pk2(s0 + 0 <= trow ? a0[0] : 0.f, s0 + 1 <= trow ? a0[1] : 0.f); ap.y = pk2(s0 + 2 <= trow ? a0[2] : 0.f, s0 + 3 <= trow ? a0[3] : 0.f);
            ap.z = pk2(s0 + 4 <= trow ? a1[0] : 0.f, s0 + 5 <= trow ? a1[1] : 0.f); ap.w = pk2(s0 + 6 <= trow ? a1[2] : 0.f, s0 + 7 <= trow ? a1[3] : 0.f);
            const bf16x8_t bfr = *(const LAS bf16x8_t*)(bp + 16 * ks);
            acc = __builtin_amdgcn_mfma_f32_32x32x16_bf16(__builtin_bit_cast(bf16x8_t, ap), bfr, acc, 0, 0, 0);
        }
        const int c = g * 64 + 32 * nt + l31;
#pragma unroll
        for (int r = 0; r < 16; ++r) { const int t = 32 * mt + (r & 3) + 8 * (r >> 2) + 4 * hi; const size_t tok = (size_t)(tok0 + t);
            const float u = bf2f(Z[tok * ZW + ZC_U + c]); YMIX[tok * DM + c] = (bf16)f2bf(u * (acc[r] + bs[g * 128 + t])); }
    }
    __syncthreads();
}

__device__ __forceinline__ void p_attn_unit_naive(Frame& F, int bh, int qb) {
    const bf16* Z = (const bf16*)(F.ws() + WS_Z); const float* LOGF = (const float*)(F.ws() + WS_LOGF); bf16* YMIX = (bf16*)(F.ws() + WS_YMIX);
    LAS float* Ks = (LAS float*)F.lds;
    LAS float* Vs = (LAS float*)(F.lds + 16384);
    LAS float* CUM = (LAS float*)(F.lds + 32768);
    LAS float* WT = (LAS float*)(F.lds + 49152);
    const int b = bh / NHF, h = bh % NHF, q0 = qb * 256, tid = F.tid, r = tid >> 1, dh = (tid & 1) * 32;
    const int nkeys = q0 + 256;
    const size_t tokb = (size_t)b * NT;
    __syncthreads();
    { float v[8]; float run = 0.f;
#pragma unroll
      for (int e = 0; e < 8; ++e) { const int t = tid * 8 + e; v[e] = t < nkeys ? LOGF[(tokb + t) * 8 + h] : 0.f; run += v[e]; v[e] = run; }
      float inc = run;
#pragma unroll
      for (int o = 1; o < 64; o <<= 1) { const float n = __shfl_up(inc, o); if (F.lane >= o) inc += n; }
      if (F.lane == 63) WT[F.wave] = inc;
      __syncthreads();
      float off = inc - run;
      for (int w = 0; w < F.wave; ++w) off += WT[w];
#pragma unroll
      for (int e = 0; e < 8; ++e) { const int t = tid * 8 + e; if (t < nkeys) CUM[t] = off + v[e]; }
    }
    __syncthreads();
    const int tq = q0 + r;
    float qv[32];
    { const bf16* qp = Z + (tokb + tq) * ZW + ZC_Q + h * 64 + dh;
#pragma unroll
      for (int d = 0; d < 32; d += 8) { const v4u w = *(const v4u*)(qp + d); qv[d] = bflo(w.x); qv[d + 1] = bfhi(w.x); qv[d + 2] = bflo(w.y); qv[d + 3] = bfhi(w.y); qv[d + 4] = bflo(w.z); qv[d + 5] = bfhi(w.z); qv[d + 6] = bflo(w.w); qv[d + 7] = bfhi(w.w); } }
    const float cq = CUM[tq];
    float mrun = -INFINITY, lrun = 0.f; float o[32];
#pragma unroll
    for (int d = 0; d < 32; ++d) o[d] = 0.f;
    for (int kt = 0; kt < nkeys / 64; ++kt) {
        __syncthreads();
        { const int kr = tid >> 3, c8 = (tid & 7) * 8; const bf16* kp = Z + (tokb + kt * 64 + kr) * ZW + h * 64 + c8;
          const v4u kw = *(const v4u*)(kp + ZC_KF), vw = *(const v4u*)(kp + ZC_VF);
          *(LAS f32x4*)(Ks + kr * 64 + c8) = (f32x4){bflo(kw.x), bfhi(kw.x), bflo(kw.y), bfhi(kw.y)}; *(LAS f32x4*)(Ks + kr * 64 + c8 + 4) = (f32x4){bflo(kw.z), bfhi(kw.z), bflo(kw.w), bfhi(kw.w)};
          *(LAS f32x4*)(Vs + kr * 64 + c8) = (f32x4){bflo(vw.x), bfhi(vw.x), bflo(vw.y), bfhi(vw.y)}; *(LAS f32x4*)(Vs + kr * 64 + c8 + 4) = (f32x4){bflo(vw.z), bfhi(vw.z), bflo(vw.w), bfhi(vw.w)}; }
        __syncthreads();
        const int klim = min(64, q0 + 256 - kt * 64);
#pragma unroll 1
        for (int kl = 0; kl < klim; ++kl) {
            const LAS float* kr = Ks + kl * 64 + dh; float a0 = 0.f, a1 = 0.f;
#pragma unroll
            for (int d = 0; d < 32; d += 4) { const f32x4 k4 = *(const LAS f32x4*)(kr + d); a0 += qv[d] * k4[0] + qv[d + 2] * k4[2]; a1 += qv[d + 1] * k4[1] + qv[d + 3] * k4[3]; }
            float part = a0 + a1; part = dpp_add<0xB1>(part);
            const int key = kt * 64 + kl; float sv = part + cq - CUM[key];
            if (key <= tq) {
                if (sv > mrun) { const float scale = exp2f(mrun - sv); lrun *= scale;
#pragma unroll
                    for (int d = 0; d < 32; ++d) o[d] *= scale;
                    mrun = sv; }
                const float p = exp2f(sv - mrun); lrun += p; const LAS float* vr = Vs + kl * 64 + dh;
#pragma unroll
                for (int d = 0; d < 32; d += 4) { const f32x4 v4 = *(const LAS f32x4*)(vr + d); o[d] += p * v4[0]; o[d + 1] += p * v4[1]; o[d + 2] += p * v4[2]; o[d + 3] += p * v4[3]; }
            }
        }
    }
    { const float inv = 1.f / lrun; bf16* op = YMIX + (tokb + tq) * DM + 512 + h * 64 + dh;
#pragma unroll
      for (int d = 0; d < 32; d += 8) { v4u w; w.x = pk2(o[d] * inv, o[d + 1] * inv); w.y = pk2(o[d + 2] * inv, o[d + 3] * inv); w.z = pk2(o[d + 4] * inv, o[d + 5] * inv); w.w = pk2(o[d + 6] * inv, o[d + 7] * inv); *(v4u*)(op + d) = w; } }
    __syncthreads();
}

#ifndef ATTN_NAIVE
#define ATTN_NAIVE 0
#endif
__device__ __forceinline__ void p_attn_unit(Frame& F, int l, int bh, int qb) {
#if ATTN_NAIVE
    p_attn_unit_naive(F, bh, qb);
#else
    const fox::bf16* Zb = (const fox::bf16*)(F.ws() + WS_Z);
    float gq = fabsf(F.in(20)[(size_t)l * 64 + F.lane]), gk = fabsf(F.in(21)[(size_t)l * 64 + F.lane]);
#pragma unroll
    for (int o = 1; o < 64; o <<= 1) { gq = fmaxf(gq, __shfl_xor(gq, o)); gk = fmaxf(gk, __shfl_xor(gk, o)); }
    const float skip_thr = 44.f + 2.f * (64.f * gq * gk * QSCALE * 1.02f);
    fox::attn_unit<20>(bh / NHF, bh % NHF, qb, Zb + ZC_Q, Zb + ZC_KF, Zb + ZC_VF, (fox::bf16*)(F.ws() + WS_YMIX) + 512, (const float*)(F.ws() + WS_LOGF), (char*)F.lds, F.tid, skip_thr);
#endif
}

__device__ __forceinline__ void p_route(Frame& F, int l, int lcur) {
    typedef short bf16x8_t __attribute__((ext_vector_type(8)));
    const float* x = F.out(); const float* modl = (const float*)(F.ws() + WS_MOD) + (size_t)l * NB * 6144;
    bf16* XN = (bf16*)(F.ws() + WS_XN);
    const bf16* wth = (const bf16*)(F.ws() + WS_WRT) + (size_t)l * 2 * NE * DM; const bf16* wtl = wth + NE * DM;
    const float* br = F.in(25) + (size_t)l * NE;
    unsigned* cur = (unsigned*)(F.ws() + WS_CTL) + CW_CUR + lcur * NE * 64;
    int* ROWTOK = (int*)(F.ws() + (lcur == l ? WS_ROWTOK : WS_XS)); int* TOKPOS = (int*)(F.ws() + WS_TOKPOS); float* TOKW = (float*)(F.ws() + WS_TOKW);
    constexpr int WP = 1032;
    LAS bf16* wlds = (LAS bf16*)F.lds;
    LAS float* lg = (LAS float*)(F.lds + 2 * NE * WP * 2 + F.wave * 1152);
    const int lane = F.lane, t = lane & 15, quad = lane >> 4;
    LAS unsigned* lcnt = (LAS unsigned*)(F.lds + 2 * NE * WP * 2 + 8 * 1152);
    static_assert(M / 16 <= 4 * 256, "one token group per wave pair at most");
    __syncthreads();
    if (F.tid < 64) lcnt[F.tid] = 0u;
    { v4u wv[16];
#pragma unroll
      for (int r = 0; r < 16; ++r) { const int ch = F.tid + NTHR * r; wv[r] = *(const v4u*)(wth + (size_t)(ch >> 7) * DM + (ch & 127) * 8); }
#pragma unroll
      for (int r = 0; r < 16; ++r) { const int ch = F.tid + NTHR * r; *(LAS v4u*)(wlds + (ch >> 7) * WP + (ch & 127) * 8) = wv[r]; } }
    __syncthreads();
    const int wq = F.wave & 3, kh = F.wave >> 2;
    const int grp = wq * F.G + F.bid;
    LAS float* part = (LAS float*)(F.lds + 2 * NE * WP * 2 + 8 * 1152 + 256) + wq * 512;
    float tv[4] = {0.f, 0.f, 0.f, 0.f}; int ti[4] = {0, 0, 0, 0};
    f32x4 acc0 = {0.f, 0.f, 0.f, 0.f}, acc1 = acc0;
    if (grp < M / 16) {
        const int row = grp * 16 + t; const float* xr = x + (size_t)row * DM + 8 * quad;
        const float* mb = modl + (size_t)(row / NT) * 6144 + 8 * quad;
        float ss;
        { const f32x4* sp = (const f32x4*)((const float*)(F.ws() + WS_SSP) + (size_t)row * 16); const f32x4 p0 = sp[0], p1 = sp[1], p2 = sp[2], p3 = sp[3];
          ss = (((p0[0] + p0[1]) + (p0[2] + p0[3])) + ((p1[0] + p1[1]) + (p1[2] + p1[3]))) + (((p2[0] + p2[1]) + (p2[2] + p2[3])) + ((p3[0] + p3[1]) + (p3[2] + p3[3]))); }
        const float rs = rsq_(ss * (1.f / DM) + 1e-6f);
        const LAS bf16* wh0 = wlds + t * WP + 8 * quad; const LAS bf16* wl0 = wlds + (NE + t) * WP + 8 * quad;
#pragma unroll 4
        for (int ks = 16 * kh; ks < 16 * kh + 16; ++ks) {
            const f32x4 a = *(const f32x4*)(xr + 32 * ks), b = *(const f32x4*)(xr + 32 * ks + 4);
            const f32x4 sh0 = *(const f32x4*)(mb + 3072 + 32 * ks), sh1 = *(const f32x4*)(mb + 3072 + 32 * ks + 4), sc0 = *(const f32x4*)(mb + 4096 + 32 * ks), sc1 = *(const f32x4*)(mb + 4096 + 32 * ks + 4);
            const f32x4 h0 = a * rs * (sc0 + 1.f) + sh0, h1 = b * rs * (sc1 + 1.f) + sh1;
            v4u hi, lo;
            hi.x = pk2(h0[0], h0[1]); hi.y = pk2(h0[2], h0[3]); hi.z = pk2(h1[0], h1[1]); hi.w = pk2(h1[2], h1[3]);
            lo.x = pk2(h0[0] - bflo(hi.x), h0[1] - bfhi(hi.x)); lo.y = pk2(h0[2] - bflo(hi.y), h0[3] - bfhi(hi.y)); lo.z = pk2(h1[0] - bflo(hi.z), h1[1] - bfhi(hi.z)); lo.w = pk2(h1[2] - bflo(hi.w), h1[3] - bfhi(hi.w));
            *(v4u*)(XN + (size_t)row * DM + 32 * ks + 8 * quad) = hi;
            const bf16x8_t ah = __builtin_bit_cast(bf16x8_t, hi), al = __builtin_bit_cast(bf16x8_t, lo);
            const bf16x8_t bh0 = *(const LAS bf16x8_t*)(wh0 + 32 * ks), bh1 = *(const LAS bf16x8_t*)(wh0 + 16 * WP + 32 * ks), bl0 = *(const LAS bf16x8_t*)(wl0 + 32 * ks), bl1 = *(const LAS bf16x8_t*)(wl0 + 16 * WP + 32 * ks);
            acc0 = __builtin_amdgcn_mfma_f32_16x16x32_bf16(ah, bh0, acc0, 0, 0, 0); acc1 = __builtin_amdgcn_mfma_f32_16x16x32_bf16(ah, bh1, acc1, 0, 0, 0);
            acc0 = __builtin_amdgcn_mfma_f32_16x16x32_bf16(ah, bl0, acc0, 0, 0, 0); acc1 = __builtin_amdgcn_mfma_f32_16x16x32_bf16(ah, bl1, acc1, 0, 0, 0);
            acc0 = __builtin_amdgcn_mfma_f32_16x16x32_bf16(al, bh0, acc0, 0, 0, 0); acc1 = __builtin_amdgcn_mfma_f32_16x16x32_bf16(al, bh1, acc1, 0, 0, 0);
        }
        if (kh == 1) { *(LAS f32x4*)(part + lane * 8) = acc0; *(LAS f32x4*)(part + lane * 8 + 4) = acc1; }
    }
    __syncthreads();
    if (grp < M / 16 && kh == 0) {
        acc0 += *(const LAS f32x4*)(part + lane * 8); acc1 += *(const LAS f32x4*)(part + lane * 8 + 4);
        const float b0 = br[t], b1 = br[16 + t];
#pragma unroll 1
        for (int half = 0; half < 2; ++half) {
            if ((quad >> 1) == half) {
#pragma unroll
                for (int i = 0; i < 4; ++i) { lg[((4 * quad + i) & 7) * 36 + t] = acc0[i] + b0; lg[((4 * quad + i) & 7) * 36 + 16 + t] = acc1[i] + b1; } }
            LDS_WAIT(); asm volatile("" ::: "memory");
            if (lane < 16 && (lane >> 3) == half) {
                float v[32];
#pragma unroll
                for (int q = 0; q < 8; ++q) { const f32x4 t4 = *(const LAS f32x4*)(lg + (lane & 7) * 36 + 4 * q); v[4 * q] = t4[0]; v[4 * q + 1] = t4[1]; v[4 * q + 2] = t4[2]; v[4 * q + 3] = t4[3]; }
#pragma unroll
                for (int k = 0; k < 4; ++k) { float bv = -INFINITY; int bi = 0;
#pragma unroll
                    for (int e = 0; e < 32; ++e) { const bool taken = (k > 0 && ti[0] == e) || (k > 1 && ti[1] == e) || (k > 2 && ti[2] == e); if (!taken && v[e] > bv) { bv = v[e]; bi = e; } }
                    tv[k] = bv; ti[k] = bi; }
            }
            LDS_WAIT(); asm volatile("" ::: "memory");
        }
    }
    const bool owner = (grp < M / 16) && kh == 0 && lane < 16;
    unsigned rank[4] = {0u, 0u, 0u, 0u};
    if (owner) {
#pragma unroll
        for (int k = 0; k < 4; ++k) rank[k] = __hip_atomic_fetch_add(lcnt + ti[k], 1u, __ATOMIC_RELAXED, __HIP_MEMORY_SCOPE_WORKGROUP);
    }
    __syncthreads();
    if (F.tid < NE) { const unsigned n = lcnt[F.tid]; lcnt[32 + F.tid] = n ? __hip_atomic_fetch_add(cur + F.tid * 64, n, __ATOMIC_RELAXED, __HIP_MEMORY_SCOPE_AGENT) : 0u; }
    __syncthreads();
    if (owner) {
        const float e1 = __expf(tv[1] - tv[0]), e2 = __expf(tv[2] - tv[0]), e3 = __expf(tv[3] - tv[0]); const float inv = rcp_(1.f + e1 + e2 + e3);
        const float gt[4] = {inv, e1 * inv, e2 * inv, e3 * inv};
        const int tok = grp * 16 + lane;
#pragma unroll
        for (int k = 0; k < 4; ++k) { const int e = ti[k]; const unsigned slot = lcnt[32 + e] + rank[k]; ROWTOK[e * M + slot] = tok; TOKPOS[tok * 4 + k] = e * M + (int)slot; TOKW[tok * 4 + k] = gt[k]; }
    }
    __syncthreads();
}
__device__ __forceinline__ void p_convert_router(Frame& F) {
    const float* w = F.in(24); bf16* wt = (bf16*)(F.ws() + WS_WRT);
    for (int idx = F.bid * NTHR + F.tid; idx < NL * NE * DM; idx += F.G * NTHR) {
        const int l = idx / (NE * DM), e = (idx / DM) % NE, c = idx % DM;
        const float v = w[((size_t)l * DM + c) * NE + e]; const unsigned hi = f2bf(v); const unsigned lo = f2bf(v - __builtin_bit_cast(float, hi << 16));
        wt[((size_t)(l * 2 + 0) * NE + e) * DM + c] = (bf16)hi; wt[((size_t)(l * 2 + 1) * NE + e) * DM + c] = (bf16)lo;
    }
}
__device__ __forceinline__ void moe_table(Frame& F, int l) {
    LAS int* tb = (LAS int*)(F.lds + LDSCTL_OFF + 64); LAS int* cnt = (LAS int*)(F.lds + LDSCTL_OFF + 256);
    unsigned* cur = (unsigned*)(F.ws() + WS_CTL) + CW_CUR + l * NE * 64;
    __syncthreads();
    if (F.tid < NE) cnt[F.tid] = (int)__hip_atomic_load(cur + F.tid * 64, __ATOMIC_RELAXED, __HIP_MEMORY_SCOPE_AGENT);
    __syncthreads();
    if (F.tid == 0) { int a = 0; for (int e = 0; e < NE; ++e) { tb[e] = a; a += (cnt[e] + 255) >> 8; } tb[NE] = a; }
    __syncthreads();
}
__device__ __forceinline__ void p_gather(Frame& F) {
    const LAS int* tb = (const LAS int*)(F.lds + LDSCTL_OFF + 64); const LAS int* cnt = (const LAS int*)(F.lds + LDSCTL_OFF + 256);
    const bf16* XN = (const bf16*)(F.ws() + WS_XN); bf16* XS = (bf16*)(F.ws() + WS_XS); const int* ROWTOK = (const int*)(F.ws() + WS_ROWTOK);
    const int nrows = tb[NE] * 256;
    for (int R = F.gw; R < nrows; R += F.ngw) {
        const int tg = R >> 8; int e = 0;
#pragma unroll
        for (int k = 1; k < NE; ++k) e += (tb[k] <= tg) ? 1 : 0;
        const int rr = R - tb[e] * 256;
        v4u a = {0u, 0u, 0u, 0u}, b = a;
        if (rr < cnt[e]) { const int tok = ROWTOK[e * M + rr]; const v4u* src = (const v4u*)(XN + (size_t)tok * DM); a = src[F.lane]; b = src[64 + F.lane]; }
        v4u* dst = (v4u*)(XS + (size_t)R * DM); dst[F.lane] = a; dst[64 + F.lane] = b;
    }
}
__device__ __forceinline__ void p_combine(Frame& F, int l, bool dummy) {
    const LAS int* tb = (const LAS int*)(F.lds + LDSCTL_OFF + 64);
    float* x = F.out(); float* xd = dummy ? (float*)(F.ws() + WS_MRG) : x; const float* MOD = (const float*)(F.ws() + WS_MOD); const float* modl = MOD + (size_t)l * NB * 6144;
    const bf16* YS = (const bf16*)(F.ws() + WS_YS); const int* TOKPOS = (const int*)(F.ws() + WS_TOKPOS); const float* TOKW = (const float*)(F.ws() + WS_TOKW);
    bf16* XN = (bf16*)(F.ws() + (dummy ? WS_MERGED : WS_XN));
    const int lane = F.lane;
    for (int row = F.gw; row < M; row += F.ngw) {
        const float* mb = modl + (size_t)(row / NT) * 6144;
        f32x4 acc[4];
#pragma unroll
        for (int j = 0; j < 4; ++j) acc[j] = (f32x4){0.f, 0.f, 0.f, 0.f};
#pragma unroll
        for (int k = 0; k < 4; ++k) { const int pos = TOKPOS[row * 4 + k]; const float w = TOKW[row * 4 + k]; const int e = pos / M, slot = pos % M;
            const bf16* yr = YS + (size_t)(tb[e] * 256 + slot) * DM;
#pragma unroll
            for (int j = 0; j < 4; ++j) { float t[4]; ld4bf(yr + 4 * lane + 256 * j, t); acc[j] += w * (f32x4){t[0], t[1], t[2], t[3]}; } }
        f32x4 v[4]; float s = 0.f;
#pragma unroll
        for (int j = 0; j < 4; ++j) { const int c = 4 * lane + 256 * j; f32x4* xp = (f32x4*)(x + (size_t)row * DM + c); const f32x4 g2 = *(const f32x4*)(mb + 5120 + c);
            v[j] = *xp + g2 * acc[j]; *(f32x4*)(xd + (size_t)row * DM + c) = v[j]; s += (v[j][0] * v[j][0] + v[j][1] * v[j][1]) + (v[j][2] * v[j][2] + v[j][3] * v[j][3]); }
        if (l + 1 < NL) { const float rs = rsq_(wave_sum(s) * (1.f / DM) + 1e-6f); const float* mn = MOD + ((size_t)(l + 1) * NB + row / NT) * 6144;
            norm_row_store(v, rs, mn + 0, mn + 1024, XN + (size_t)row * DM, lane); }
    }
}

__global__ void __launch_bounds__(NTHR, 2) fwd(Params P) {
    extern __shared__ __attribute__((aligned(16))) unsigned char lds[];
    Frame F;
    F.lds = (LAS unsigned char*)lds; F.ka = (kptr_t)__builtin_amdgcn_kernarg_segment_ptr();
    F.tid = threadIdx.x; F.lane = F.tid & 63; F.wave = __builtin_amdgcn_readfirstlane(F.tid >> 6);
    F.G = gridDim.x; F.bid = blockIdx.x; F.gw = blockIdx.x * NWAVES + F.wave; F.ngw = F.G * NWAVES;
    for (int u = F.tid; u < (LDS_BYTES - LDSCTL_OFF) / 4; u += NTHR) ((LAS unsigned*)(F.lds + LDSCTL_OFF))[u] = 0u;
    __syncthreads();
    XcdBarrier bar = xcd_barrier_post((unsigned*)(F.ws() + WS_CTL) + CW_BAR, (volatile LAS unsigned*)(F.lds + LDSCTL_OFF));
#define GRID_BAR() do { PHASE_BEGIN(); xcd_barrier(bar, (unsigned*)(F.ws() + WS_CTL) + CW_BAR); } while (0)
#ifndef PH_MASK
#define PH_MASK 0xFFFFFFFFu
#endif
#define PH(k) if constexpr ((PH_MASK >> (k)) & 1u)
#ifndef REP_MASK
#define REP_MASK 0u
#endif
#define REP(k) for (int _r = 0; _r < ((((REP_MASK) >> (k)) & 1u) ? 2 : 1); ++_r)
#if PROBE_TS
#define TS_NOW() ((unsigned)__builtin_amdgcn_s_memrealtime())
#define TS_E(l, k) do { if (F.tid == 0) atomicMax((unsigned*)(F.ws() + WS_CTL) + CW_TS + (l) * 32 + (k), TS_NOW()); } while (0)
#define TS_X(l, p) do { if (F.tid == 0 && F.bid == 0) ((unsigned*)(F.ws() + WS_CTL))[CW_TS + (l) * 32 + 16 + (p)] = TS_NOW(); } while (0)
#else
#define TS_E(l, k) do { } while (0)
#define TS_X(l, p) do { } while (0)
#endif
#define PHASE_BEGIN() do { kptr_t _k = (kptr_t)__builtin_amdgcn_kernarg_segment_ptr(); int _t = threadIdx.x, _b = blockIdx.x, _g = gridDim.x; asm volatile("" : "+s"(_k), "+v"(_t), "+s"(_b), "+s"(_g)); \
    F.ka = _k; F.tid = _t; F.lane = _t & 63; F.wave = __builtin_amdgcn_readfirstlane(_t >> 6); F.bid = _b; F.G = _g; F.gw = _b * NWAVES + F.wave; F.ngw = _g * NWAVES; } while (0)

    PHASE_BEGIN();
    REP(0) PH(0) { p_convert(F); p_convert_router(F); }
    __syncthreads();
    PHASE_BEGIN();
    PH(1) p_mod(F);
    GRID_BAR();
    PHASE_BEGIN();
    PH(2) p_norm_rows(F, F.in(0), (const float*)(F.ws() + WS_MOD), 0, 1024);
    GRID_BAR();
    TS_X(0, 15);

#define LAYER_BODY(l) do { \
 \
        PHASE_BEGIN(); \
        REP(3) PH(3) { pg8::Gemm g{(const bf16*)(F.ws() + WS_XN), (const bf16*)(F.ws() + WS_WIN) + (size_t)l * ZW * DM, DM, DM, DM}; pg8::StaticOrder S; S.init(M, ZW, F.G, F.bid); \
          EpiZ E; E.Z = (bf16*)(F.ws() + WS_Z); E.FL = (float*)(F.ws() + WS_FLOGIT); \
          pg8::gemm_phase<EpiZ, pg8::StaticOrder, true>(F.lds, g, S, E, F.tid); } \
        TS_E(l, 0); GRID_BAR(); TS_X(l, 0); \
 \
        PHASE_BEGIN(); \
        static_assert(2 * RWC == 64 && (M / 64) == NB * NCH / 2, "prep + pass 1 share the unit: 64 consecutive tokens"); \
        PH(4) for (int un = F.bid; un < M / 64; un += F.G) { \
            p_prep(F, l, false, 16 * un + F.wave, 8, 16 * un + 16); \
            VM_WAIT(); TS_E(l, 14); \
            PH(5) p_rwkv_pass1(F, un, 1, un + 1); \
            __syncthreads(); } \
        TS_E(l, 1); GRID_BAR(); TS_X(l, 1); \
 \
        PHASE_BEGIN(); \
        REP(6) PH(6) { const int nrw = NB * NHR; \
          if (F.bid >= F.G - nrw) { REP(15) PH(15) p_rwkv_pass2(F, F.G - nrw, l); TS_E(l, 3); } \
          else { const int nw = F.G - nrw, me = F.bid; \
 \
              PH(16) { unsigned* qh = (unsigned*)(F.ws() + WS_CTL) + CW_ATT + 64 * l; LAS int* qs = (LAS int*)(F.lds + LDSCTL_OFF + 512); \
                for (;;) { __syncthreads(); if (F.tid == 0) qs[0] = (int)__hip_atomic_fetch_add(qh, 1u, __ATOMIC_RELAXED, __HIP_MEMORY_SCOPE_AGENT); __syncthreads(); \
                    const int idx = __builtin_amdgcn_readfirstlane(qs[0]); if (idx >= 512 + M / 128) break; \
                    if (idx < 416 || idx >= 416 + M / 128) { const int j = idx < 416 ? idx : idx - M / 128; p_attn_unit(F, l, j & 31, 15 - (j >> 5)); } else { PHASE_BEGIN(); p_gmlp_unit(F, l, idx - 416); } } } PHASE_BEGIN(); TS_E(l, 2); } } \
        GRID_BAR(); TS_X(l, 2); \
 \
        PHASE_BEGIN(); \
        REP(7) PH(7) p_rwkv_pass3(F, l); \
        TS_E(l, 4); GRID_BAR(); TS_X(l, 3); \
 \
        PHASE_BEGIN(); \
        REP(8) PH(8) { pg8::Gemm g{(const bf16*)(F.ws() + WS_YMIX), (const bf16*)(F.ws() + WS_WBR) + (size_t)l * DM * DM, DM, DM, DM}; pg8::StaticOrder S; S.init(M, DM, F.G, F.bid); \
          EpiMerge2 E; E.Z = (const bf16*)(F.ws() + WS_Z); E.MERGED = (bf16*)(F.ws() + WS_MERGED); \
          pg8::gemm_phase<EpiMerge2, pg8::StaticOrder, true>(F.lds, g, S, E, F.tid); } \
        TS_E(l, 5); GRID_BAR(); TS_X(l, 4); \
 \
        PHASE_BEGIN(); \
        PH(9) { pg8::Gemm g{(const bf16*)(F.ws() + WS_MERGED), (const bf16*)(F.ws() + WS_WO) + (size_t)l * DM * DM, DM, DM, DM}; pg8::StaticOrder S; S.init(M, DM, F.G, F.bid); \
          EpiWo E; E.xin = (l == 0) ? F.in(0) : F.out(); E.xout = F.out(); E.gate = (const float*)(F.ws() + WS_MOD) + (size_t)l * NB * 6144 + 2048; E.SSP = (float*)(F.ws() + WS_SSP); \
          pg8::gemm_phase<EpiWo, pg8::StaticOrder, true>(F.lds, g, S, E, F.tid); } \
        TS_E(l, 6); GRID_BAR(); TS_X(l, 5); \
 \
        PHASE_BEGIN(); \
        if constexpr ((REP_MASK >> 10) & 1u) { p_route(F, l, l + 4); __syncthreads(); } \
        PH(10) p_route(F, l, l); \
        TS_E(l, 7); GRID_BAR(); TS_X(l, 6); \
 \
        PHASE_BEGIN(); \
        moe_table(F, l); \
        REP(12) PH(12) { pg8::Gemm g{(const bf16*)(F.ws() + WS_XN), (const bf16*)(F.ws() + WS_WGU) + (size_t)l * NE * 2048 * DM, DM, DM, DM}; \
          pg8::GroupedOrder S; S.tb = (const LAS int*)(F.lds + LDSCTL_OFF + 64); S.nct = 8; S.G = F.G; S.c = F.bid; \
          EpiMoe1 E; E.bgu = F.in(27) + (size_t)l * NE * 2048; E.ACT = (bf16*)(F.ws() + WS_ACT); E.ROWTOK = (const int*)(F.ws() + WS_ROWTOK); E.tb = S.tb; E.cnt = (const LAS int*)(F.lds + LDSCTL_OFF + 256); \
          pg8::gemm_phase<EpiMoe1, pg8::GroupedOrder, true>(F.lds, g, S, E, F.tid); } \
        TS_E(l, 8); GRID_BAR(); TS_X(l, 7); \
 \
        PHASE_BEGIN(); \
        REP(13) PH(13) { pg8::Gemm g{(const bf16*)(F.ws() + WS_ACT), (const bf16*)(F.ws() + WS_WD) + (size_t)l * NE * DM * DFF, DFF, DFF, DFF}; \
          pg8::GroupedOrder S; S.tb = (const LAS int*)(F.lds + LDSCTL_OFF + 64); S.nct = 4; S.G = F.G; S.c = F.bid; \
          EpiMoe2 E; E.bd = F.in(29) + (size_t)l * NE * DM; E.YS = (bf16*)(F.ws() + WS_YS); \
          pg8::gemm_phase<EpiMoe2, pg8::GroupedOrder, true>(F.lds, g, S, E, F.tid); } \
        TS_E(l, 9); GRID_BAR(); TS_X(l, 8); \
 \
        PHASE_BEGIN(); \
        if constexpr ((REP_MASK >> 14) & 1u) { p_combine(F, l, true); } \
        PH(14) p_combine(F, l, false); \
        TS_E(l, 10); GRID_BAR(); TS_X(l, 9); \
    } while (0)
    LAYER_BODY(0); LAYER_BODY(1); LAYER_BODY(2); LAYER_BODY(3);
#undef LAYER_BODY
#if PROBE_TS
    PHASE_BEGIN();
    if (F.bid == 0 && F.tid == 0) {
        unsigned* ts = (unsigned*)(F.ws() + WS_CTL) + CW_TS; unsigned D = 0;
        const int ph_of[11] = {0, 1, 2, 2, 3, 4, 5, 6, 7, 8, 9};
        for (int l = 0; l < NL; ++l) {
            if (PROBE_TS == 14) { D += __hip_atomic_load(ts + l * 32 + 14, __ATOMIC_RELAXED, __HIP_MEMORY_SCOPE_AGENT) - ts[l * 32 + 16 + 0]; }
            else if (PROBE_TS >= 21) { D += __hip_atomic_load(ts + l * 32 + 11 + (PROBE_TS - 21), __ATOMIC_RELAXED, __HIP_MEMORY_SCOPE_AGENT); }
            else if (PROBE_TS <= 11) { const int k = PROBE_TS - 1, p = ph_of[k];
                const unsigned e = __hip_atomic_load(ts + l * 32 + k, __ATOMIC_RELAXED, __HIP_MEMORY_SCOPE_AGENT);
                const unsigned x0 = (p == 0) ? ((l == 0) ? ts[16 + 15] : ts[(l - 1) * 32 + 16 + 9]) : ts[l * 32 + 16 + p - 1];
                D += e - x0;
            } else {
                for (int p = 0; p < 10; ++p) { unsigned e;
                    if (p == 2) { const unsigned e2 = __hip_atomic_load(ts + l * 32 + 2, __ATOMIC_RELAXED, __HIP_MEMORY_SCOPE_AGENT), e3 = __hip_atomic_load(ts + l * 32 + 3, __ATOMIC_RELAXED, __HIP_MEMORY_SCOPE_AGENT); e = (int)(e2 - e3) > 0 ? e2 : e3; }
                    else e = __hip_atomic_load(ts + l * 32 + (p < 2 ? p : p + 1), __ATOMIC_RELAXED, __HIP_MEMORY_SCOPE_AGENT);
                    D += ts[l * 32 + 16 + p] - e; }
            }
        }
        if (PROBE_TS == 13 || (PROBE_TS > 14 && PROBE_TS < 21)) D = 0;
        D *= 8u; const unsigned t_start = TS_NOW();
        while (TS_NOW() - t_start < D) __builtin_amdgcn_s_sleep(32);
    }
#endif
}

extern "C" void kernel_launch(void* const* d_in, const int* in_sizes, int n_in, void* d_out, int out_size, void* d_ws, size_t ws_size, hipStream_t stream) {
    static int grid = 0;
    if (grid == 0) {
        if (n_in != 30 || out_size != M * DM || ws_size < WS_END) { fprintf(stderr, "kernel_launch: unexpected shapes (n_in %d, out %d, ws %zu)\n", n_in, out_size, ws_size); grid = -1; return; }
        int dev = 0, cus = 0, per_cu = 0;
        if (hipGetDevice(&dev) != hipSuccess || hipDeviceGetAttribute(&cus, hipDeviceAttributeMultiprocessorCount, dev) != hipSuccess) { grid = -1; return; }
        if (hipFuncSetAttribute((const void*)fwd, hipFuncAttributeMaxDynamicSharedMemorySize, LDS_BYTES) != hipSuccess) { fprintf(stderr, "kernel_launch: hipFuncSetAttribute failed\n"); grid = -1; return; }
        if (hipOccupancyMaxActiveBlocksPerMultiprocessor(&per_cu, (const void*)fwd, NTHR, LDS_BYTES) != hipSuccess || per_cu < 1) { fprintf(stderr, "kernel_launch: occupancy query says %d\n", per_cu); (void)hipGetLastError(); grid = -1; return; }
        grid = cus;
    }
    if (grid < 0) return;
    if (hipMemsetAsync((char*)d_ws + WS_CTL, 0, CTL_ZERO_BYTES, stream) != hipSuccess) return;
    Params p{};
    for (int i = 0; i < 30; ++i) p.in[i] = (const float*)d_in[i];
    p.out = (float*)d_out; p.ws = (unsigned char*)d_ws;
    hipLaunchKernelGGL(fwd, dim3(grid), dim3(NTHR), LDS_BYTES, stream, p);
}
```
